# Optimizing an MI355X kernel written in HIP

```python
import jax, jax.numpy as jnp
from jax import lax
import numpy as np

D_MODEL = 1024
BATCH = 8
SEQ = 2048
DEPTH = 4
DEC_BATCH = 128
DEC_SEQ = 8
PAST_LEN = 16384
PAGE_SIZE = 128

N_MIXERS = 2
D_FF = 2816
EXPAND = 2
D_INNER = EXPAND * D_MODEL
SSD_HEAD_DIM = 64
SSD_HEADS = D_INNER // SSD_HEAD_DIM
SSD_GROUPS = 4
HEADS_PER_GROUP = SSD_HEADS // SSD_GROUPS
D_STATE = 128
CONV_W = 4
CONV_DIM = D_INNER + 2 * SSD_GROUPS * D_STATE
IN_DIM = D_INNER + CONV_DIM + SSD_HEADS
SSD_CHUNK = 128
POOL_WINDOWS = (2, 4, 8, 16)
POOL_GROUPS = len(POOL_WINDOWS)
POOL_GW = D_MODEL // POOL_GROUPS
POOL_BUF = max(POOL_WINDOWS) - 1
N_MEM = 256
MEM_HEADS = 4
MEM_HEAD_DIM = D_MODEL // MEM_HEADS
N_SSD_LAYERS = (DEPTH + 1) // 2
N_POOL_LAYERS = DEPTH // 2
EPS = 1e-5

kernel_name = "hybrid_ssd_pool_macaron_memxattn_step"


def _rms(x, g):
    xf = x.astype(jnp.float32)
    r = lax.rsqrt(jnp.mean(xf * xf, axis=-1, keepdims=True) + EPS)
    return (xf * r * g.astype(jnp.float32)).astype(x.dtype)


def _swiglu(u, wg, wu, wd):
    return (jax.nn.silu(u @ wg) * (u @ wu)) @ wd


def _ssd_scan(x, dt, a, bm, cm, h0):
    Bsz, L = x.shape[0], x.shape[1]
    q = SSD_CHUNK if L % SSD_CHUNK == 0 else L
    nc = L // q
    x = x.reshape(Bsz, nc, q, SSD_GROUPS, HEADS_PER_GROUP, SSD_HEAD_DIM)
    dt = dt.reshape(Bsz, nc, q, SSD_GROUPS, HEADS_PER_GROUP)
    bm = bm.reshape(Bsz, nc, q, SSD_GROUPS, D_STATE)
    cm = cm.reshape(Bsz, nc, q, SSD_GROUPS, D_STATE)
    acs = jnp.cumsum(dt * a.reshape(SSD_GROUPS, HEADS_PER_GROUP), axis=2)
    xdt = x * dt[..., None]
    causal = jnp.tril(jnp.ones((q, q), dtype=bool))[:, :, None, None]
    seg = acs[:, :, :, None] - acs[:, :, None, :]
    decay = jnp.exp(jnp.where(causal, seg, -jnp.inf))
    cb = jnp.einsum('bcqgn,bckgn->bcqkg', cm, bm)
    y_diag = jnp.einsum('bcqkgh,bckghp->bcqghp', cb[..., None] * decay, xdt)
    decay_to_end = jnp.exp(acs[:, :, -1:] - acs)
    states = jnp.einsum('bcqgn,bcqgh,bcqghp->bcghpn', bm, decay_to_end, xdt)
    chunk_decay = jnp.exp(acs[:, :, -1])

    def step(h, inp):
        st, dec = inp
        return h * dec[..., None, None] + st, h

    h_init = h0.reshape(Bsz, SSD_GROUPS, HEADS_PER_GROUP, SSD_HEAD_DIM, D_STATE)
    h_final, h_prev = lax.scan(step, h_init, (jnp.moveaxis(states, 1, 0), jnp.moveaxis(chunk_decay, 1, 0)))
    h_prev = jnp.moveaxis(h_prev, 0, 1)
    y_off = jnp.einsum('bcqgn,bcghpn,bcqgh->bcqghp', cm, h_prev, jnp.exp(acs))
    y = (y_diag + y_off).reshape(Bsz, L, SSD_HEADS, SSD_HEAD_DIM)
    return y, h_final.reshape(Bsz, SSD_HEADS, SSD_HEAD_DIM, D_STATE)


def _ssd_mixer(u, conv_buf, ssm_state, in_w, conv_w, conv_b, dt_bias, a_log, d_skip, norm_w, out_w):
    Bsz, L, _ = u.shape
    zxbcdt = u @ in_w
    z = zxbcdt[..., :D_INNER]
    xbc = zxbcdt[..., D_INNER:D_INNER + CONV_DIM]
    dt_raw = zxbcdt[..., D_INNER + CONV_DIM:]
    xx = jnp.concatenate([conv_buf.astype(xbc.dtype), xbc], axis=1)
    conv = conv_b + sum(xx[:, k:k + L] * conv_w[k] for k in range(CONV_W))
    xbc = jax.nn.silu(conv)
    new_conv = xx[:, L:].astype(conv_buf.dtype)
    gn = SSD_GROUPS * D_STATE
    xs = xbc[..., :D_INNER].reshape(Bsz, L, SSD_HEADS, SSD_HEAD_DIM).astype(jnp.float32)
    bm = xbc[..., D_INNER:D_INNER + gn].reshape(Bsz, L, SSD_GROUPS, D_STATE).astype(jnp.float32)
    cm = xbc[..., D_INNER + gn:].reshape(Bsz, L, SSD_GROUPS, D_STATE).astype(jnp.float32)
    dt = jax.nn.softplus(dt_raw.astype(jnp.float32) + dt_bias.astype(jnp.float32))
    a = -jnp.exp(a_log.astype(jnp.float32))
    y, new_ssm = _ssd_scan(xs, dt, a, bm, cm, ssm_state.astype(jnp.float32))
    y = y + xs * d_skip.astype(jnp.float32)[:, None]
    y = y.reshape(Bsz, L, D_INNER) * jax.nn.silu(z.astype(jnp.float32))
    yg = y.reshape(Bsz, L, SSD_GROUPS, D_INNER // SSD_GROUPS)
    yg = yg * lax.rsqrt(jnp.mean(yg * yg, axis=-1, keepdims=True) + EPS)
    y = (yg.reshape(Bsz, L, D_INNER) * norm_w.astype(jnp.float32)).astype(u.dtype)
    return y @ out_w, new_conv, new_ssm.astype(ssm_state.dtype)


def _pool_mixer(u, buf, pos0, pool_w, pool_scale):
    Bsz, L, _ = u.shape
    xx = jnp.concatenate([buf.astype(jnp.float32), u.astype(jnp.float32)], axis=1)
    cs0 = jnp.concatenate([jnp.zeros((Bsz, 1, D_MODEL), jnp.float32), jnp.cumsum(xx, axis=1)], axis=1)
    end = cs0[:, POOL_BUF + 1:]
    pos = (pos0 + jnp.arange(L)).astype(jnp.float32)
    uf = u.astype(jnp.float32)
    outs = []
    for g, w in enumerate(POOL_WINDOWS):
        lo, hi = g * POOL_GW, (g + 1) * POOL_GW
        start = cs0[:, POOL_BUF + 1 - w:POOL_BUF + 1 - w + L, lo:hi]
        cnt = jnp.minimum(pos + 1.0, float(w))[None, :, None]
        mix = (end[..., lo:hi] - start) / cnt - uf[..., lo:hi]
        outs.append(jnp.einsum('bld,de->ble', mix, pool_w[g].astype(jnp.float32)))
    out = (jnp.concatenate(outs, axis=-1) * pool_scale.astype(jnp.float32)).astype(u.dtype)
    return out, xx[:, L:].astype(buf.dtype)


def _mem_kv(mem, g, wk, wv):
    Bsz = mem.shape[0]
    m = _rms(mem, g)
    k = (m @ wk).reshape(Bsz, N_MEM, MEM_HEADS, MEM_HEAD_DIM)
    v = (m @ wv).reshape(Bsz, N_MEM, MEM_HEADS, MEM_HEAD_DIM)
    return k, v


def _cross_attn(u, mk, mv, wq, wo):
    Bsz, L, _ = u.shape
    q = (u @ wq).reshape(Bsz, L, MEM_HEADS, MEM_HEAD_DIM)
    s = jnp.einsum('blhd,bmhd->bhlm', q.astype(jnp.float32), mk.astype(jnp.float32)) * (MEM_HEAD_DIM ** -0.5)
    p = jax.nn.softmax(s, axis=-1).astype(mv.dtype)
    o = jnp.einsum('bhlm,bmhd->blhd', p, mv).reshape(Bsz, L, D_MODEL)
    return o @ wo


def setup_inputs(seed: int = 0) -> dict:
    key = jax.random.key(seed)
    ks = iter(jax.random.split(key, 64))
    f32 = jnp.float32

    def nrm(shape, scale):
        return jax.random.normal(next(ks), shape, f32) * scale

    def gain(shape):
        return 1.0 + 0.05 * jax.random.normal(next(ks), shape, f32)

    dt0 = jnp.exp(jax.random.uniform(next(ks), (N_SSD_LAYERS, SSD_HEADS), f32)
                  * (np.log(0.1) - np.log(0.001)).astype(np.float32) + np.float32(np.log(0.001)))
    dt_bias = dt0 + jnp.log(-jnp.expm1(-dt0))
    a_log = jnp.log(jax.random.uniform(next(ks), (N_SSD_LAYERS, SSD_HEADS), f32, minval=1.0, maxval=16.0))
    return {
        "x_prompt": nrm((BATCH, SEQ, D_MODEL), 1.0),
        "x_sample": nrm((DEC_BATCH, DEC_SEQ, D_MODEL), 1.0),
        "mem_prompt": nrm((BATCH, N_MEM, D_MODEL), 1.0),
        "cache_mem_k": nrm((DEPTH, DEC_BATCH, N_MEM, MEM_HEADS, MEM_HEAD_DIM), 1.0),
        "cache_mem_v": nrm((DEPTH, DEC_BATCH, N_MEM, MEM_HEADS, MEM_HEAD_DIM), 1.0),
        "state_ssm": nrm((N_SSD_LAYERS, DEC_BATCH, SSD_HEADS, SSD_HEAD_DIM, D_STATE), 0.3),
        "state_conv": nrm((N_SSD_LAYERS, DEC_BATCH, CONV_W - 1, CONV_DIM), 1.0),
        "state_pool": nrm((N_POOL_LAYERS, DEC_BATCH, POOL_BUF, D_MODEL), 1.0),
        "norm_ffn1": gain((DEPTH, D_MODEL)),
        "ffn1_w_gate": nrm((DEPTH, D_MODEL, D_FF), D_MODEL ** -0.5),
        "ffn1_w_up": nrm((DEPTH, D_MODEL, D_FF), D_MODEL ** -0.5),
        "ffn1_w_down": nrm((DEPTH, D_FF, D_MODEL), D_FF ** -0.5),
        "norm_mix": gain((DEPTH, D_MODEL)),
        "ssd_in_w": nrm((N_SSD_LAYERS, D_MODEL, IN_DIM), D_MODEL ** -0.5),
        "ssd_conv_w": nrm((N_SSD_LAYERS, CONV_W, CONV_DIM), CONV_W ** -0.5),
        "ssd_conv_b": nrm((N_SSD_LAYERS, CONV_DIM), 0.02),
        "ssd_dt_bias": dt_bias,
        "ssd_a_log": a_log,
        "ssd_d": gain((N_SSD_LAYERS, SSD_HEADS)),
        "ssd_norm_w": gain((N_SSD_LAYERS, D_INNER)),
        "ssd_out_w": nrm((N_SSD_LAYERS, D_INNER, D_MODEL), D_INNER ** -0.5),
        "pool_w": nrm((N_POOL_LAYERS, POOL_GROUPS, POOL_GW, POOL_GW), POOL_GW ** -0.5),
        "pool_scale": gain((N_POOL_LAYERS, D_MODEL)),
        "norm_cross": gain((DEPTH, D_MODEL)),
        "norm_mem": gain((DEPTH, D_MODEL)),
        "xa_wq": nrm((DEPTH, D_MODEL, D_MODEL), D_MODEL ** -0.5),
        "xa_wk": nrm((DEPTH, D_MODEL, D_MODEL), D_MODEL ** -0.5),
        "xa_wv": nrm((DEPTH, D_MODEL, D_MODEL), D_MODEL ** -0.5),
        "xa_wo": nrm((DEPTH, D_MODEL, D_MODEL), D_MODEL ** -0.5),
        "norm_ffn2": gain((DEPTH, D_MODEL)),
        "ffn2_w_gate": nrm((DEPTH, D_MODEL, D_FF), D_MODEL ** -0.5),
        "ffn2_w_up": nrm((DEPTH, D_MODEL, D_FF), D_MODEL ** -0.5),
        "ffn2_w_down": nrm((DEPTH, D_FF, D_MODEL), D_FF ** -0.5),
        "final_norm": gain((D_MODEL,)),
    }


def reference(x_prompt, x_sample, mem_prompt, cache_mem_k, cache_mem_v, state_ssm, state_conv, state_pool,
              norm_ffn1, ffn1_w_gate, ffn1_w_up, ffn1_w_down, norm_mix,
              ssd_in_w, ssd_conv_w, ssd_conv_b, ssd_dt_bias, ssd_a_log, ssd_d, ssd_norm_w, ssd_out_w,
              pool_w, pool_scale, norm_cross, norm_mem, xa_wq, xa_wk, xa_wv, xa_wo,
              norm_ffn2, ffn2_w_gate, ffn2_w_up, ffn2_w_down, final_norm):

    def run_group(x, pos0, conv_in, ssm_in, pool_in, mem_k, mem_v):
        new_conv, new_ssm, new_pool = [], [], []
        for i in range(DEPTH):
            j = i // N_MIXERS
            x = x + 0.5 * _swiglu(_rms(x, norm_ffn1[i]), ffn1_w_gate[i], ffn1_w_up[i], ffn1_w_down[i])
            u = _rms(x, norm_mix[i])
            if i % N_MIXERS == 0:
                out, cs, ss = _ssd_mixer(u, conv_in[j], ssm_in[j], ssd_in_w[j], ssd_conv_w[j], ssd_conv_b[j],
                                         ssd_dt_bias[j], ssd_a_log[j], ssd_d[j], ssd_norm_w[j], ssd_out_w[j])
                new_conv.append(cs)
                new_ssm.append(ss)
            else:
                out, ps = _pool_mixer(u, pool_in[j], pos0, pool_w[j], pool_scale[j])
                new_pool.append(ps)
            x = x + out
            x = x + _cross_attn(_rms(x, norm_cross[i]), mem_k[i], mem_v[i], xa_wq[i], xa_wo[i])
            x = x + 0.5 * _swiglu(_rms(x, norm_ffn2[i]), ffn2_w_gate[i], ffn2_w_up[i], ffn2_w_down[i])
        return _rms(x, final_norm), jnp.stack(new_ssm), jnp.stack(new_conv), jnp.stack(new_pool)

    dt_p = x_prompt.dtype
    conv0 = [jnp.zeros((BATCH, CONV_W - 1, CONV_DIM), dt_p) for _ in range(N_SSD_LAYERS)]
    ssm0 = [jnp.zeros((BATCH, SSD_HEADS, SSD_HEAD_DIM, D_STATE), dt_p) for _ in range(N_SSD_LAYERS)]
    pool0 = [jnp.zeros((BATCH, POOL_BUF, D_MODEL), dt_p) for _ in range(N_POOL_LAYERS)]
    mk_p, mv_p = [], []
    for i in range(DEPTH):
        k_i, v_i = _mem_kv(mem_prompt, norm_mem[i], xa_wk[i], xa_wv[i])
        mk_p.append(k_i)
        mv_p.append(v_i)
    y_prompt, ssm_p, conv_p, pool_p = run_group(x_prompt, 0, conv0, ssm0, pool0, mk_p, mv_p)
    new_mem_k_prompt = jnp.stack(mk_p)
    new_mem_v_prompt = jnp.stack(mv_p)

    y_sample, ssm_s, conv_s, pool_s = run_group(x_sample, PAST_LEN, state_conv, state_ssm, state_pool,
                                                cache_mem_k, cache_mem_v)
    return (y_prompt, y_sample, ssm_p, conv_p, pool_p, new_mem_k_prompt, new_mem_v_prompt, ssm_s, conv_s, pool_s)
```

```cpp
#include <hip/hip_runtime.h>
#include <cstdio>
#include <cstdint>

#define GAS __attribute__((address_space(1)))
#define LAS __attribute__((address_space(3)))
typedef unsigned short bf16_t;
typedef short bf16x8 __attribute__((ext_vector_type(8)));
typedef float f32x4 __attribute__((ext_vector_type(4)));
typedef float f32x2 __attribute__((ext_vector_type(2)));
typedef unsigned u32x4 __attribute__((ext_vector_type(4)));
typedef unsigned u32x2 __attribute__((ext_vector_type(2)));

constexpr int D = 1024, FF = 2816, DI = 2048, CONVD = 3072, NHEAD = 32, HDIM = 64, NST = 128, NGRP = 4;
constexpr int INW = 5152, INP = 5376, ZXP = 5120;
constexpr int MP = 16384, MS = 1024, M = MP + MS;
constexpr int PB = 8, PL = 2048, SB = 128, SL = 8, NMEM = 256;
constexpr float EPS = 1e-5f;

__device__ __forceinline__ unsigned f2bf(float f) { unsigned u = __builtin_bit_cast(unsigned, f); return (u + 0x7fffu + ((u >> 16) & 1u)) >> 16; }
__device__ __forceinline__ float bf2f(unsigned h) { return __builtin_bit_cast(float, h << 16); }
__device__ __forceinline__ unsigned cvt_pk_bf16(float lo, float hi);
__device__ __forceinline__ unsigned pk2(float lo, float hi) { return cvt_pk_bf16(lo, hi); }
typedef __bf16 bf16x2_t __attribute__((ext_vector_type(2)));
__device__ __forceinline__ unsigned cvt_pk_bf16(float lo, float hi) { f32x2 v = {lo, hi}; bf16x2_t b = __builtin_convertvector(v, bf16x2_t); return __builtin_bit_cast(unsigned, b); }
__device__ __forceinline__ float fast_exp(float x) { return __builtin_amdgcn_exp2f(x * 1.4426950408889634f); }
__device__ __forceinline__ float silu_f(float x) { return x * __builtin_amdgcn_rcpf(1.0f + fast_exp(-x)); }
__device__ __forceinline__ float softplus_f(float x) { const float e = fast_exp(x); const float r = (x < -8.f) ? e : __builtin_amdgcn_logf(1.0f + e) * 0.6931471805599453f; return x > 20.f ? x : r; }
__device__ __forceinline__ int opaque(int x) { asm volatile("" : "+v"(x)); return x; }
__device__ __forceinline__ int lane_now() { int l; asm volatile("v_mbcnt_lo_u32_b32 %0, -1, 0\n\tv_mbcnt_hi_u32_b32 %0, -1, %0" : "=v"(l)); return l; }
__device__ __forceinline__ int tid_now(int wave) { return wave * 64 + lane_now(); }
__device__ __forceinline__ float shx(float v, int mask) { return __builtin_bit_cast(float, __builtin_amdgcn_ds_bpermute((lane_now() ^ mask) << 2, __builtin_bit_cast(int, v))); }
__device__ __forceinline__ float shi(float v, int src) { return __builtin_bit_cast(float, __builtin_amdgcn_ds_bpermute(src << 2, __builtin_bit_cast(int, v))); }
__device__ __forceinline__ float shup(float v, int o) { return __builtin_bit_cast(float, __builtin_amdgcn_ds_bpermute(((lane_now() - o) & 63) << 2, __builtin_bit_cast(int, v))); }
__device__ __forceinline__ float wave_sum(float v) {
#pragma unroll
    for (int o = 1; o < 64; o <<= 1) v += shx(v, o);
    return v;
}

namespace pg8 {
#define PG8_LAS __attribute__((address_space(3)))
constexpr int BM = 256, BK = 64, HALF = 128, HTB = HALF * BK * 2  , STAGE_BYTES = 8 * HTB, NXCD = 8, WGM = 8;

__host__ __device__ __forceinline__ int lds_byte(int r, int c) { const int st = (r >> 4) * 2 + (c >> 5), rr = r & 15, cc = c & 31, ob = rr * 64 + cc * 2; return st * 1024 + (ob ^ (((ob >> 9) & 1) << 5)); }
__host__ __device__ __forceinline__ void stage_rc(int b, int& R, int& C) { const int st = b / 1024, sb = b % 1024, swz = sb ^ (((sb >> 9) & 1) << 5); R = (st >> 1) * 16 + swz / 64; C = (st & 1) * 32 + (swz % 64) / 2; }
__host__ __device__ __forceinline__ int perm32(int rho) { const int n = rho >> 4, i = rho & 15; return 8 * (i >> 2) + 4 * n + (i & 3); }

struct Unit { int pm, pn; };
__host__ __device__ __forceinline__ int uni(int x) {
#if defined(__HIP_DEVICE_COMPILE__)
    x = __builtin_amdgcn_readfirstlane(x); asm volatile("" : "+s"(x)); return x;
#else
    return x;
#endif
}
struct Gemm { const bf16_t* A; const bf16_t* Bt; int K, lda, ldb, akoff; };

struct StaticOrder {
    int nM, nN, nwg, G, c;
    __host__ __device__ __forceinline__ void init(int M_, int N_, int G_, int c_) { nM = M_ / BM; nN = N_ / BM; nwg = nM * nN; G = G_; c = c_; }
    __host__ __device__ __forceinline__ bool next(int i, Unit& u) const {
        const long L = (long)i * G + c; if (L >= nwg) return false;
        int wgid = (int)L; { const int q = nwg / NXCD, r = nwg % NXCD, xcd = wgid % NXCD, off = wgid / NXCD; wgid = (xcd < r ? xcd * (q + 1) : r * (q + 1) + (xcd - r) * q) + off; }
        const int nig = WGM * nN, gid = wgid / nig, fm = gid * WGM, rem = wgid % nig;
        if (fm + WGM <= nM) { u.pm = uni(fm + rem % WGM); u.pn = uni(rem / WGM); }
        else { const int g2 = (nM % WGM) ? (nM % WGM) : 1; u.pm = uni(fm + rem % g2); u.pn = uni(rem / g2); }
        return true;
    }
};
struct KvOrder {
    int G, c;
    __host__ __device__ __forceinline__ bool next(int i, Unit& u) const {
        const int L = i * G + c; if (L >= 384) return false;
        const int l = L / 96, r = L % 96, b = r & 7, h = (r >> 3) & 3, ty = r >> 5;
        if (ty == 0) { u.pm = 32 + l * 8 + b; u.pn = l * 8 + h; } else if (ty == 1) { u.pm = 32 + l * 8 + b; u.pn = l * 8 + 4 + h; } else { u.pm = l * 8 + 4 + h; u.pn = 32 + l * 8 + b; }
        u.pm = uni(u.pm); u.pn = uni(u.pn);
        return true;
    }
};


struct EpiGU {
    static constexpr bool PERM = true;
    bf16_t* H;
    __device__ __forceinline__ void operator()(const f32x4 (&acc)[2][2][4][2], const Unit& u, int wr, int wc, int fr, int fq) const {
        const int row0 = u.pm * BM + wr * 64 + fr, col0 = u.pn * HALF + wc * 32 + 8 * fq;
#pragma unroll
        for (int ai = 0; ai < 2; ++ai)
#pragma unroll
            for (int m = 0; m < 4; ++m) {
                bf16_t* p = H + (unsigned)((row0 + ai * HALF + m * 16) * FF + col0);
                const f32x4 g0 = acc[ai][0][m][0], g1 = acc[ai][0][m][1], u0 = acc[ai][1][m][0], u1 = acc[ai][1][m][1];
                u32x4 w;
                w.x = cvt_pk_bf16(silu_f(g0[0]) * u0[0], silu_f(g0[1]) * u0[1]); w.y = cvt_pk_bf16(silu_f(g0[2]) * u0[2], silu_f(g0[3]) * u0[3]);
                w.z = cvt_pk_bf16(silu_f(g1[0]) * u1[0], silu_f(g1[1]) * u1[1]); w.w = cvt_pk_bf16(silu_f(g1[2]) * u1[2], silu_f(g1[3]) * u1[3]);
                *(u32x4*)p = w;
            }
    }
};
struct EpiRes {
    static constexpr bool PERM = false;
    const float* sp; const float* ss; float* X; float alpha; const float* scale;
    __device__ __forceinline__ void operator()(const f32x4 (&acc)[2][2][4][2], const Unit& u, int wr, int wc, int fr, int fq) const {
        const int row0 = u.pm * BM + wr * 64 + fr, col0 = u.pn * BM + wc * 32 + 4 * fq;
        const float* src = (u.pm < MP / BM) ? sp : (ss - (size_t)MP * D);
        f32x4 sc[2][2];
#pragma unroll
        for (int bj = 0; bj < 2; ++bj)
#pragma unroll
            for (int n = 0; n < 2; ++n) { sc[bj][n] = scale ? *(const f32x4*)(scale + col0 + bj * HALF + n * 16) : (f32x4){1.f, 1.f, 1.f, 1.f}; sc[bj][n] = sc[bj][n] * alpha; }
#pragma unroll
        for (int ai = 0; ai < 2; ++ai)
#pragma unroll
            for (int mp = 0; mp < 2; ++mp) {
                f32x4 v[2][2][2];
#pragma unroll
                for (int m2 = 0; m2 < 2; ++m2) { const unsigned off = (unsigned)((row0 + ai * HALF + (2 * mp + m2) * 16) * D + col0);
#pragma unroll
                    for (int bj = 0; bj < 2; ++bj)
#pragma unroll
                        for (int n = 0; n < 2; ++n) v[m2][bj][n] = *(const f32x4*)(src + (off + bj * HALF + n * 16)); }
#pragma unroll
                for (int m2 = 0; m2 < 2; ++m2) { const unsigned off = (unsigned)((row0 + ai * HALF + (2 * mp + m2) * 16) * D + col0);
#pragma unroll
                    for (int bj = 0; bj < 2; ++bj)
#pragma unroll
                        for (int n = 0; n < 2; ++n) *(f32x4*)(X + (off + bj * HALF + n * 16)) = v[m2][bj][n] + acc[ai][bj][2 * mp + m2][n] * sc[bj][n]; }
            }
    }
};
template <class T, class = void> struct epi_groups { static constexpr bool value = false; };
template <class T> struct epi_groups<T, decltype((void)T::GROUPS)> { static constexpr bool value = T::GROUPS; };
struct EpiResG : EpiRes {
    static constexpr bool GROUPS = true;
    const PG8_LAS float* tab;
    __device__ __forceinline__ void rescale_slab(f32x4 (&sa)[2], int gi, int fr) const { const float f = tab[(256 + fr) * 4 + gi]; sa[0] = sa[0] * f; sa[1] = sa[1] * f; }
    __device__ __forceinline__ void rescale(f32x4 (&acc)[2][2][4][2], int gi, int wr, int fr) const {
        const PG8_LAS float* t0 = tab + opaque((wr * 64 + fr) * 4 + gi);
#pragma unroll
        for (int ai = 0; ai < 2; ++ai)
#pragma unroll
            for (int m = 0; m < 4; ++m) {
                const float f = t0[(ai * HALF + m * 16) * 4];
#pragma unroll
                for (int bj = 0; bj < 2; ++bj)
#pragma unroll
                    for (int n = 0; n < 2; ++n) acc[ai][bj][m][n] = acc[ai][bj][m][n] * f;
            }
    }
};
struct EpiBf16 {
    static constexpr bool PERM = true;
    bf16_t* O; int ldc; int dt_tile; float* DT; const float* dt_bias;
    __device__ __forceinline__ void operator()(const f32x4 (&acc)[2][2][4][2], const Unit& u, int wr, int wc, int fr, int fq) const {
        const int row0 = u.pm * BM + wr * 64 + fr;
        if (u.pn == dt_tile) {
            if (wc == 0) {
#pragma unroll
                for (int n = 0; n < 2; ++n) { const f32x4 bv = *(const f32x4*)(dt_bias + 8 * fq + 4 * n);
#pragma unroll
                    for (int ai = 0; ai < 2; ++ai)
#pragma unroll
                        for (int m = 0; m < 4; ++m) { f32x4 v = acc[ai][0][m][n] + bv, o;
#pragma unroll
                            for (int i = 0; i < 4; ++i) o[i] = softplus_f(v[i]);
                            *(f32x4*)(DT + (unsigned)((row0 + ai * HALF + m * 16) * 32 + 8 * fq + 4 * n)) = o; } }
            }
            return;
        }
        const int col0 = u.pn * BM + wc * 32 + 8 * fq;
#pragma unroll
        for (int ai = 0; ai < 2; ++ai)
#pragma unroll
            for (int m = 0; m < 4; ++m) { bf16_t* rowp = O + (unsigned)((row0 + ai * HALF + m * 16) * ldc + col0);
#pragma unroll
                for (int bj = 0; bj < 2; ++bj) { const f32x4 v0 = acc[ai][bj][m][0], v1 = acc[ai][bj][m][1];
                    u32x4 w; w.x = cvt_pk_bf16(v0[0], v0[1]); w.y = cvt_pk_bf16(v0[2], v0[3]); w.z = cvt_pk_bf16(v1[0], v1[1]); w.w = cvt_pk_bf16(v1[2], v1[3]);
                    *(u32x4*)(rowp + bj * HALF) = w; } }
    }
};
struct EpiKV {
    static constexpr bool PERM = false;
    float* outK; float* outV; bf16_t* KB; bf16_t* VT;
    __device__ __forceinline__ void operator()(const f32x4 (&acc)[2][2][4][2], const Unit& u, int wr, int wc, int fr, int fq) const {
        const bool nat = u.pm >= 32;
        const int l = nat ? (u.pm - 32) >> 3 : u.pm >> 3, b = (nat ? u.pm - 32 : u.pn - 32) & 7, j = (nat ? u.pn : u.pm) & 7, h = j & 3;
        const bool wf = nat, wb = !(nat && j >= 4);
        const size_t boff = ((size_t)l * 2048 + b * 256) * D + h * 256;
        float* outp = (j >= 4 ? outV : outK) + boff;
        bf16_t* cp = nat ? KB + boff : VT + (size_t)((l * 8 + b) * 4 + h) * 65536;
        const int dl = wc * 32 + 4 * fq, rpitch = nat ? D : 256;
        int coff[2][2];
#pragma unroll
        for (int bj = 0; bj < 2; ++bj)
#pragma unroll
            for (int n = 0; n < 2; ++n) { const int kc = dl + bj * HALF + n * 16; coff[bj][n] = nat ? kc : ((kc & ~31) | (((kc >> 2) & 3) << 3) | (((kc >> 4) & 1) << 2)); }
#pragma unroll
        for (int ai = 0; ai < 2; ++ai)
#pragma unroll
            for (int m = 0; m < 4; ++m) {
                const int rowoff = (ai * HALF + wr * 64 + m * 16 + fr) * rpitch;
#pragma unroll
                for (int bj = 0; bj < 2; ++bj)
#pragma unroll
                    for (int n = 0; n < 2; ++n) {
                        const f32x4 v = acc[ai][bj][m][n];
                        const unsigned off = (unsigned)(rowoff + coff[bj][n]);
                        if (wf) *(f32x4*)(outp + off) = v;
                        if (wb) { u32x2 w; w.x = cvt_pk_bf16(v[0], v[1]); w.y = cvt_pk_bf16(v[2], v[3]); *(u32x2*)(cp + off) = w; }
                    }
            }
    }
};
constexpr int SLB_OFF = 131072 + 10240;
struct NoSlab { static constexpr bool ON = false; };
template <class E2> struct Slab { static constexpr bool ON = true; E2 e; };
template <class Epi, class Sched, bool ALIGN_EPI = false, bool SP2 = false, class SlabT = NoSlab>
__device__ __forceinline__ void gemm_phase(PG8_LAS unsigned char* lds, const Gemm g, const Sched& S, const Epi& E, int wave_, const SlabT& SL = SlabT{}) {
    static_assert(!SlabT::ON || SP2, "the slab rides in the SP2 schedule only");
    int tid_ = tid_now(wave_);
    const int tid = tid_, wid = __builtin_amdgcn_readfirstlane(tid >> 6), lane = tid & 63, wr = wid >> 2, wc = wid & 3, fr = lane & 15, fq = lane >> 4;
    const int K = g.K, nt = K / BK;
    unsigned voffA[2], voffB[2];
#pragma unroll
    for (int i = 0; i < 2; ++i) { int R, C; stage_rc(tid * 16 + i * 8192, R, C); const int Rb = Epi::PERM ? ((R & ~31) + perm32(R & 31)) : R;
        voffA[i] = (unsigned)(R * g.lda + C) * 2u; voffB[i] = (unsigned)(Rb * g.ldb + C) * 2u; }
    unsigned voffS = 0;
    if constexpr (SlabT::ON) { const int r = 2 * wid + (lane >> 5), p = lane & 31, c = (p >> 2) ^ (r & 7); voffS = (unsigned)(r * g.lda) * 2u + (unsigned)(c * 4 + (p & 3)) * 4u; }
    const int soff = (lane & 15) * 128, sq = lane >> 4, s7 = lane & 7;
    const size_t kstep = (size_t)(BK * 2);
    const size_t hstepA = (size_t)HALF * g.lda * 2, hstepB = (size_t)HALF * g.ldb * 2;
    const size_t tstepA = 2 * hstepA, tstepB = 2 * hstepB, akoffb = (size_t)g.akoff * 2;
    const unsigned ldsw = (unsigned)wid * 1024u;
    const int aoff = lds_byte(wr * 64 + fr, fq * 8), boff = lds_byte(wc * 32 + fr, fq * 8);
#define PG8_SA(b, h) (((b) * 2 + (h)) * HTB)
#define PG8_SB(b, h) ((4 + (b) * 2 + (h)) * HTB)
#define PG8_STAGE(bufoff, gbase, voff) do { _Pragma("unroll") for (int _i = 0; _i < 2; ++_i) \
        __builtin_amdgcn_global_load_lds((const unsigned*)((const char*)(gbase) + (voff)[_i]), (PG8_LAS unsigned*)(lds + (bufoff) + ldsw + _i * 8192), 16, 0, 0); } while (0)
#define PG8_LDA(dst, b, h) do { _Pragma("unroll") for (int m = 0; m < 4; ++m) _Pragma("unroll") for (int k = 0; k < 2; ++k) dst[m][k] = *(const PG8_LAS bf16x8*)(lds + PG8_SA(b, h) + aoff + m * 2048 + k * 1024); } while (0)
#define PG8_LDB(dst, b, h) do { _Pragma("unroll") for (int n = 0; n < 2; ++n) _Pragma("unroll") for (int k = 0; k < 2; ++k) dst[n][k] = *(const PG8_LAS bf16x8*)(lds + PG8_SB(b, h) + boff + n * 2048 + k * 1024); } while (0)
#define PG8_MMA(ai, bj, At, Bt) do { __builtin_amdgcn_s_setprio(1); _Pragma("unroll") for (int m = 0; m < 4; ++m) _Pragma("unroll") for (int n = 0; n < 2; ++n) _Pragma("unroll") for (int k = 0; k < 2; ++k) \
        acc[ai][bj][m][n] = __builtin_amdgcn_mfma_f32_16x16x32_bf16(Bt[n][k], At[m][k], acc[ai][bj][m][n], 0, 0, 0); __builtin_amdgcn_s_setprio(0); } while (0)
#define PG8_STAGE_S(b, gbase) do { if constexpr (SlabT::ON) __builtin_amdgcn_global_load_lds((const unsigned*)((const char*)(gbase) + voffS), (PG8_LAS unsigned*)(lds + SLB_OFF + (b) * 2048 + wid * 256), 4, 0, 0); } while (0)
#define PG8_LDS_S(b) do { if constexpr (SlabT::ON) { _Pragma("unroll") for (int k = 0; k < 2; ++k) SAf[k] = *(const PG8_LAS bf16x8*)(lds + SLB_OFF + (b) * 2048 + soff + (((4 * k + sq) ^ s7) << 4)); } } while (0)
#define PG8_MMA_S() do { if constexpr (SlabT::ON) { __builtin_amdgcn_s_setprio(1); if (wr == 0) { _Pragma("unroll") for (int n = 0; n < 2; ++n) _Pragma("unroll") for (int k = 0; k < 2; ++k) sacc[n] = __builtin_amdgcn_mfma_f32_16x16x32_bf16(B0[n][k], SAf[k], sacc[n], 0, 0, 0); } \
        else { _Pragma("unroll") for (int n = 0; n < 2; ++n) _Pragma("unroll") for (int k = 0; k < 2; ++k) sacc[n] = __builtin_amdgcn_mfma_f32_16x16x32_bf16(B1[n][k], SAf[k], sacc[n], 0, 0, 0); } __builtin_amdgcn_s_setprio(0); } } while (0)
#define PG8_WAIT_V8() do { if constexpr (SlabT::ON) asm volatile("s_waitcnt vmcnt(9)" ::: "memory"); else asm volatile("s_waitcnt vmcnt(8)" ::: "memory"); } while (0)
#define PG8_WAIT_V(n) asm volatile("s_waitcnt vmcnt(" #n ")" ::: "memory")
#define PG8_WAIT_L(n) asm volatile("s_waitcnt lgkmcnt(" #n ")" ::: "memory")
#define PG8_BAR __builtin_amdgcn_s_barrier()
#define PG8_SCHED __builtin_amdgcn_sched_barrier(0)
    Unit cur, nxt; int ui = 0;
    if (!S.next(0, cur)) return;
    f32x4 acc[2][2][4][2];
#pragma unroll
    for (int a = 0; a < 2; ++a)
#pragma unroll
        for (int b = 0; b < 2; ++b)
#pragma unroll
            for (int m = 0; m < 4; ++m)
#pragma unroll
                for (int n = 0; n < 2; ++n) acc[a][b][m][n] = (f32x4){0.f, 0.f, 0.f, 0.f};
    bf16x8 At[4][2], B0[2][2], B1[2][2];
    f32x4 sacc[2] = {{0.f, 0.f, 0.f, 0.f}, {0.f, 0.f, 0.f, 0.f}}; bf16x8 SAf[2];
    (void)sacc; (void)SAf; (void)soff; (void)sq; (void)s7; (void)voffS;
    const char* cA = (const char*)g.A + (size_t)cur.pm * tstepA + (size_t)cur.pn * akoffb; const char* cB = (const char*)g.Bt + (size_t)cur.pn * tstepB;
    const size_t sstep = (size_t)16 * g.lda * 2, sbase = (size_t)MP * g.lda * 2;
    const char* cS = (const char*)g.A + sbase + (size_t)cur.pm * sstep + (size_t)cur.pn * akoffb;
    if constexpr (SP2) {
        PG8_STAGE_S(0, cS);
        PG8_STAGE(PG8_SB(0, 0), cB, voffB); PG8_STAGE(PG8_SB(0, 1), cB + hstepB, voffB); PG8_STAGE(PG8_SA(0, 0), cA, voffA); PG8_STAGE(PG8_SA(0, 1), cA + hstepA, voffA);
        if (wr == 1) PG8_BAR;
        PG8_WAIT_V(2); PG8_BAR;
        PG8_STAGE_S(1, cS + kstep);
        PG8_STAGE(PG8_SB(1, 0), cB + kstep, voffB); PG8_STAGE(PG8_SA(1, 0), cA + kstep, voffA); PG8_STAGE(PG8_SB(1, 1), cB + hstepB + kstep, voffB);
        PG8_WAIT_V(6); PG8_BAR;
    } else {
        PG8_STAGE(PG8_SB(0, 0), cB, voffB); PG8_STAGE(PG8_SA(0, 0), cA, voffA); PG8_STAGE(PG8_SB(0, 1), cB + hstepB, voffB); PG8_STAGE(PG8_SA(0, 1), cA + hstepA, voffA);
        if (wr == 1) PG8_BAR;
        PG8_WAIT_V(4); PG8_BAR;
        PG8_STAGE(PG8_SB(1, 0), cB + kstep, voffB); PG8_STAGE(PG8_SA(1, 0), cA + kstep, voffA); PG8_STAGE(PG8_SB(1, 1), cB + hstepB + kstep, voffB);
        PG8_WAIT_V(6); PG8_BAR;
    }
    for (;;) {
        const bool has_next = S.next(ui + 1, nxt);
        const char* nA = has_next ? (const char*)g.A + (size_t)nxt.pm * tstepA + (size_t)nxt.pn * akoffb : cA; const char* nB = has_next ? (const char*)g.Bt + (size_t)nxt.pn * tstepB : cB;
        const char* nS = has_next ? (const char*)g.A + sbase + (size_t)nxt.pm * sstep + (size_t)nxt.pn * akoffb : cS;
        const int tspan = epi_groups<Epi>::value ? 8 : nt;
        for (int tg = 0; tg < nt; tg += tspan) {
        if constexpr (epi_groups<Epi>::value) { if (tg != 0) { const int lh = lane_now() & 15; E.rescale(acc, (tg >> 3) - 1, wr, lh); if constexpr (SlabT::ON) E.rescale_slab(sacc, (tg >> 3) - 1, lh); } }
        for (int t = tg; t < tg + tspan; t += 2) {
            const bool last = (t == nt - 2);
            const char* a1 = cA + (size_t)(t + 1) * kstep;
            const char* a2 = last ? nA : cA + (size_t)(t + 2) * kstep; const char* b2 = last ? nB : cB + (size_t)(t + 2) * kstep;
            const char* a3 = a2 + kstep; const char* b3 = b2 + kstep;
            const char* s2 = last ? nS : cS + (size_t)(t + 2) * kstep; const char* s3 = s2 + kstep; (void)s3;
            if constexpr (SP2) {
            PG8_LDB(B0, 0, 0); PG8_LDB(B1, 0, 1); PG8_SCHED; PG8_LDA(At, 0, 0); PG8_LDS_S(0); PG8_STAGE(PG8_SA(1, 1), a1 + hstepA, voffA);
            PG8_WAIT_V8(); PG8_WAIT_L(0); PG8_BAR; PG8_MMA(0, 0, At, B0); PG8_MMA(0, 1, At, B1); PG8_MMA_S(); PG8_BAR; PG8_SCHED;
            PG8_LDA(At, 0, 1); PG8_STAGE_S(0, s2); PG8_STAGE(PG8_SB(0, 0), b2, voffB); PG8_STAGE(PG8_SB(0, 1), b2 + hstepB, voffB); PG8_STAGE(PG8_SA(0, 0), a2, voffA);
            PG8_WAIT_V8(); PG8_WAIT_L(0); PG8_BAR; PG8_MMA(1, 0, At, B0); PG8_MMA(1, 1, At, B1); PG8_BAR; PG8_SCHED;
            PG8_LDB(B0, 1, 0); PG8_LDB(B1, 1, 1); PG8_SCHED; PG8_LDA(At, 1, 0); PG8_LDS_S(1); PG8_STAGE(PG8_SA(0, 1), a2 + hstepA, voffA);
            PG8_WAIT_V8(); PG8_WAIT_L(0); PG8_BAR; PG8_MMA(0, 0, At, B0); PG8_MMA(0, 1, At, B1); PG8_MMA_S(); PG8_BAR; PG8_SCHED;
            PG8_LDA(At, 1, 1); PG8_STAGE_S(1, s3); PG8_STAGE(PG8_SB(1, 0), b3, voffB); PG8_STAGE(PG8_SB(1, 1), b3 + hstepB, voffB); PG8_STAGE(PG8_SA(1, 0), a3, voffA);
            PG8_WAIT_V8(); PG8_WAIT_L(0); PG8_BAR; PG8_MMA(1, 0, At, B0); PG8_MMA(1, 1, At, B1); PG8_BAR; PG8_SCHED;
            } else {
            PG8_LDB(B0, 0, 0); PG8_SCHED; PG8_LDA(At, 0, 0); PG8_STAGE(PG8_SA(1, 1), a1 + hstepA, voffA);
            PG8_WAIT_L(8); PG8_BAR; PG8_WAIT_L(0); PG8_MMA(0, 0, At, B0); PG8_BAR; PG8_SCHED;
            PG8_LDB(B1, 0, 1); PG8_STAGE(PG8_SB(0, 0), b2, voffB);
            PG8_BAR; PG8_WAIT_L(0); PG8_MMA(0, 1, At, B1); PG8_BAR;
            PG8_LDA(At, 0, 1); PG8_STAGE(PG8_SA(0, 0), a2, voffA);
            PG8_BAR; PG8_WAIT_L(0); PG8_MMA(1, 0, At, B0); PG8_BAR; PG8_SCHED;
            PG8_STAGE(PG8_SB(0, 1), b2 + hstepB, voffB);
            PG8_WAIT_V(6); PG8_BAR; PG8_MMA(1, 1, At, B1); PG8_BAR;
            PG8_LDB(B0, 1, 0); PG8_SCHED; PG8_LDA(At, 1, 0); PG8_STAGE(PG8_SA(0, 1), a2 + hstepA, voffA);
            PG8_WAIT_L(8); PG8_BAR; PG8_WAIT_L(0); PG8_MMA(0, 0, At, B0); PG8_BAR; PG8_SCHED;
            PG8_LDB(B1, 1, 1); PG8_STAGE(PG8_SB(1, 0), b3, voffB);
            PG8_BAR; PG8_WAIT_L(0); PG8_MMA(0, 1, At, B1); PG8_BAR;
            PG8_LDA(At, 1, 1); PG8_STAGE(PG8_SA(1, 0), a3, voffA);
            PG8_BAR; PG8_WAIT_L(0); PG8_MMA(1, 0, At, B0); PG8_BAR; PG8_SCHED;
            PG8_STAGE(PG8_SB(1, 1), b3 + hstepB, voffB);
            PG8_WAIT_V(6); PG8_BAR; PG8_MMA(1, 1, At, B1); PG8_BAR;
            }
        }
        }
        if constexpr (ALIGN_EPI) { if (wr == 0) PG8_BAR; }
        const int le = lane_now();
        if constexpr (epi_groups<Epi>::value) E.rescale(acc, 3, wr, le & 15);
        E(acc, cur, wr, wc, le & 15, le >> 4);
        if constexpr (SlabT::ON) {
            if constexpr (epi_groups<Epi>::value) E.rescale_slab(sacc, 3, le & 15);
            const int srow = MP + 16 * cur.pm + (le & 15), scol = cur.pn * BM + wr * HALF + wc * 32 + (Epi::PERM ? 8 * (le >> 4) : 4 * (le >> 4));
#pragma unroll
            for (int n = 0; n < 2; ++n) { SL.e(srow, scol + (Epi::PERM ? 4 * n : 16 * n), sacc[n]); sacc[n] = (f32x4){0.f, 0.f, 0.f, 0.f}; }
        }
        if (!has_next) break;
#pragma unroll
        for (int a = 0; a < 2; ++a)
#pragma unroll
            for (int b = 0; b < 2; ++b)
#pragma unroll
                for (int m = 0; m < 4; ++m)
#pragma unroll
                    for (int n = 0; n < 2; ++n) acc[a][b][m][n] = (f32x4){0.f, 0.f, 0.f, 0.f};
        cur = nxt; cA = nA; cB = nB; ++ui;
        if constexpr (ALIGN_EPI) { if (wr == 1) PG8_BAR; }
    }
    PG8_WAIT_V(0);
    if constexpr (!ALIGN_EPI) { if (wr == 0) PG8_BAR; }
    PG8_BAR;
#undef PG8_SA
#undef PG8_SB
#undef PG8_STAGE
#undef PG8_LDA
#undef PG8_LDB
#undef PG8_MMA
#undef PG8_WAIT_V
#undef PG8_STAGE_S
#undef PG8_LDS_S
#undef PG8_MMA_S
#undef PG8_WAIT_V8
#undef PG8_WAIT_L
#undef PG8_BAR
#undef PG8_SCHED
}
}


constexpr int NWAVES = 8, NTHR = NWAVES * 64;
constexpr int RING_BYTES = 131072, MISC_OFF = RING_BYTES, LDS_BYTES = 147456;
#ifndef ONE_LAUNCH
#define ONE_LAUNCH 1
#endif

constexpr size_t al256(size_t x) { return (x + 255) & ~(size_t)255; }
constexpr size_t WS_CTL = 0, CTL_ZERO_BYTES = 1u << 20;
constexpr size_t SZ_WGU = (size_t)2 * FF * D * 2, SZ_WD = (size_t)D * FF * 2, SZ_WIN = (size_t)INP * D * 2, SZ_WOUT = (size_t)D * DI * 2, SZ_WSQ = (size_t)D * D * 2, SZ_WPOOL = (size_t)D * 256 * 2;
constexpr size_t WS_WGU = CTL_ZERO_BYTES;
constexpr size_t WS_WD = WS_WGU + 8 * SZ_WGU;
constexpr size_t WS_WIN = WS_WD + 8 * SZ_WD;
constexpr size_t WS_WOUT = WS_WIN + 2 * SZ_WIN;
constexpr size_t WS_WQ = WS_WOUT + 2 * SZ_WOUT;
constexpr size_t WS_WKV = WS_WQ + 4 * SZ_WSQ;
constexpr size_t WS_MN = WS_WKV + 8 * SZ_WSQ;
constexpr size_t WS_WO = WS_MN + 8 * SZ_WSQ;
constexpr size_t WS_WPOOL = WS_WO + 4 * SZ_WSQ;
constexpr size_t WS_X = al256(WS_WPOOL + 2 * SZ_WPOOL);
constexpr size_t WS_U = WS_X + (size_t)M * D * 4;
constexpr size_t WS_H = WS_U + (size_t)M * D * 2;
constexpr size_t WS_ZX = WS_H + (size_t)M * FF * 2;
constexpr size_t WS_DT = WS_ZX + (size_t)M * ZXP * 2;
constexpr size_t WS_SS = WS_DT + (size_t)M * 32 * 4;
constexpr size_t WS_V = WS_SS + (size_t)M * 32 * 4;
constexpr size_t WS_Q = WS_V + (size_t)M * DI * 2;
constexpr size_t WS_O = WS_Q + (size_t)M * D * 2;
constexpr size_t WS_R = WS_O + (size_t)M * D * 2;
constexpr size_t WS_KB = al256(WS_R + (size_t)M * 4);
constexpr size_t WS_VT = WS_KB + 4 * (size_t)2048 * D * 2;
constexpr size_t WS_XBC = WS_VT + 4 * (size_t)2048 * D * 2;
constexpr size_t WS_END = WS_XBC + (size_t)M * CONVD * 2;
constexpr int CW_BAR = 4096;

constexpr size_t OUT_Y = 0;
constexpr size_t OUT_SSM_P = (size_t)M * D;
constexpr size_t OUT_CONV_P = OUT_SSM_P + (size_t)2 * PB * NHEAD * HDIM * NST;
constexpr size_t OUT_POOL_P = OUT_CONV_P + (size_t)2 * PB * 3 * CONVD;
constexpr size_t OUT_MK = OUT_POOL_P + (size_t)2 * PB * 15 * D;
constexpr size_t OUT_MV = OUT_MK + (size_t)4 * PB * NMEM * D;
constexpr size_t OUT_SSM_S = OUT_MV + (size_t)4 * PB * NMEM * D;
constexpr size_t OUT_CONV_S = OUT_SSM_S + (size_t)2 * SB * NHEAD * HDIM * NST;
constexpr size_t OUT_POOL_S = OUT_CONV_S + (size_t)2 * SB * 3 * CONVD;
constexpr size_t OUT_END = OUT_POOL_S + (size_t)2 * SB * 15 * D;

#define XB_TMO      128
#define XB_XCNT(j)  (256  + 64 * (j))
#define XB_XSUB(j)  (1280 + 64 * (j))
#define XB_XGEN(j)  (2304 + 64 * (j))
#define XB_TOP      3328
#define XB_TOPGEN   3392
#define XCD_BAR_WORDS 3456
#define XB_SPIN_CAP (1u << 18)
__device__ __forceinline__ unsigned xb_ld(unsigned* p)              { return __hip_atomic_load(p, __ATOMIC_RELAXED, __HIP_MEMORY_SCOPE_AGENT); }
__device__ __forceinline__ unsigned xb_add(unsigned* p, unsigned v) { return __hip_atomic_fetch_add(p, v, __ATOMIC_RELAXED, __HIP_MEMORY_SCOPE_AGENT); }
__device__ __forceinline__ unsigned xb_xcc_id() { return (unsigned)__builtin_amdgcn_s_getreg((3 << 11) | 20) & 0xFu; }
#define XB_SPIN(cond, bar) do { unsigned _sp = 0; while (cond) { __builtin_amdgcn_s_sleep(1); \
    if ((++_sp & 255u) == 0u) { if (xb_ld(&(bar)[XB_TMO])) break; if (_sp > XB_SPIN_CAP) { atomicAdd(&(bar)[XB_TMO], 1u); break; } } } } while (0)
struct XcdBarrier { unsigned* bar; unsigned x; volatile LAS unsigned* st; int wave; };
__device__ __forceinline__ XcdBarrier xcd_barrier_post(unsigned* bar, volatile LAS unsigned* st, int wave) {
    XcdBarrier b; b.bar = bar; b.x = xb_xcc_id(); b.st = st; b.wave = wave;
    if (threadIdx.x == 0) (void)xb_add(&bar[XB_XCNT(b.x)], 1u);
    return b;
}
__device__ __forceinline__ void xcd_barrier_complete(unsigned* bar, unsigned x, unsigned& nloc, unsigned& nx) {
    const unsigned G = gridDim.x * gridDim.y * gridDim.z;
    unsigned sum, cnt, mine, sp = 0u;
    for (;;) {
        sum = 0u; cnt = 0u; mine = 0u;
#pragma unroll
        for (unsigned j = 0; j < 16; ++j) { const unsigned c = xb_ld(&bar[XB_XCNT(j)]); sum += c; cnt += (c > 0u) ? 1u : 0u; mine = (j == x) ? c : mine; }
        if (sum == G) break;
        __builtin_amdgcn_s_sleep(1);
        if ((++sp & 255u) == 0u) { if (xb_ld(&bar[XB_TMO])) break; if (sp > XB_SPIN_CAP) { atomicAdd(&bar[XB_TMO], 1u); break; } }
    }
    nloc = mine > 0u ? mine : 1u; nx = cnt > 0u ? cnt : 1u;
}
__device__ __forceinline__ void xcd_barrier(const XcdBarrier& b) {
    asm volatile("s_waitcnt vmcnt(0)" ::: "memory");
    __syncthreads();
    if (b.wave == 0 && lane_now() == 0) {
        unsigned* bar = b.bar;
        __builtin_amdgcn_s_waitcnt(0);
        unsigned nloc = b.st[0], nx = b.st[1];
        if (nloc == 0u) { xcd_barrier_complete(bar, b.x, nloc, nx); b.st[0] = nloc; b.st[1] = nx; }
        const unsigned old = xb_add(&bar[XB_XSUB(b.x)], 1u);
        const unsigned gen = old / nloc;
        if (old + 1u == (gen + 1u) * nloc) {
            __builtin_amdgcn_fence(__ATOMIC_RELEASE, "agent");
            asm volatile("s_waitcnt vmcnt(0)" ::: "memory");
            const unsigned og = xb_add(&bar[XB_TOP], 1u);
            const unsigned tg = og / nx;
            if (og + 1u == (tg + 1u) * nx) xb_add(&bar[XB_TOPGEN], 1u);
            else XB_SPIN(xb_ld(&bar[XB_TOPGEN]) == tg, bar);
            __builtin_amdgcn_fence(__ATOMIC_ACQUIRE, "agent");
            xb_add(&bar[XB_XGEN(b.x)], 1u);
            asm volatile("s_waitcnt vmcnt(0)" ::: "memory");
        } else {
            XB_SPIN(xb_ld(&bar[XB_XGEN(b.x)]) == gen, bar);
            __builtin_amdgcn_fence(__ATOMIC_ACQUIRE, "agent");
            asm volatile("s_waitcnt vmcnt(0)" ::: "memory");
        }
    }
    __syncthreads();
}

struct Args { const float* in[34]; float* out; unsigned char* ws; int ph_lo, ph_hi; };
enum { I_XP = 0, I_XS, I_MEM, I_CK, I_CV, I_SSM, I_SCONV, I_SPOOL, I_NF1, I_G1, I_U1, I_D1, I_NMIX, I_INW, I_CONVW, I_CONVB, I_DTB, I_ALOG, I_DSKIP, I_SNORM, I_OUTW,
       I_POOLW, I_POOLS, I_NCROSS, I_NMEM, I_WQ, I_WK, I_WV, I_WO, I_NF2, I_G2, I_U2, I_D2, I_NFIN };

struct Frame { LAS unsigned char* lds; unsigned char* ws; float* out; int tid, lane, wave, G, gw, ngw; };
__device__ __forceinline__ unsigned char* launder_u(unsigned char* p) { GAS unsigned char* g = (GAS unsigned char*)p; asm volatile("" : "+s"(g)); return (unsigned char*)g; }
__device__ __forceinline__ int launder_i(int x) { asm volatile("" : "+s"(x)); return x; }
__device__ __forceinline__ float* launder_f(float* p) { GAS float* g = (GAS float*)p; asm volatile("" : "+s"(g)); return (float*)g; }

__device__ __forceinline__ void transpose_item(const float* W, int ldw, int k0, int n0, bf16_t* WT, int ldt, int drow0, const float* ks, LAS float* scr, int lane) {
    { const int r8 = lane >> 3, c4 = lane & 7;
      f32x4 v[8];
#pragma unroll
      for (int i = 0; i < 8; ++i) v[i] = *(const f32x4*)(W + (size_t)(k0 + 8 * i + r8) * ldw + n0 + 4 * c4);
#pragma unroll
      for (int i = 0; i < 8; ++i) { const int kk = 8 * i + r8; f32x4 x = v[i]; if (ks) x = x * ks[k0 + kk];
          LAS float* d = scr + kk * 33 + 4 * c4; d[0] = x[0]; d[1] = x[1]; d[2] = x[2]; d[3] = x[3]; } }
    asm volatile("s_waitcnt lgkmcnt(0)" ::: "memory");
    const int c = lane & 7;
#pragma unroll
    for (int j = 0; j < 4; ++j) { const int n = (lane >> 3) + 8 * j; const LAS float* s = scr + (8 * c) * 33 + n;
        u32x4 o; o.x = pk2(s[0 * 33], s[1 * 33]); o.y = pk2(s[2 * 33], s[3 * 33]); o.z = pk2(s[4 * 33], s[5 * 33]); o.w = pk2(s[6 * 33], s[7 * 33]);
        *(u32x4*)(WT + (size_t)(drow0 + n) * ldt + k0 + 8 * c) = o; }
    asm volatile("s_waitcnt lgkmcnt(0)" ::: "memory");
}
__device__ __forceinline__ void p0_prologue(const Frame& F, const Args& a) {
    unsigned char* ws = F.ws;
    LAS float* scr = (LAS float*)(F.lds + F.wave * 16384);
    constexpr int I_GU = (D / 64) * (FF / 32), I_DN = (FF / 64) * (D / 32), I_IN = (D / 64) * (INW / 32), I_OUT = (DI / 64) * (D / 32), I_SQ = (D / 64) * (D / 32), I_PL = (256 / 64) * (256 / 32);
    constexpr int C0 = 16 * I_GU, C1 = C0 + 8 * I_DN, C2 = C1 + 2 * I_IN, C3 = C2 + 2 * I_OUT, C4 = C3 + 16 * I_SQ, C5 = C4 + 8 * I_PL;
    for (int it = F.gw; it < C5; it += F.ngw) {
        int r = it;
        if (r < C0) {
            const int q = r / I_GU, e = r % I_GU, which = q >> 2, layer = q & 3, kb = e / (FF / 32), nb = e % (FF / 32);
            const float* W = a.in[which == 0 ? I_G1 : which == 1 ? I_U1 : which == 2 ? I_G2 : I_U2] + (size_t)layer * D * FF;
            const int s = layer * 2 + (which >> 1), n0 = nb * 32, drow = (n0 >> 7) * 256 + (which & 1) * 128 + (n0 & 127);
            transpose_item(W, FF, kb * 64, n0, (bf16_t*)(ws + WS_WGU + (size_t)s * SZ_WGU), D, drow, nullptr, scr, F.lane);
        } else if (r < C1) {
            r -= C0; const int q = r / I_DN, e = r % I_DN, which = q >> 2, layer = q & 3, kb = e / (D / 32), nb = e % (D / 32);
            const float* W = a.in[which == 0 ? I_D1 : I_D2] + (size_t)layer * FF * D;
            transpose_item(W, D, kb * 64, nb * 32, (bf16_t*)(ws + WS_WD + (size_t)(layer * 2 + which) * SZ_WD), FF, nb * 32, nullptr, scr, F.lane);
        } else if (r < C2) {
            r -= C1; const int j = r / I_IN, e = r % I_IN, kb = e / (INW / 32), nb = e % (INW / 32);
            transpose_item(a.in[I_INW] + (size_t)j * D * INW, INW, kb * 64, nb * 32, (bf16_t*)(ws + WS_WIN + (size_t)j * SZ_WIN), D, nb * 32, nullptr, scr, F.lane);
        } else if (r < C3) {
            r -= C2; const int j = r / I_OUT, e = r % I_OUT, kb = e / (D / 32), nb = e % (D / 32);
            transpose_item(a.in[I_OUTW] + (size_t)j * DI * D, D, kb * 64, nb * 32, (bf16_t*)(ws + WS_WOUT + (size_t)j * SZ_WOUT), DI, nb * 32, a.in[I_SNORM] + j * DI, scr, F.lane);
        } else if (r < C4) {
            r -= C3; const int q = r / I_SQ, e = r % I_SQ, which = q >> 2, layer = q & 3, kb = e / (D / 32), nb = e % (D / 32);
            const float* W = a.in[which == 0 ? I_WQ : which == 1 ? I_WK : which == 2 ? I_WV : I_WO] + (size_t)layer * D * D;
            bf16_t* T = which == 0 ? (bf16_t*)(ws + WS_WQ + (size_t)layer * SZ_WSQ) : which == 3 ? (bf16_t*)(ws + WS_WO + (size_t)layer * SZ_WSQ)
                      : (bf16_t*)(ws + WS_WKV + (size_t)layer * 2 * SZ_WSQ + (which == 2 ? SZ_WSQ : 0));
            transpose_item(W, D, kb * 64, nb * 32, T, D, nb * 32, nullptr, scr, F.lane);
        } else {
            r -= C4; const int q = r / I_PL, e = r % I_PL, kb = e / 8, nb = e % 8;
            transpose_item(a.in[I_POOLW] + (size_t)q * 256 * 256, 256, kb * 64, nb * 32, (bf16_t*)(ws + WS_WPOOL) + (size_t)q * 256 * 256, 256, nb * 32, nullptr, scr, F.lane);
        }
    }
    for (int i = F.gw * 64 + F.lane; i < 2 * (INP - INW) * D / 8; i += F.ngw * 64) {
        const int j = i / ((INP - INW) * D / 8), e = i % ((INP - INW) * D / 8);
        *(u32x4*)((bf16_t*)(ws + WS_WIN + (size_t)j * SZ_WIN) + (size_t)INW * D + (size_t)e * 8) = (u32x4){0u, 0u, 0u, 0u};
    }
    for (int m = F.gw; m < PB * NMEM; m += F.ngw) {
        const f32x4* xr = (const f32x4*)(a.in[I_MEM] + (size_t)m * D) + F.lane;
        f32x4 v[4]; float s = 0.f;
#pragma unroll
        for (int j = 0; j < 4; ++j) { v[j] = xr[64 * j]; s += (v[j].x * v[j].x + v[j].y * v[j].y) + (v[j].z * v[j].z + v[j].w * v[j].w); }
        const float rstd = 1.f / sqrtf(wave_sum(s) * (1.f / D) + EPS);
#pragma unroll
        for (int i = 0; i < 4; ++i) {
            const f32x4* gr = (const f32x4*)(a.in[I_NMEM] + i * D) + F.lane;
            u32x2* o = (u32x2*)((bf16_t*)(ws + WS_MN) + ((size_t)i * 2048 + m) * D) + F.lane;
#pragma unroll
            for (int j = 0; j < 4; ++j) { const f32x4 g = gr[64 * j]; u32x2 w; w.x = pk2(v[j].x * rstd * g.x, v[j].y * rstd * g.y); w.y = pk2(v[j].z * rstd * g.z, v[j].w * rstd * g.w); o[64 * j] = w; }
        }
    }
}

template <bool FINAL, bool WU = true> __device__ __forceinline__ void norm_phase(const Frame& F, const float* sp, const float* ss, const float* gain, bf16_t* U, float* R, float* outf) {
    f32x4 g[4];
#pragma unroll
    for (int j = 0; j < 4; ++j) g[j] = ((const f32x4*)gain)[F.lane + 64 * j];
    for (int m0 = F.gw; m0 < M; m0 += 3 * F.ngw) {
        f32x4 v[3][4]; float s[3];
#pragma unroll
        for (int q = 0; q < 3; ++q) {
            const int m = m0 + q * F.ngw, mc = m < M ? m : m0;
            const float* xrow = mc < MP ? sp + (size_t)mc * D : ss + (size_t)(mc - MP) * D;
            const f32x4* xr = (const f32x4*)xrow + F.lane;
#pragma unroll
            for (int j = 0; j < 4; ++j) v[q][j] = xr[64 * j];
        }
#pragma unroll
        for (int q = 0; q < 3; ++q) { float t = 0.f;
#pragma unroll
            for (int j = 0; j < 4; ++j) t += (v[q][j].x * v[q][j].x + v[q][j].y * v[q][j].y) + (v[q][j].z * v[q][j].z + v[q][j].w * v[q][j].w);
            s[q] = t; }
#pragma unroll
        for (int o = 1; o < 64; o <<= 1) {
#pragma unroll
            for (int q = 0; q < 3; ++q) s[q] += shx(s[q], o);
        }
#pragma unroll
        for (int q = 0; q < 3; ++q) {
            const int m = m0 + q * F.ngw;
            if (m < M) {
                const float rstd = 1.f / sqrtf(s[q] * (1.f / D) + EPS);
                if constexpr (FINAL) {
                    f32x4* o = (f32x4*)(outf + (size_t)m * D) + F.lane;
#pragma unroll
                    for (int j = 0; j < 4; ++j) o[64 * j] = v[q][j] * rstd * g[j];
                } else {
                    u32x2* o = (u32x2*)(U + (size_t)m * D) + F.lane;
#pragma unroll
                    for (int j = 0; j < 4; ++j) if constexpr (WU) { u32x2 w; w.x = pk2(v[q][j].x * rstd * g[j].x, v[q][j].y * rstd * g[j].y); w.y = pk2(v[q][j].z * rstd * g[j].z, v[q][j].w * rstd * g[j].w); o[64 * j] = w; }
                    if (F.lane == 0) R[m] = rstd;
                }
            }
        }
    }
}

template <int W> __device__ __forceinline__ void pool_prompt_unit(const float* X, const float* R, const f32x4 g4, bf16_t* MIX, float* outp, int rb, int c, int vz) {
    const int row0 = rb * 32, b = row0 >> 11, t0 = row0 & 2047;
    f32x4 s = {0.f, 0.f, 0.f, 0.f};
#pragma unroll
    for (int j = 1; j < W; ++j) {
        const bool valid = t0 - j >= 0; const int rx = valid ? row0 - j : row0;
        const f32x4 x = *(const f32x4*)(X + (size_t)rx * D + c); const float r = R[rx + vz];
        s = s + x * (valid ? r : 0.f);
    }
#pragma unroll 1
    for (int q0 = 0; q0 < 32; q0 += 8) {
        f32x4 xn[8], xo[8]; float rn[8], rr[8];
#pragma unroll
        for (int i = 0; i < 8; ++i) {
            const int row = row0 + q0 + i, t = t0 + q0 + i;
            const bool vo = t - (W - 1) >= 0; const int ro = vo ? row - (W - 1) : row;
            xn[i] = *(const f32x4*)(X + (size_t)row * D + c); rn[i] = R[row + vz];
            xo[i] = *(const f32x4*)(X + (size_t)ro * D + c); rr[i] = vo ? R[ro + vz] : 0.f;
        }
#pragma unroll
        for (int i = 0; i < 8; ++i) {
            const int row = row0 + q0 + i, t = t0 + q0 + i;
            const f32x4 un = xn[i] * rn[i];
            s = s + un;
            const float inv = (t + 1 < W) ? 1.0f / (float)(t + 1) : 1.0f / (float)W;
            const f32x4 mix = (s * inv - un) * g4;
            u32x2 o; o.x = pk2(mix.x, mix.y); o.y = pk2(mix.z, mix.w);
            *(u32x2*)(MIX + (size_t)row * D + c) = o;
            if (t >= PL - 15) *(f32x4*)(outp + ((size_t)b * 15 + (t - (PL - 15))) * D + c) = un * g4;
            s = s - xo[i] * rr[i];
        }
    }
}
template <int W> __device__ __forceinline__ void pool_sample_unit(const float* X, const float* R, const float* sp, const f32x4 g4, bf16_t* MIX, float* ob, int b, int c, int vz) {
    const int row0 = MP + 8 * b;
    f32x4 s = {0.f, 0.f, 0.f, 0.f};
#pragma unroll
    for (int j = 1; j < W; ++j) s = s + *(const f32x4*)(sp + (size_t)(15 - j) * D + c);
    f32x4 xn[8]; float rn[8];
#pragma unroll
    for (int t = 0; t < 8; ++t) { xn[t] = *(const f32x4*)(X + (size_t)(row0 + t) * D + c); rn[t] = R[row0 + t + vz]; }
    f32x4 old[8];
#pragma unroll
    for (int t = 0; t < 8; ++t) if (t < W - 1) old[t] = *(const f32x4*)(sp + (size_t)(16 + t - W) * D + c);
#pragma unroll
    for (int t = 0; t < 8; ++t) {
        const f32x4 un = xn[t] * rn[t] * g4;
        s = s + un;
        const f32x4 mix = s * (1.0f / (float)W) - un;
        u32x2 o; o.x = pk2(mix.x, mix.y); o.y = pk2(mix.z, mix.w);
        *(u32x2*)(MIX + (size_t)(row0 + t) * D + c) = o;
        *(f32x4*)(ob + (size_t)(7 + t) * D + c) = un;
        if (t < W - 1) s = s - old[t]; else s = s - xn[t - (W - 1) < 0 ? 0 : t - (W - 1)] * rn[t - (W - 1) < 0 ? 0 : t - (W - 1)] * g4;
    }
}
__device__ __forceinline__ void pool_phase(const Frame& F, const Args& a, int jl, int layer) {
    const float* X = (const float*)(F.ws + WS_X); const float* R = (const float*)(F.ws + WS_R);
    bf16_t* MIX = (bf16_t*)(F.ws + WS_Q);
    const float* gain = a.in[I_NMIX] + layer * D;
    const float* spool = a.in[I_SPOOL] + (size_t)jl * SB * 15 * D;
    float* outp = F.out + OUT_POOL_P + (size_t)jl * PB * 15 * D;
    float* outs = F.out + OUT_POOL_S + (size_t)jl * SB * 15 * D;
    const int vz = opaque(0);
    for (int wu = F.gw; wu < (MP / 32) * 4; wu += F.ngw) {
        const int g = wu & 3, rb = wu >> 2, c = 256 * g + 4 * F.lane;
        const f32x4 g4 = *(const f32x4*)(gain + c);
        if (g == 0) pool_prompt_unit<2>(X, R, g4, MIX, outp, rb, c, vz);
        else if (g == 1) pool_prompt_unit<4>(X, R, g4, MIX, outp, rb, c, vz);
        else if (g == 2) pool_prompt_unit<8>(X, R, g4, MIX, outp, rb, c, vz);
        else pool_prompt_unit<16>(X, R, g4, MIX, outp, rb, c, vz);
    }
    if ((F.gw & 3) == 0) for (int su = F.gw >> 2; su < SB * 4; su += F.ngw >> 2) {
        const int g = su & 3, b = su >> 2, c = 256 * g + 4 * F.lane;
        const f32x4 g4 = *(const f32x4*)(gain + c);
        const float* sp = spool + (size_t)b * 15 * D; float* ob = outs + (size_t)b * 15 * D;
        if (g == 0) pool_sample_unit<2>(X, R, sp, g4, MIX, ob, b, c, vz);
        else if (g == 1) pool_sample_unit<4>(X, R, sp, g4, MIX, ob, b, c, vz);
        else if (g == 2) pool_sample_unit<8>(X, R, sp, g4, MIX, ob, b, c, vz);
        else pool_sample_unit<16>(X, R, sp, g4, MIX, ob, b, c, vz);
    }
    for (int i = F.gw * 64 + F.lane; i < SB * 7 * (D / 4); i += F.ngw * 64) {
        const int c4 = i % (D / 4), rr = (i / (D / 4)) % 7, b = i / (7 * (D / 4));
        *(f32x4*)(outs + ((size_t)b * 15 + rr) * D + c4 * 4) = *(const f32x4*)(spool + ((size_t)b * 15 + 8 + rr) * D + c4 * 4);
    }
}

__device__ __forceinline__ void gnorm_phase(const Frame& F, const Args& a) {
    bf16_t* V = (bf16_t*)(F.ws + WS_V); const float* SS = (const float*)(F.ws + WS_SS);
    for (int m0 = F.gw; m0 < M; m0 += 3 * F.ngw) {
        f32x4 s0[3]; u32x4 w[3][4];
#pragma unroll
        for (int q = 0; q < 3; ++q) {
            const int m = m0 + q * F.ngw, mc = m < M ? m : m0;
            s0[q] = *(const f32x4*)(SS + (size_t)mc * 32 + (F.lane & 7) * 4);
#pragma unroll
            for (int j = 0; j < 4; ++j) w[q][j] = *((const u32x4*)(V + (size_t)mc * DI + 512 * j) + F.lane);
        }
#pragma unroll
        for (int q = 0; q < 3; ++q) {
            const int m = m0 + q * F.ngw;
            float sg = (s0[q].x + s0[q].y) + (s0[q].z + s0[q].w);
            sg += shx(sg, 1);
#pragma unroll
            for (int j = 0; j < 4; ++j) {
                const float tot = shi(sg, 2 * j);
                const float r = __builtin_amdgcn_rsqf(tot * (1.f / 512.f) + EPS);
                u32x4 o;
#pragma unroll
                for (int e = 0; e < 4; ++e) { const unsigned x = w[q][j][e]; o[e] = cvt_pk_bf16(bf2f(x & 0xffffu) * r, bf2f(x >> 16) * r); }
                if (m < M) *((u32x4*)(V + (size_t)m * DI + 512 * j) + F.lane) = o;
            }
        }
    }
}


constexpr int GTAB_OFF = MISC_OFF + 4096;
static_assert(pg8::SLB_OFF == MISC_OFF + 10240 && GTAB_OFF + 272 * 16 <= pg8::SLB_OFF && pg8::SLB_OFF + 4096 <= LDS_BYTES, "slab buffers sit beyond the group-norm table inside the misc LDS region");
__device__ __forceinline__ void gnorm_table(const Frame& F, int pm) {
    const float* SS = (const float*)(F.ws + WS_SS);
    LAS float* tab = (LAS float*)(F.lds + GTAB_OFF);
    if (F.tid < 272) {
        const int row = F.tid < 256 ? pm * 256 + F.tid : MP + 16 * pm + (F.tid - 256);
        f32x4 v[8];
#pragma unroll
        for (int i = 0; i < 8; ++i) v[i] = *(const f32x4*)(SS + (size_t)row * 32 + 4 * i);
        float r[4];
#pragma unroll
        for (int g = 0; g < 4; ++g) { const f32x4 t = v[2 * g] + v[2 * g + 1]; r[g] = __builtin_amdgcn_rsqf(((t.x + t.y) + (t.z + t.w)) * (1.f / 512.f) + EPS); }
        f32x4 o; o.x = r[0] / r[1]; o.y = r[1] / r[2]; o.z = r[2] / r[3]; o.w = r[3];
        *(LAS f32x4*)(tab + F.tid * 4) = o;
    }
    __syncthreads();
}
__device__ __forceinline__ bf16x8 lfrag(const LAS bf16_t* base, int row, int pitch, int k) { return *(const LAS bf16x8*)(base + row * pitch + k); }
__device__ __forceinline__ void wave_lds_sync() { asm volatile("s_waitcnt lgkmcnt(0)" ::: "memory"); __builtin_amdgcn_wave_barrier(); }
__device__ __forceinline__ bf16x8 pack8(f32x4 a, f32x4 b) { u32x4 w; w.x = cvt_pk_bf16(a[0], a[1]); w.y = cvt_pk_bf16(a[2], a[3]); w.z = cvt_pk_bf16(b[0], b[1]); w.w = cvt_pk_bf16(b[2], b[3]); return __builtin_bit_cast(bf16x8, w); }

__device__ __forceinline__ void lds_barrier() { asm volatile("s_waitcnt lgkmcnt(0)" ::: "memory"); __builtin_amdgcn_s_barrier(); asm volatile("" ::: "memory"); }
__device__ __forceinline__ float row16_sum(float v) {
    v += __builtin_bit_cast(float, __builtin_amdgcn_update_dpp(0, __builtin_bit_cast(int, v), 0x128, 0xf, 0xf, false));
    v += __builtin_bit_cast(float, __builtin_amdgcn_update_dpp(0, __builtin_bit_cast(int, v), 0x124, 0xf, 0xf, false));
    v += __builtin_bit_cast(float, __builtin_amdgcn_update_dpp(0, __builtin_bit_cast(int, v), 0x122, 0xf, 0xf, false));
    v += __builtin_bit_cast(float, __builtin_amdgcn_update_dpp(0, __builtin_bit_cast(int, v), 0x121, 0xf, 0xf, false));
    return v;
}

struct MiniRes {
    const float* src; float* X; float alpha; const float* scale;
    __device__ __forceinline__ void operator()(int row, int col, f32x4 v) const {
        const unsigned off = (unsigned)(row * D + col);
        f32x4 sc = scale ? *(const f32x4*)(scale + col) : (f32x4){1.f, 1.f, 1.f, 1.f};
        *(f32x4*)(X + off) = *(const f32x4*)(src + off) + v * (sc * alpha);
    }
};
struct MiniBf16 {
    bf16_t* O; int ldc;
    __device__ __forceinline__ void operator()(int row, int col, f32x4 v) const {
        u32x2 w; w.x = cvt_pk_bf16(v[0], v[1]); w.y = cvt_pk_bf16(v[2], v[3]);
        *(u32x2*)(O + (unsigned)(row * ldc + col)) = w;
    }
};
__device__ __forceinline__ void conv_phase(const Frame& F, const Args& a, int jl) {
    const bf16_t* ZX = (const bf16_t*)(F.ws + WS_ZX); bf16_t* XBC = (bf16_t*)(F.ws + WS_XBC);
    const float* cw = a.in[I_CONVW] + (size_t)jl * 4 * CONVD; const float* cb = a.in[I_CONVB] + (size_t)jl * CONVD;
    const int lane = F.lane;
    constexpr int RPU = (M * 6) / 2048;
    static_assert(RPU * 2048 == M * 6, "conv runs");
#define CONV_UNPACK(dst, raw) do { dst[0] = (f32x4){bf2f((raw).x & 0xffffu), bf2f((raw).x >> 16), bf2f((raw).y & 0xffffu), bf2f((raw).y >> 16)}; dst[1] = (f32x4){bf2f((raw).z & 0xffffu), bf2f((raw).z >> 16), bf2f((raw).w & 0xffffu), bf2f((raw).w >> 16)}; } while (0)
    for (int u = F.gw; u < 2048; u += F.ngw) {
        int slab = -1, ch = 0;
        f32x4 w[4][2], bv[2], x0[2], x1[2], x2[2];
#pragma unroll
        for (int e = 0; e < 2; ++e) { x0[e] = (f32x4){0.f, 0.f, 0.f, 0.f}; x1[e] = x0[e]; x2[e] = x0[e]; bv[e] = x0[e];
#pragma unroll
            for (int k = 0; k < 4; ++k) w[k][e] = x0[e]; }
#pragma unroll 1
        for (int r0 = 0; r0 < RPU; r0 += 8) {
            u32x4 rq[8];
#pragma unroll
            for (int q = 0; q < 8; ++q) { const int rc = (r0 + q < RPU) ? r0 + q : RPU - 1; const int idx = u * RPU + rc, sl = idx / M, row = idx - sl * M;
                rq[q] = *(const u32x4*)(ZX + (size_t)row * ZXP + DI + sl * 512 + 8 * lane); }
#pragma unroll
            for (int q = 0; q < 8; ++q) {
                const int r = r0 + q;
                if (r < RPU) {
                    const int idx = u * RPU + r, sl = idx / M, row = idx - sl * M;
                    const bool isS = row >= MP;
                    const int t = isS ? ((row - MP) & 7) : (row & (PL - 1));
                    if (sl != slab) {
                        slab = sl; ch = sl * 512 + 8 * lane;
#pragma unroll
                        for (int k = 0; k < 4; ++k) { w[k][0] = *(const f32x4*)(cw + k * CONVD + ch); w[k][1] = *(const f32x4*)(cw + k * CONVD + ch + 4); }
                        bv[0] = *(const f32x4*)(cb + ch); bv[1] = *(const f32x4*)(cb + ch + 4);
                    }
                    if (r == 0 || t == 0) {
                        const float* sc = a.in[I_SCONV] + (((size_t)jl * SB + (isS ? ((row - MP) >> 3) : 0)) * 3) * CONVD + ch;
#pragma unroll
                        for (int j = 1; j <= 3; ++j) {
                            f32x4 h[2];
                            if (t - j >= 0) { const u32x4 rw = *(const u32x4*)(ZX + (size_t)(row - j) * ZXP + DI + ch); CONV_UNPACK(h, rw); }
                            else if (isS) { h[0] = *(const f32x4*)(sc + (size_t)(3 + t - j) * CONVD); h[1] = *(const f32x4*)(sc + (size_t)(3 + t - j) * CONVD + 4); }
                            else { h[0] = (f32x4){0.f, 0.f, 0.f, 0.f}; h[1] = h[0]; }
                            if (j == 1) { x2[0] = h[0]; x2[1] = h[1]; } else if (j == 2) { x1[0] = h[0]; x1[1] = h[1]; } else { x0[0] = h[0]; x0[1] = h[1]; }
                        }
                    }
                    f32x4 x3[2]; CONV_UNPACK(x3, rq[q]);
                    u32x4 o;
                    {   f32x4 v0 = bv[0] + w[0][0] * x0[0] + w[1][0] * x1[0] + w[2][0] * x2[0] + w[3][0] * x3[0];
                        f32x4 v1 = bv[1] + w[0][1] * x0[1] + w[1][1] * x1[1] + w[2][1] * x2[1] + w[3][1] * x3[1];
                        o.x = cvt_pk_bf16(silu_f(v0[0]), silu_f(v0[1])); o.y = cvt_pk_bf16(silu_f(v0[2]), silu_f(v0[3]));
                        o.z = cvt_pk_bf16(silu_f(v1[0]), silu_f(v1[1])); o.w = cvt_pk_bf16(silu_f(v1[2]), silu_f(v1[3])); }
                    *(u32x4*)(XBC + (size_t)row * CONVD + ch) = o;
#pragma unroll
                    for (int e = 0; e < 2; ++e) { x0[e] = x1[e]; x1[e] = x2[e]; x2[e] = x3[e]; }
                }
            }
        }
    }
#undef CONV_UNPACK
}

constexpr int SC_CM = 0, SC_XD = 17408, SC_BM = 34816, SC_XW = 53248, SC_LM = 71680, SC_XS = 80896, SC_HS = 90112, SC_ZT = 107520, SC_VT = 116736, SC_F32 = 125952;
__device__ __forceinline__ void scan_prompt_unit(const Frame& F, const Args& a, int jl, int b, int h) {
    LAS unsigned char* L = F.lds;
    LAS bf16_t* CM = (LAS bf16_t*)(L + SC_CM); LAS bf16_t* BM = (LAS bf16_t*)(L + SC_BM);
    LAS bf16_t* XD = (LAS bf16_t*)(L + SC_XD); LAS bf16_t* XW = (LAS bf16_t*)(L + SC_XW); LAS bf16_t* LM = (LAS bf16_t*)(L + SC_LM);
    LAS bf16_t* XS = (LAS bf16_t*)(L + SC_XS); LAS bf16_t* HS = (LAS bf16_t*)(L + SC_HS);
    LAS bf16_t* ZT = (LAS bf16_t*)(L + SC_ZT); LAS bf16_t* VT = (LAS bf16_t*)(L + SC_VT);
    LAS float* FB = (LAS float*)(L + SC_F32);
    LAS float* SSP = FB + 2 * 256;
    const int g = h >> 3, tid = F.tid, lane = F.lane, w = F.wave, fr = lane & 15, fq = lane >> 4;
    const bf16_t* ZX = (const bf16_t*)(F.ws + WS_ZX); const bf16_t* XBC = (const bf16_t*)(F.ws + WS_XBC); const float* DT = (const float*)(F.ws + WS_DT);
    bf16_t* V = (bf16_t*)(F.ws + WS_V); float* SS = (float*)(F.ws + WS_SS);
    const float A_h = -__expf(a.in[I_ALOG][jl * 32 + h]), dsk = a.in[I_DSKIP][jl * 32 + h];
    const size_t row0 = (size_t)b * PL;
    for (int i = tid; i < 64 * 136 / 2; i += NTHR) ((LAS unsigned*)HS)[i] = 0u;
    f32x4 hacc[4];
#pragma unroll
    for (int j = 0; j < 4; ++j) hacc[j] = (f32x4){0.f, 0.f, 0.f, 0.f};
    const int qt = w >> 1, xh = w & 1;
    const unsigned trq4 = (unsigned)(fr >> 2), trp4 = (unsigned)(fr & 3);
    const unsigned trx = (unsigned)(size_t)L + (8u * fq + trq4) * 160u + 8u * trp4 + 64u * (unsigned)xh;
    const unsigned trw = (unsigned)(size_t)L + (8u * fq + trq4) * 160u + 8u * trp4 + 32u * (unsigned)qt;
    const unsigned trb = (unsigned)(size_t)L + (8u * fq + trq4) * 288u + 8u * trp4 + 128u * (unsigned)xh;
    u32x4 pre[5], prez; float predt;
    const int zr = tid >> 3, zo = tid & 7;
#define SCAN_CH(it_) ((it_) == 0 ? h * 64 + 8 * w : ((it_) < 3 ? DI + g * 128 + 8 * (w + 8 * ((it_) - 1)) : DI + 512 + g * 128 + 8 * (w + 8 * ((it_) - 3))))
#define SCAN_LOAD(c_) do { const size_t rb_ = row0 + (size_t)(c_) * 64; \
        _Pragma("unroll") for (int it = 0; it < 5; ++it) pre[it] = *(const u32x4*)(XBC + (rb_ + lane) * CONVD + SCAN_CH(it)); \
        prez = *(const u32x4*)(ZX + (rb_ + zr) * ZXP + h * 64 + 8 * zo); predt = DT[(rb_ + lane) * 32 + h]; } while (0)
#define SCAN_STEP0(c_) do { if (w == 0) { LAS float* fb_ = FB + ((c_) & 1) * 256; \
        const float dtv = predt; float x = A_h * dtv; \
        _Pragma("unroll") for (int o = 1; o < 64; o <<= 1) { const float y = shup(x, o); if (lane >= o) x += y; } \
        const float tot = shi(x, 63); fb_[lane] = x; fb_[64 + lane] = dtv; fb_[128 + lane] = __expf(tot - x); if (lane == 0) fb_[192] = __expf(tot); } } while (0)
    SCAN_LOAD(0);
    SCAN_STEP0(0);
    __syncthreads();
    for (int c = 0; c < PL / 64; ++c) {
        const int t0 = c * 64;
        LAS float* fb = FB + (c & 1) * 256;
        {   const int r = lane;
            {   const u32x4 pk = pre[0];
                *(LAS u32x4*)(XS + r * 72 + 8 * w) = pk;
                const float dtl = fb[64 + r], dte = fb[128 + r];
                u32x4 d4, w4;
#pragma unroll
                for (int e = 0; e < 4; ++e) { const float x0 = bf2f(pk[e] & 0xffffu) * dtl, x1 = bf2f(pk[e] >> 16) * dtl; d4[e] = cvt_pk_bf16(x0, x1); w4[e] = cvt_pk_bf16(x0 * dte, x1 * dte); }
                *(LAS u32x4*)(XD + r * 80 + 8 * w) = d4; *(LAS u32x4*)(XW + r * 80 + 8 * w) = w4; }
#pragma unroll
            for (int it = 1; it < 3; ++it) *(LAS u32x4*)(BM + r * 144 + 8 * (w + 8 * (it - 1))) = pre[it];
#pragma unroll
            for (int it = 3; it < 5; ++it) *(LAS u32x4*)(CM + r * 136 + 8 * (w + 8 * (it - 3))) = pre[it];
        }
        *(LAS u32x4*)(ZT + zr * 72 + 8 * zo) = prez;
        lds_barrier();
        { const int cn = (c + 1 < PL / 64) ? c + 1 : c; SCAN_LOAD(cn); }
        const float cdec = fb[192];
        f32x4 yoff[2];
#pragma unroll
        for (int x = 0; x < 2; ++x) {
            const int ct = 2 * xh + x;
            f32x4 c1 = {0.f, 0.f, 0.f, 0.f}, c3 = {0.f, 0.f, 0.f, 0.f};
#pragma unroll
            for (int ks = 0; ks < 4; ++ks) {
                const bf16x8 af = lfrag(CM, qt * 16 + fr, 136, ks * 32 + 8 * fq);
                const bf16x8 b1 = lfrag(BM, ct * 16 + fr, 144, ks * 32 + 8 * fq);
                const bf16x8 b3 = lfrag(HS, ct * 16 + fr, 136, ks * 32 + 8 * fq);
                c1 = __builtin_amdgcn_mfma_f32_16x16x32_bf16(af, b1, c1, 0, 0, 0);
                c3 = __builtin_amdgcn_mfma_f32_16x16x32_bf16(af, b3, c3, 0, 0, 0);
            }
            const int kk = ct * 16 + fr; const float ak = fb[kk];
#pragma unroll
            for (int r = 0; r < 4; ++r) {
                const int q = qt * 16 + 4 * fq + r; const float aq = fb[q];
                const float lv = (kk <= q) ? c1[r] * __expf(aq - ak) : 0.f;
                LM[q * 72 + kk] = (bf16_t)cvt_pk_bf16(lv, 0.f);
                yoff[x][r] = c3[r] * __expf(aq);
            }
        }
        lds_barrier();
        float ssq[4] = {0.f, 0.f, 0.f, 0.f};
        bf16x8 xdf[2][2];
        {   u32x2 r0, r1, r2, r3, r4, r5, r6, r7; const unsigned ad = trx + SC_XD;
            asm volatile("ds_read_b64_tr_b16 %0, %8\n\tds_read_b64_tr_b16 %1, %8 offset:640\n\tds_read_b64_tr_b16 %2, %8 offset:5120\n\tds_read_b64_tr_b16 %3, %8 offset:5760\n\t"
                         "ds_read_b64_tr_b16 %4, %8 offset:32\n\tds_read_b64_tr_b16 %5, %8 offset:672\n\tds_read_b64_tr_b16 %6, %8 offset:5152\n\tds_read_b64_tr_b16 %7, %8 offset:5792\n\ts_waitcnt lgkmcnt(0)"
                         : "=&v"(r0), "=&v"(r1), "=&v"(r2), "=&v"(r3), "=&v"(r4), "=&v"(r5), "=&v"(r6), "=&v"(r7) : "v"(ad) : "memory");
            xdf[0][0] = __builtin_bit_cast(bf16x8, (u32x4){r0.x, r0.y, r1.x, r1.y}); xdf[0][1] = __builtin_bit_cast(bf16x8, (u32x4){r2.x, r2.y, r3.x, r3.y});
            xdf[1][0] = __builtin_bit_cast(bf16x8, (u32x4){r4.x, r4.y, r5.x, r5.y}); xdf[1][1] = __builtin_bit_cast(bf16x8, (u32x4){r6.x, r6.y, r7.x, r7.y}); }
#pragma unroll
        for (int x = 0; x < 2; ++x) {
            const int pt = 2 * xh + x;
            f32x4 c2 = yoff[x];
#pragma unroll
            for (int ks = 0; ks < 2; ++ks)
                c2 = __builtin_amdgcn_mfma_f32_16x16x32_bf16(lfrag(LM, qt * 16 + fr, 72, ks * 32 + 8 * fq), xdf[x][ks], c2, 0, 0, 0);
            const int p = pt * 16 + fr;
#pragma unroll
            for (int r = 0; r < 4; ++r) {
                const int q = qt * 16 + 4 * fq + r;
                const float y = c2[r] + dsk * bf2f(XS[q * 72 + p]);
                const float vv = y * silu_f(bf2f(ZT[q * 72 + p]));
                VT[q * 72 + p] = (bf16_t)cvt_pk_bf16(vv, 0.f);
                ssq[r] += vv * vv;
            }
        }
#pragma unroll
        for (int r = 0; r < 4; ++r) { const float s = row16_sum(ssq[r]); if (fr == 0) SSP[xh * 64 + qt * 16 + 4 * fq + r] = s; }
        bf16x8 xwf[2], bmf[4][2];
        {   u32x2 r0, r1, r2, r3, r4, r5, r6, r7, r8, r9, r10, r11; const unsigned aw = trw + SC_XW, ab = trb + SC_BM;
            asm volatile("ds_read_b64_tr_b16 %0, %12\n\tds_read_b64_tr_b16 %1, %12 offset:640\n\tds_read_b64_tr_b16 %2, %12 offset:5120\n\tds_read_b64_tr_b16 %3, %12 offset:5760\n\t"
                         "ds_read_b64_tr_b16 %4, %13\n\tds_read_b64_tr_b16 %5, %13 offset:1152\n\tds_read_b64_tr_b16 %6, %13 offset:9216\n\tds_read_b64_tr_b16 %7, %13 offset:10368\n\t"
                         "ds_read_b64_tr_b16 %8, %13 offset:32\n\tds_read_b64_tr_b16 %9, %13 offset:1184\n\tds_read_b64_tr_b16 %10, %13 offset:9248\n\tds_read_b64_tr_b16 %11, %13 offset:10400\n\ts_waitcnt lgkmcnt(0)"
                         : "=&v"(r0), "=&v"(r1), "=&v"(r2), "=&v"(r3), "=&v"(r4), "=&v"(r5), "=&v"(r6), "=&v"(r7), "=&v"(r8), "=&v"(r9), "=&v"(r10), "=&v"(r11) : "v"(aw), "v"(ab) : "memory");
            xwf[0] = __builtin_bit_cast(bf16x8, (u32x4){r0.x, r0.y, r1.x, r1.y}); xwf[1] = __builtin_bit_cast(bf16x8, (u32x4){r2.x, r2.y, r3.x, r3.y});
            bmf[0][0] = __builtin_bit_cast(bf16x8, (u32x4){r4.x, r4.y, r5.x, r5.y}); bmf[0][1] = __builtin_bit_cast(bf16x8, (u32x4){r6.x, r6.y, r7.x, r7.y});
            bmf[1][0] = __builtin_bit_cast(bf16x8, (u32x4){r8.x, r8.y, r9.x, r9.y}); bmf[1][1] = __builtin_bit_cast(bf16x8, (u32x4){r10.x, r10.y, r11.x, r11.y}); }
        {   u32x2 r0, r1, r2, r3, r4, r5, r6, r7; const unsigned ab = trb + SC_BM;
            asm volatile("ds_read_b64_tr_b16 %0, %8 offset:64\n\tds_read_b64_tr_b16 %1, %8 offset:1216\n\tds_read_b64_tr_b16 %2, %8 offset:9280\n\tds_read_b64_tr_b16 %3, %8 offset:10432\n\t"
                         "ds_read_b64_tr_b16 %4, %8 offset:96\n\tds_read_b64_tr_b16 %5, %8 offset:1248\n\tds_read_b64_tr_b16 %6, %8 offset:9312\n\tds_read_b64_tr_b16 %7, %8 offset:10464\n\ts_waitcnt lgkmcnt(0)"
                         : "=&v"(r0), "=&v"(r1), "=&v"(r2), "=&v"(r3), "=&v"(r4), "=&v"(r5), "=&v"(r6), "=&v"(r7) : "v"(ab) : "memory");
            bmf[2][0] = __builtin_bit_cast(bf16x8, (u32x4){r0.x, r0.y, r1.x, r1.y}); bmf[2][1] = __builtin_bit_cast(bf16x8, (u32x4){r2.x, r2.y, r3.x, r3.y});
            bmf[3][0] = __builtin_bit_cast(bf16x8, (u32x4){r4.x, r4.y, r5.x, r5.y}); bmf[3][1] = __builtin_bit_cast(bf16x8, (u32x4){r6.x, r6.y, r7.x, r7.y}); }
#pragma unroll
        for (int j = 0; j < 4; ++j) {
            const int nt = 4 * xh + j;
            f32x4 acc = hacc[j] * cdec;
#pragma unroll
            for (int ks = 0; ks < 2; ++ks)
                acc = __builtin_amdgcn_mfma_f32_16x16x32_bf16(xwf[ks], bmf[j][ks], acc, 0, 0, 0);
            hacc[j] = acc;
#pragma unroll
            for (int r = 0; r < 4; ++r) HS[(qt * 16 + 4 * fq + r) * 136 + nt * 16 + fr] = (bf16_t)cvt_pk_bf16(acc[r], 0.f);
        }
        SCAN_STEP0(c + 1);
        lds_barrier();
        *(u32x4*)(V + (row0 + t0 + zr) * DI + h * 64 + 8 * zo) = *(const LAS u32x4*)(VT + zr * 72 + 8 * zo);
        if (tid < 64) SS[(row0 + t0 + tid) * 32 + h] = SSP[tid] + SSP[64 + tid];
    }
#undef SCAN_LOAD
#undef SCAN_CH
#undef SCAN_STEP0
    float* outS = F.out + OUT_SSM_P + (((size_t)jl * PB + b) * NHEAD + h) * HDIM * NST;
#pragma unroll
    for (int j = 0; j < 4; ++j)
#pragma unroll
        for (int r = 0; r < 4; ++r) outS[(qt * 16 + 4 * fq + r) * NST + (4 * xh + j) * 16 + fr] = hacc[j][r];
    __syncthreads();
}

__device__ __forceinline__ void scan_sample_unit(const Frame& F, const Args& a, int jl, int b, int h) {
    LAS float* S = (LAS float*)(F.lds + F.wave * 16384);
    LAS float* xsS = S; LAS float* bmS = S + 512; LAS float* cmS = bmS + 1056; LAS float* xdtS = cmS + 1056; LAS float* xdtwS = xdtS + 512; LAS float* LmS = xdtwS + 512; LAS float* acsS = LmS + 64;
    const int lane = F.lane, g = h >> 3;
    const bf16_t* ZX = (const bf16_t*)(F.ws + WS_ZX); const bf16_t* XBC = (const bf16_t*)(F.ws + WS_XBC); const float* DT = (const float*)(F.ws + WS_DT);
    bf16_t* V = (bf16_t*)(F.ws + WS_V); float* SS = (float*)(F.ws + WS_SS);
    const float A_h = -__expf(a.in[I_ALOG][jl * 32 + h]), dsk = a.in[I_DSKIP][jl * 32 + h];
    const size_t row0 = (size_t)MP + (size_t)b * SL;
    const size_t soff = ((((size_t)jl * SB + b) * NHEAD + h) * HDIM) * NST;
    const float* st = a.in[I_SSM] + soff; float* so = F.out + OUT_SSM_S + soff;
    const int pl = lane & 15, kq = lane >> 4, tq = lane & 7;
    f32x4 hc[4][8];
#pragma unroll
    for (int pt = 0; pt < 4; ++pt)
#pragma unroll
        for (int e = 0; e < 8; ++e) hc[pt][e] = *(const f32x4*)(st + (unsigned)((16 * pt + pl) * NST + 32 * (e >> 1) + 8 * kq + 4 * (e & 1)));
    float dtv[8], acs[8]; float run = 0.f;
    const int vz = opaque(0);
#pragma unroll
    for (int t = 0; t < 8; ++t) { dtv[t] = DT[(row0 + t) * 32 + h + vz]; run += A_h * dtv[t]; acs[t] = run; }
    const float tot = run, cdec = __expf(tot);
    { float v = acs[0];
#pragma unroll
      for (int t = 1; t < 8; ++t) v = (lane == t) ? acs[t] : v;
      if (lane < 8) acsS[lane] = v; }
#pragma unroll
    for (int it = 0; it < 10; ++it) {
        const int item = lane + 64 * it, t = item / 80, qd = item % 80;
        const int ch = qd < 16 ? h * 64 + 4 * qd : (qd < 48 ? DI + g * 128 + 4 * (qd - 16) : DI + 512 + g * 128 + 4 * (qd - 48));
        const u32x2 raw = *(const u32x2*)(XBC + (row0 + t) * CONVD + ch);
        LAS float* dst = qd < 16 ? xsS + t * 64 + 4 * qd : (qd < 48 ? bmS + t * 132 + 4 * (qd - 16) : cmS + t * 132 + 4 * (qd - 48));
        *(LAS f32x4*)dst = (f32x4){bf2f(raw.x & 0xffffu), bf2f(raw.x >> 16), bf2f(raw.y & 0xffffu), bf2f(raw.y >> 16)};
    }
    wave_lds_sync();
#pragma unroll
    for (int t = 0; t < 8; ++t) { const float xd = xsS[t * 64 + lane] * dtv[t]; xdtS[t * 64 + lane] = xd; xdtwS[t * 64 + lane] = xd * __expf(tot - acs[t]); }
    { const int t = lane >> 3, k = lane & 7; float s = 0.f;
#pragma unroll 8
      for (int n = 0; n < 128; n += 4) { const f32x4 c4 = *(const LAS f32x4*)(cmS + t * 132 + n), b4 = *(const LAS f32x4*)(bmS + k * 132 + n); s += (c4[0] * b4[0] + c4[1] * b4[1]) + (c4[2] * b4[2] + c4[3] * b4[3]); }
      LmS[lane] = (k <= t) ? s * __expf(acsS[t] - acsS[k]) : 0.f; }
    wave_lds_sync();
    bf16x8 cmF[4];
#pragma unroll
    for (int ks = 0; ks < 4; ++ks) cmF[ks] = pack8(*(const LAS f32x4*)(cmS + tq * 132 + 32 * ks + 8 * kq), *(const LAS f32x4*)(cmS + tq * 132 + 32 * ks + 8 * kq + 4));
    float Lrow[8];
#pragma unroll
    for (int k = 0; k < 8; ++k) Lrow[k] = LmS[tq * 8 + k];
    const float eacs = __expf(acsS[tq]);
    float ssacc = 0.f;
#pragma unroll
    for (int pt = 0; pt < 4; ++pt) {
        const int p = 16 * pt + pl;
        const int kqo = opaque(kq);
        float xw[8];
#pragma unroll
        for (int t = 0; t < 8; ++t) xw[t] = xdtwS[t * 64 + p];
        f32x4 yacc = {0.f, 0.f, 0.f, 0.f};
#pragma unroll
        for (int ks = 0; ks < 4; ++ks) {
            const f32x4 h0a = hc[pt][2 * ks], h0b = hc[pt][2 * ks + 1];
            yacc = __builtin_amdgcn_mfma_f32_16x16x32_bf16(pack8(h0a, h0b), cmF[ks], yacc, 0, 0, 0);
            f32x4 na = h0a * cdec, nb = h0b * cdec;
#pragma unroll
            for (int t = 0; t < 8; ++t) { na = na + *(const LAS f32x4*)(bmS + t * 132 + 32 * ks + 8 * kqo) * xw[t]; nb = nb + *(const LAS f32x4*)(bmS + t * 132 + 32 * ks + 8 * kqo + 4) * xw[t]; }
            *(f32x4*)(so + (unsigned)(p * NST + 32 * ks + 8 * kq)) = na; *(f32x4*)(so + (unsigned)(p * NST + 32 * ks + 8 * kq + 4)) = nb;
        }
#pragma unroll
        for (int r = 0; r < 4; ++r) {
            const int pp = 16 * pt + 4 * kq + r;
            float y = eacs * yacc[r] + dsk * xsS[tq * 64 + pp];
#pragma unroll
            for (int k = 0; k < 8; ++k) y += Lrow[k] * xdtS[k * 64 + pp];
            if (pl < 8) {
                const size_t grow = row0 + tq;
                const float z = bf2f(ZX[grow * ZXP + h * 64 + pp]);
                const float vv = y * silu_f(z);
                V[grow * DI + h * 64 + pp] = (bf16_t)f2bf(vv);
                ssacc += vv * vv;
            }
        }
        asm volatile("" ::: "memory");
    }
    ssacc += shx(ssacc, 16);
    ssacc += shx(ssacc, 32);
    if (lane < 8) SS[(row0 + lane) * 32 + h] = ssacc;
    wave_lds_sync();
}

__device__ __forceinline__ void scan_phase(const Frame& F, const Args& a, int jl) {
#ifndef REP_SP
#define REP_SP 1
#endif
#ifndef REP_SS
#define REP_SS 1
#endif
    for (int rep = 0; rep < REP_SP; ++rep)
    for (int u = blockIdx.x; u < PB * NHEAD; u += F.G) {
        const int x = u & 7, hi = (u >> 3) & 7, z = u >> 6, bg = x + 8 * z;
        scan_prompt_unit(F, a, jl, bg >> 2, (bg & 3) * 8 + hi);
    }
    for (int rep = 0; rep < REP_SS; ++rep)
    for (int u = F.gw; u < SB * NHEAD; u += F.ngw) scan_sample_unit(F, a, jl, u >> 5, u & 31);
    const bf16_t* ZX = (const bf16_t*)(F.ws + WS_ZX);
    for (int i = F.gw * 64 + F.lane; i < (PB + SB) * 3 * (CONVD / 4); i += F.ngw * 64) {
        const int c4 = i % (CONVD / 4), rr = (i / (CONVD / 4)) % 3, bb = i / (3 * (CONVD / 4));
        const size_t row = bb < PB ? (size_t)bb * PL + (PL - 3) + rr : (size_t)MP + (size_t)(bb - PB) * SL + (SL - 3) + rr;
        const u32x2 raw = *(const u32x2*)(ZX + row * ZXP + DI + c4 * 4);
        float* o = bb < PB ? F.out + OUT_CONV_P + (((size_t)jl * PB + bb) * 3 + rr) * CONVD + c4 * 4 : F.out + OUT_CONV_S + (((size_t)jl * SB + (bb - PB)) * 3 + rr) * CONVD + c4 * 4;
        *(f32x4*)o = (f32x4){bf2f(raw.x & 0xffffu), bf2f(raw.x >> 16), bf2f(raw.y & 0xffffu), bf2f(raw.y >> 16)};
    }
}

constexpr float ATT_C = 0.0625f * 1.4426950408889634f;
__device__ __forceinline__ void stage_256x256(LAS unsigned char* L, const bf16_t* src, int pitch, int tid) {
#pragma unroll 1
    for (int hseg = 0; hseg < 2; ++hseg) {
        u32x4 st[8];
#pragma unroll
        for (int i = 0; i < 8; ++i) { const int c = tid + NTHR * (i + 8 * hseg), row = c >> 5, ch = c & 31; st[i] = *(const u32x4*)(src + (unsigned)(row * pitch + ch * 8)); }
#pragma unroll
        for (int i = 0; i < 8; ++i) { const int c = tid + NTHR * (i + 8 * hseg), row = c >> 5, ch = c & 31; *(LAS u32x4*)(L + row * 512 + ((ch ^ (row & 15)) << 4)) = st[i]; }
    }
}
__device__ __forceinline__ void attn_prompt_wg(const Frame& F, const bf16_t* Qp, const bf16_t* Kp, const bf16_t* VTp, bf16_t* Op) {
    LAS unsigned char* L = F.lds;
    const int lane = opaque(F.lane), w = F.wave, tid = w * 64 + lane, fr = lane & 15, fq = lane >> 4;
    stage_256x256(L, Kp, D, tid);
    __syncthreads();
    bf16x8 pf[2][8];
#pragma unroll
    for (int qh = 0; qh < 2; ++qh) {
        const int qrow = qh * 128 + w * 16 + fr;
        bf16x8 qf[8];
#pragma unroll
        for (int ks = 0; ks < 8; ++ks) qf[ks] = *(const bf16x8*)(Qp + (unsigned)(qrow * D + ks * 32 + 8 * fq));
        f32x4 s[16];
#pragma unroll
        for (int kt = 0; kt < 16; ++kt) {
            f32x4 acc = {0.f, 0.f, 0.f, 0.f};
#pragma unroll
            for (int ks = 0; ks < 8; ++ks)
                acc = __builtin_amdgcn_mfma_f32_16x16x32_bf16(*(const LAS bf16x8*)(L + (kt * 16 + fr) * 512 + (((ks * 4 + fq) ^ fr) << 4)), qf[ks], acc, 0, 0, 0);
            s[kt] = acc;
            asm volatile("" ::: "memory");
        }
        float mx = -3.0e38f;
#pragma unroll
        for (int kt = 0; kt < 16; ++kt)
#pragma unroll
            for (int r = 0; r < 4; ++r) mx = fmaxf(mx, s[kt][r]);
        mx = fmaxf(mx, shx(mx, 16)); mx = fmaxf(mx, shx(mx, 32));
        float sum = 0.f;
#pragma unroll
        for (int kt = 0; kt < 16; ++kt)
#pragma unroll
            for (int r = 0; r < 4; ++r) { const float p = __builtin_amdgcn_exp2f((s[kt][r] - mx) * ATT_C); s[kt][r] = p; sum += p; }
        sum += shx(sum, 16); sum += shx(sum, 32);
        const float inv = 1.0f / sum;
#pragma unroll
        for (int k2 = 0; k2 < 8; ++k2) pf[qh][k2] = pack8(s[2 * k2] * inv, s[2 * k2 + 1] * inv);
        asm volatile("" ::: "memory");
    }
    __syncthreads();
    stage_256x256(L, VTp, 256, tid);
    __syncthreads();
    const int qrow0 = w * 16 + fr;
#pragma unroll 2
    for (int dt = 0; dt < 16; ++dt) {
        f32x4 o0 = {0.f, 0.f, 0.f, 0.f}, o1 = {0.f, 0.f, 0.f, 0.f};
#pragma unroll
        for (int k2 = 0; k2 < 8; ++k2) {
            const bf16x8 vf = *(const LAS bf16x8*)(L + (dt * 16 + fr) * 512 + (((k2 * 4 + fq) ^ fr) << 4));
            o0 = __builtin_amdgcn_mfma_f32_16x16x32_bf16(vf, pf[0][k2], o0, 0, 0, 0);
            o1 = __builtin_amdgcn_mfma_f32_16x16x32_bf16(vf, pf[1][k2], o1, 0, 0, 0);
        }
        u32x2 w0, w1; w0.x = cvt_pk_bf16(o0[0], o0[1]); w0.y = cvt_pk_bf16(o0[2], o0[3]); w1.x = cvt_pk_bf16(o1[0], o1[1]); w1.y = cvt_pk_bf16(o1[2], o1[3]);
        *(u32x2*)(Op + (unsigned)(qrow0 * D + dt * 16 + 4 * fq)) = w0;
        *(u32x2*)(Op + (unsigned)((qrow0 + 128) * D + dt * 16 + 4 * fq)) = w1;
        asm volatile("" ::: "memory");
    }
    __syncthreads();
}
constexpr int AS_STAT = MISC_OFF + 1024;
__device__ __forceinline__ void attn_sample_wg(const Frame& F, const bf16_t* Qp, const float* Kp, const float* Vp, bf16_t* Op) {
    LAS float* RED = (LAS float*)F.lds; LAS float* MXS = (LAS float*)(F.lds + AS_STAT); LAS float* SMS = MXS + 128;
    const int lane = F.lane, w = F.wave, fr = lane & 15, fq = lane >> 4;
    bf16x8 qf[8];
#pragma unroll
    for (int ks = 0; ks < 8; ++ks) qf[ks] = *(const bf16x8*)(Qp + (unsigned)((fr & 7) * D + ks * 32 + 8 * fq));
    f32x4 s[2];
#pragma unroll
    for (int x = 0; x < 2; ++x) {
        f32x4 acc = {0.f, 0.f, 0.f, 0.f};
        const float* kp = Kp + (unsigned)((w * 32 + x * 16 + fr) * D + 8 * fq);
#pragma unroll
        for (int ks = 0; ks < 8; ++ks) { const f32x4 k0 = *(const f32x4*)(kp + ks * 32), k1 = *(const f32x4*)(kp + ks * 32 + 4); acc = __builtin_amdgcn_mfma_f32_16x16x32_bf16(pack8(k0, k1), qf[ks], acc, 0, 0, 0); }
        s[x] = acc;
    }
#define AS_LOADV(dst_, db_) do { _Pragma("unroll") for (int j = 0; j < 8; ++j) { const int key = w * 32 + (j < 4 ? 4 * fq + j : 16 + 4 * fq + (j - 4)); dst_[j] = *(const f32x4*)(Vp + (unsigned)(key * D + (db_) * 64 + 4 * fr)); } } while (0)
#define AS_PROC(src_, db_) do { _Pragma("unroll") for (int i = 0; i < 4; ++i) { \
            u32x4 wv; wv.x = cvt_pk_bf16(src_[0][i], src_[1][i]); wv.y = cvt_pk_bf16(src_[2][i], src_[3][i]); wv.z = cvt_pk_bf16(src_[4][i], src_[5][i]); wv.w = cvt_pk_bf16(src_[6][i], src_[7][i]); \
            const f32x4 o = __builtin_amdgcn_mfma_f32_16x16x32_bf16(pf, __builtin_bit_cast(bf16x8, wv), (f32x4){0.f, 0.f, 0.f, 0.f}, 0, 0, 0); \
            *(LAS f32x4*)(RED + ((w * 16 + (db_) * 4 + i) * 64 + lane) * 4) = o; } } while (0)
    f32x4 va0[8], va1[8];
    AS_LOADV(va0, 0); AS_LOADV(va1, 1);
    float mx = fmaxf(fmaxf(fmaxf(s[0][0], s[0][1]), fmaxf(s[0][2], s[0][3])), fmaxf(fmaxf(s[1][0], s[1][1]), fmaxf(s[1][2], s[1][3])));
    mx = fmaxf(mx, shx(mx, 16)); mx = fmaxf(mx, shx(mx, 32));
    if (fq == 0) MXS[w * 16 + fr] = mx;
    lds_barrier();
    float gm = MXS[fr];
#pragma unroll
    for (int w2 = 1; w2 < 8; ++w2) gm = fmaxf(gm, MXS[w2 * 16 + fr]);
    float sum = 0.f;
#pragma unroll
    for (int x = 0; x < 2; ++x)
#pragma unroll
        for (int r = 0; r < 4; ++r) { const float p = __builtin_amdgcn_exp2f((s[x][r] - gm) * ATT_C); s[x][r] = p; sum += p; }
    sum += shx(sum, 16); sum += shx(sum, 32);
    if (fq == 0) SMS[w * 16 + fr] = sum;
    const bf16x8 pf = pack8(s[0], s[1]);
    {   f32x4 vb0[8], vb1[8];
        AS_LOADV(vb0, 2); AS_LOADV(vb1, 3);
        AS_PROC(va0, 0); AS_PROC(va1, 1); AS_PROC(vb0, 2); AS_PROC(vb1, 3);
    }
#undef AS_LOADV
#undef AS_PROC
    lds_barrier();
    {   const int db = w >> 1, i0 = 2 * (w & 1);
        f32x4 a0 = {0.f, 0.f, 0.f, 0.f}, a1 = {0.f, 0.f, 0.f, 0.f};
#pragma unroll
        for (int w2 = 0; w2 < 8; ++w2) { a0 = a0 + *(const LAS f32x4*)(RED + ((w2 * 16 + db * 4 + i0) * 64 + lane) * 4); a1 = a1 + *(const LAS f32x4*)(RED + ((w2 * 16 + db * 4 + i0 + 1) * 64 + lane) * 4); }
        if (fq < 2) {
#pragma unroll
            for (int r = 0; r < 4; ++r) {
                const int t = 4 * fq + r;
                float tot = 0.f;
#pragma unroll
                for (int w2 = 0; w2 < 8; ++w2) tot += SMS[w2 * 16 + t];
                const float inv = 1.0f / tot;
                *(unsigned*)(Op + (unsigned)(t * D + db * 64 + 4 * fr + i0)) = cvt_pk_bf16(a0[r] * inv, a1[r] * inv);
            }
        }
    }
    lds_barrier();
}
__device__ __forceinline__ void attn_phase(const Frame& F, const Args& a, int layer) {
    const bf16_t* Q = (const bf16_t*)(F.ws + WS_Q); bf16_t* O = (bf16_t*)(F.ws + WS_O);
    const bf16_t* KB = (const bf16_t*)(F.ws + WS_KB) + (size_t)layer * 2048 * D; const bf16_t* VT = (const bf16_t*)(F.ws + WS_VT) + (size_t)layer * 32 * 65536;
    const float* CK = a.in[I_CK] + (size_t)layer * SB * NMEM * D; const float* CV = a.in[I_CV] + (size_t)layer * SB * NMEM * D;
    for (int u = blockIdx.x; u < PB * 4 * (PL / 256); u += F.G) {
        const int x = u & 7, y = u >> 3, bh = x + 8 * (y >> 3), qb = y & 7, b = bh >> 2, h = bh & 3;
        const size_t row0 = (size_t)b * PL + qb * 256;
#ifndef NO_APW
        attn_prompt_wg(F, Q + row0 * D + h * 256, KB + (size_t)b * NMEM * D + h * 256, VT + (size_t)bh * 65536, O + row0 * D + h * 256);
#endif
    }
    Frame F2 = F; F2.tid = tid_now(F.wave); F2.lane = F2.tid & 63;
    for (int u = blockIdx.x; u < SB * 4; u += F.G) {
        const int b = u >> 2, h = u & 3; const size_t row0 = (size_t)MP + (size_t)b * SL;
#ifndef NO_ASW
        attn_sample_wg(F2, Q + row0 * D + h * 256, CK + (size_t)b * NMEM * D + h * 256, CV + (size_t)b * NMEM * D + h * 256, O + row0 * D + h * 256);
#endif
    }
}

constexpr int PH_PRO = 0, PH_KV = 1, PH_SEG0 = 2, PH_PER_SEG = 13, PH_FINAL = PH_SEG0 + 8 * PH_PER_SEG, PH_END = PH_FINAL + 1;
__global__ void __launch_bounds__(NTHR, 2) fwd(Args a) {
    extern __shared__ __attribute__((aligned(16))) unsigned char lds_raw[];
    Frame F;
    F.lds = (LAS unsigned char*)lds_raw;
    F.tid = threadIdx.x; F.lane = F.tid & 63; F.wave = __builtin_amdgcn_readfirstlane(F.tid >> 6);
    F.G = gridDim.x; F.gw = (int)blockIdx.x * NWAVES + F.wave; F.ngw = F.G * NWAVES;
    F.ws = a.ws; F.out = a.out;
    volatile LAS unsigned* MISC = (volatile LAS unsigned*)(F.lds + MISC_OFF);
    if (F.tid < 64) MISC[F.tid] = 0u;
    __syncthreads();
#if ONE_LAUNCH
    XcdBarrier bar = xcd_barrier_post((unsigned*)(a.ws + WS_CTL) + CW_BAR, MISC + 8, F.wave);
#define SEAM() xcd_barrier(bar)
#else
#define SEAM() do {} while (0)
#endif
#define PH(id) (a.ph_lo <= (id) && (id) < a.ph_hi)
#ifndef REP_SCAN
#define REP_SCAN 1
#endif
#ifndef REP_ATTN
#define REP_ATTN 1
#endif
#ifndef REP_NORM
#define REP_NORM 1
#endif
#ifndef REP_PRO
#define REP_PRO 1
#endif
#define REFRESH() do { F.tid = tid_now(F.wave); F.lane = F.tid & 63; F.ws = launder_u(a.ws); F.out = launder_f(a.out); F.gw = launder_i(F.gw); } while (0)
#define RELANE() do { F.tid = tid_now(F.wave); F.lane = F.tid & 63; } while (0)
#define WSB(off, T) ((T*)(F.ws + (off)))
#define XPTR WSB(WS_X, float)
#define SRC_P ((s == 0) ? a.in[I_XP] : (const float*)XPTR)
#define SRC_S ((s == 0) ? a.in[I_XS] : (const float*)XPTR + (size_t)MP * D)

#ifndef NO_PRO
    if (PH(PH_PRO)) for (int rep = 0; rep < REP_PRO; ++rep) { REFRESH(); p0_prologue(F, a); SEAM(); }
#endif
    const bool fill0 = (F.G == 256);
    if (PH(PH_KV)) {
        REFRESH();
        pg8::Gemm g{WSB(WS_WKV, const bf16_t), WSB(WS_WKV, const bf16_t), D, D, D, 0};
        pg8::KvOrder S{F.G, (int)blockIdx.x};
        pg8::EpiKV E{F.out + OUT_MK, F.out + OUT_MV, WSB(WS_KB, bf16_t), WSB(WS_VT, bf16_t)};
        pg8::gemm_phase<pg8::EpiKV, pg8::KvOrder, true, true>(F.lds, g, S, E, F.wave);
        if (fill0 && blockIdx.x >= 128) {
            RELANE(); Frame F2 = F; F2.gw = ((int)blockIdx.x - 128) * NWAVES + F.wave; F2.ngw = 128 * NWAVES;
            norm_phase<false>(F2, a.in[I_XP], a.in[I_XS], a.in[I_NF1], WSB(WS_U, bf16_t), WSB(WS_R, float), nullptr);
        }
        SEAM();
    }
#pragma unroll 1
    for (int s = 0; s < 8; ++s) {
        const int base = PH_SEG0 + s * PH_PER_SEG, layer = s >> 1, jl = layer >> 1;
        if (PH(base + 0) && !(fill0 && s == 0)) for (int rep = 0; rep < REP_NORM; ++rep) { REFRESH(); norm_phase<false>(F, SRC_P, SRC_S, a.in[(s & 1) ? I_NF2 : I_NF1] + layer * D, WSB(WS_U, bf16_t), WSB(WS_R, float), nullptr); SEAM(); }
#ifndef REP_GU
#define REP_GU 1
#endif
#ifndef REP_DOWN
#define REP_DOWN 1
#endif
        if (PH(base + 1)) for (int rep = 0; rep < REP_GU; ++rep) {
            REFRESH();
            pg8::Gemm g{WSB(WS_U, const bf16_t), WSB(WS_WGU + (size_t)s * SZ_WGU, const bf16_t), D, D, D, 0};
            pg8::StaticOrder S; S.init(M, 2 * FF, F.G, (int)blockIdx.x);
            pg8::EpiGU E{WSB(WS_H, bf16_t)};
            pg8::gemm_phase<pg8::EpiGU, pg8::StaticOrder, true, true>(F.lds, g, S, E, F.wave);
            SEAM();
        }
        if (PH(base + 2)) for (int rep = 0; rep < REP_DOWN; ++rep) {
            REFRESH(); const float alpha_ = (rep == REP_DOWN - 1) ? 0.5f : 0.0f;
            pg8::Gemm g{WSB(WS_H, const bf16_t), WSB(WS_WD + (size_t)s * SZ_WD, const bf16_t), FF, FF, FF, 0};
            pg8::StaticOrder S; S.init(MP, D, F.G, (int)blockIdx.x);
            pg8::EpiRes E{SRC_P, SRC_S, XPTR, alpha_, nullptr};
            pg8::Slab<MiniRes> SE{MiniRes{SRC_S - (size_t)MP * D, XPTR, alpha_, nullptr}};
            pg8::gemm_phase<pg8::EpiRes, pg8::StaticOrder, true, true, pg8::Slab<MiniRes>>(F.lds, g, S, E, F.wave, SE);
            SEAM();
        }
        if (s & 1) continue;
        if (PH(base + 3)) { REFRESH();
            if (layer & 1) norm_phase<false, false>(F, XPTR, XPTR + (size_t)MP * D, a.in[I_NMIX] + layer * D, WSB(WS_U, bf16_t), WSB(WS_R, float), nullptr);
            else norm_phase<false, true>(F, XPTR, XPTR + (size_t)MP * D, a.in[I_NMIX] + layer * D, WSB(WS_U, bf16_t), WSB(WS_R, float), nullptr);
            SEAM(); }
        if ((layer & 1) == 0) {
            if (PH(base + 4)) {
                REFRESH();
                pg8::Gemm g{WSB(WS_U, const bf16_t), WSB(WS_WIN + (size_t)jl * SZ_WIN, const bf16_t), D, D, D, 0};
                pg8::StaticOrder S; S.init(M, INP, F.G, (int)blockIdx.x);
                pg8::EpiBf16 E{WSB(WS_ZX, bf16_t), ZXP, ZXP / 256, WSB(WS_DT, float), a.in[I_DTB] + jl * 32};
                pg8::gemm_phase<pg8::EpiBf16, pg8::StaticOrder, true, true>(F.lds, g, S, E, F.wave);
                SEAM();
            }
#ifndef NO_SCAN
            if (PH(base + 12)) { REFRESH(); conv_phase(F, a, jl); SEAM(); }
            if (PH(base + 5)) for (int rep = 0; rep < REP_SCAN; ++rep) { REFRESH(); scan_phase(F, a, jl); SEAM(); }
#endif
            const bool gfold = (F.G == 256);
            if (PH(base + 6) && !gfold) { REFRESH(); gnorm_phase(F, a); SEAM(); }
            if (PH(base + 7)) {
                REFRESH();
                pg8::Gemm g{WSB(WS_V, const bf16_t), WSB(WS_WOUT + (size_t)jl * SZ_WOUT, const bf16_t), DI, DI, DI, 0};
                pg8::StaticOrder S; S.init(MP, D, F.G, (int)blockIdx.x);
                if (gfold) {
                    pg8::Unit u0; S.next(0, u0);
                    gnorm_table(F, u0.pm);
                    const LAS float* tab = (const LAS float*)(F.lds + GTAB_OFF);
                    pg8::EpiResG E{{XPTR, XPTR + (size_t)MP * D, XPTR, 1.0f, nullptr}, tab};
                    pg8::Slab<MiniRes> SE{MiniRes{XPTR, XPTR, 1.0f, nullptr}};
                    pg8::gemm_phase<pg8::EpiResG, pg8::StaticOrder, true, true, pg8::Slab<MiniRes>>(F.lds, g, S, E, F.wave, SE);
                } else {
                    pg8::EpiRes E{XPTR, XPTR + (size_t)MP * D, XPTR, 1.0f, nullptr};
                    pg8::Slab<MiniRes> SE{MiniRes{XPTR, XPTR, 1.0f, nullptr}};
                    pg8::gemm_phase<pg8::EpiRes, pg8::StaticOrder, true, true, pg8::Slab<MiniRes>>(F.lds, g, S, E, F.wave, SE);
                }
                SEAM();
            }
        } else {
#ifndef NO_POOL
            if (PH(base + 4)) { REFRESH(); pool_phase(F, a, jl, layer); SEAM(); }
#endif
            if (PH(base + 7)) {
                REFRESH();
                pg8::Gemm g{WSB(WS_Q, const bf16_t), WSB(WS_WPOOL + (size_t)jl * SZ_WPOOL, const bf16_t), 256, D, 256, 256};
                pg8::StaticOrder S; S.init(MP, D, F.G, (int)blockIdx.x);
                pg8::EpiRes E{XPTR, XPTR + (size_t)MP * D, XPTR, 1.0f, a.in[I_POOLS] + jl * D};
                pg8::Slab<MiniRes> SE{MiniRes{XPTR, XPTR, 1.0f, a.in[I_POOLS] + jl * D}};
                pg8::gemm_phase<pg8::EpiRes, pg8::StaticOrder, true, true, pg8::Slab<MiniRes>>(F.lds, g, S, E, F.wave, SE);
                SEAM();
            }
        }
        if (PH(base + 8)) for (int rep = 0; rep < REP_NORM; ++rep) { REFRESH(); norm_phase<false>(F, XPTR, XPTR + (size_t)MP * D, a.in[I_NCROSS] + layer * D, WSB(WS_U, bf16_t), WSB(WS_R, float), nullptr); SEAM(); }
        if (PH(base + 9)) {
            REFRESH();
            pg8::Gemm g{WSB(WS_U, const bf16_t), WSB(WS_WQ + (size_t)layer * SZ_WSQ, const bf16_t), D, D, D, 0};
            pg8::StaticOrder S; S.init(MP, D, F.G, (int)blockIdx.x);
            pg8::EpiBf16 E{WSB(WS_Q, bf16_t), D, -1, nullptr, nullptr};
            pg8::Slab<MiniBf16> SE{MiniBf16{WSB(WS_Q, bf16_t), D}};
            pg8::gemm_phase<pg8::EpiBf16, pg8::StaticOrder, true, true, pg8::Slab<MiniBf16>>(F.lds, g, S, E, F.wave, SE);
            SEAM();
        }
#ifndef NO_ATTN
        if (PH(base + 10)) for (int rep = 0; rep < REP_ATTN; ++rep) { REFRESH(); attn_phase(F, a, layer); SEAM(); }
#endif
        if (PH(base + 11)) {
            REFRESH();
            pg8::Gemm g{WSB(WS_O, const bf16_t), WSB(WS_WO + (size_t)layer * SZ_WSQ, const bf16_t), D, D, D, 0};
            pg8::StaticOrder S; S.init(MP, D, F.G, (int)blockIdx.x);
            pg8::EpiRes E{XPTR, XPTR + (size_t)MP * D, XPTR, 1.0f, nullptr};
            pg8::Slab<MiniRes> SE{MiniRes{XPTR, XPTR, 1.0f, nullptr}};
            pg8::gemm_phase<pg8::EpiRes, pg8::StaticOrder, true, true, pg8::Slab<MiniRes>>(F.lds, g, S, E, F.wave, SE);
            SEAM();
        }
    }
    if (PH(PH_FINAL)) { REFRESH(); norm_phase<true>(F, XPTR, XPTR + (size_t)MP * D, a.in[I_NFIN], nullptr, nullptr, F.out + OUT_Y); }
#undef PH
#undef SEAM
#undef REFRESH
#undef WSB
#undef XPTR
#undef SRC_P
#undef SRC_S
}

extern "C" void kernel_launch(void* const* d_in, const int* in_sizes, int n_in, void* d_out, int out_size, void* d_ws, size_t ws_size, hipStream_t stream) {
    static int grid = 0;
    if (grid == 0) {
        if (n_in != 34 || (size_t)out_size != OUT_END || ws_size < WS_END) { fprintf(stderr, "kernel_launch: unexpected shapes: n_in %d out %d (want %zu) ws %zu (want %zu)\n", n_in, out_size, (size_t)OUT_END, ws_size, (size_t)WS_END); grid = -1; return; }
        int dev = 0, cus = 0, per_cu = 0;
        if (hipGetDevice(&dev) != hipSuccess || hipDeviceGetAttribute(&cus, hipDeviceAttributeMultiprocessorCount, dev) != hipSuccess) { grid = -1; return; }
        if (hipFuncSetAttribute((const void*)fwd, hipFuncAttributeMaxDynamicSharedMemorySize, LDS_BYTES) != hipSuccess) { fprintf(stderr, "kernel_launch: hipFuncSetAttribute failed\n"); grid = -1; return; }
        if (hipOccupancyMaxActiveBlocksPerMultiprocessor(&per_cu, (const void*)fwd, NTHR, LDS_BYTES) != hipSuccess || per_cu < 1) { fprintf(stderr, "kernel_launch: occupancy query says %d\n", per_cu); }
        (void)hipGetLastError();
        grid = cus;
    }
    if (grid < 0) return;
    (void)hipMemsetAsync((char*)d_ws + WS_CTL, 0, CTL_ZERO_BYTES, stream);
    Args a{};
    for (int i = 0; i < 34; ++i) a.in[i] = (const float*)d_in[i];
    a.out = (float*)d_out; a.ws = (unsigned char*)d_ws;
#if ONE_LAUNCH
    a.ph_lo = 0; a.ph_hi = PH_END;
    hipLaunchKernelGGL(fwd, dim3(grid), dim3(NTHR), LDS_BYTES, stream, a);
#else
#ifndef PH_LIMIT
#define PH_LIMIT PH_END
#endif
    for (int id = 0; id < PH_END; ++id) {
        bool valid = false;
        if (id < PH_SEG0 || id == PH_FINAL) valid = true;
        else { const int s = (id - PH_SEG0) / PH_PER_SEG, k = (id - PH_SEG0) % PH_PER_SEG, layer = s >> 1;
               if (k <= 2) valid = true; else if (!(s & 1)) valid = (layer & 1) ? (k != 5 && k != 6 && k != 12) : true; }
        if (!valid) continue;
        if (id >= PH_LIMIT && id != PH_FINAL) continue;
        a.ph_lo = id; a.ph_hi = id + 1;
        hipLaunchKernelGGL(fwd, dim3(grid), dim3(NTHR), LDS_BYTES, stream, a);
    }
#endif
}
```

```cpp
#include <hip/hip_runtime.h>
#include <cstdio>
#include <cstdint>

#define GAS __attribute__((address_space(1)))
#define LAS __attribute__((address_space(3)))
typedef unsigned short bf16_t;
typedef short bf16x8 __attribute__((ext_vector_type(8)));
typedef float f32x4 __attribute__((ext_vector_type(4)));
typedef float f32x2 __attribute__((ext_vector_type(2)));
typedef unsigned u32x4 __attribute__((ext_vector_type(4)));
typedef unsigned u32x2 __attribute__((ext_vector_type(2)));

constexpr int D = 1024, FF = 2816, DI = 2048, CONVD = 3072, NHEAD = 32, HDIM = 64, NST = 128, NGRP = 4;
constexpr int INW = 5152, INP = 5376, ZXP = 5120;
constexpr int MP = 16384, MS = 1024, M = MP + MS;
constexpr int PB = 8, PL = 2048, SB = 128, SL = 8, NMEM = 256;
constexpr float EPS = 1e-5f;

__device__ __forceinline__ unsigned f2bf(float f) { unsigned u = __builtin_bit_cast(unsigned, f); return (u + 0x7fffu + ((u >> 16) & 1u)) >> 16; }
__device__ __forceinline__ float bf2f(unsigned h) { return __builtin_bit_cast(float, h << 16); }
__device__ __forceinline__ unsigned pk2(float lo, float hi) { return f2bf(lo) | (f2bf(hi) << 16); }
typedef __bf16 bf16x2_t __attribute__((ext_vector_type(2)));
__device__ __forceinline__ unsigned cvt_pk_bf16(float lo, float hi) { f32x2 v = {lo, hi}; bf16x2_t b = __builtin_convertvector(v, bf16x2_t); return __builtin_bit_cast(unsigned, b); }
__device__ __forceinline__ float fast_exp(float x) { return __builtin_amdgcn_exp2f(x * 1.4426950408889634f); }
__device__ __forceinline__ float silu_f(float x) { return x * __builtin_amdgcn_rcpf(1.0f + fast_exp(-x)); }
__device__ __forceinline__ float softplus_f(float x) { const float e = fast_exp(x); const float r = (x < -8.f) ? e : __builtin_amdgcn_logf(1.0f + e) * 0.6931471805599453f; return x > 20.f ? x : r; }
__device__ __forceinline__ int opaque(int x) { asm volatile("" : "+v"(x)); return x; }
__device__ __forceinline__ int lane_now() { int l; asm volatile("v_mbcnt_lo_u32_b32 %0, -1, 0\n\tv_mbcnt_hi_u32_b32 %0, -1, %0" : "=v"(l)); return l; }
__device__ __forceinline__ int tid_now(int wave) { return wave * 64 + lane_now(); }
__device__ __forceinline__ float shx(float v, int mask) { return __builtin_bit_cast(float, __builtin_amdgcn_ds_bpermute((lane_now() ^ mask) << 2, __builtin_bit_cast(int, v))); }
__device__ __forceinline__ float shi(float v, int src) { return __builtin_bit_cast(float, __builtin_amdgcn_ds_bpermute(src << 2, __builtin_bit_cast(int, v))); }
__device__ __forceinline__ float shup(float v, int o) { return __builtin_bit_cast(float, __builtin_amdgcn_ds_bpermute(((lane_now() - o) & 63) << 2, __builtin_bit_cast(int, v))); }
__device__ __forceinline__ float wave_sum(float v) {
#pragma unroll
    for (int o = 1; o < 64; o <<= 1) v += shx(v, o);
    return v;
}

namespace pg8 {
#define PG8_LAS __attribute__((address_space(3)))
constexpr int BM = 256, BK = 64, HALF = 128, HTB = HALF * BK * 2  , STAGE_BYTES = 8 * HTB, NXCD = 8, WGM = 8;

__host__ __device__ __forceinline__ int lds_byte(int r, int c) { const int st = (r >> 4) * 2 + (c >> 5), rr = r & 15, cc = c & 31, ob = rr * 64 + cc * 2; return st * 1024 + (ob ^ (((ob >> 9) & 1) << 5)); }
__host__ __device__ __forceinline__ void stage_rc(int b, int& R, int& C) { const int st = b / 1024, sb = b % 1024, swz = sb ^ (((sb >> 9) & 1) << 5); R = (st >> 1) * 16 + swz / 64; C = (st & 1) * 32 + (swz % 64) / 2; }
__host__ __device__ __forceinline__ int perm32(int rho) { const int n = rho >> 4, i = rho & 15; return 8 * (i >> 2) + 4 * n + (i & 3); }

struct Unit { int pm, pn; };
__host__ __device__ __forceinline__ int uni(int x) {
#if defined(__HIP_DEVICE_COMPILE__)
    x = __builtin_amdgcn_readfirstlane(x); asm volatile("" : "+s"(x)); return x;
#else
    return x;
#endif
}
struct Gemm { const bf16_t* A; const bf16_t* Bt; int K, lda, ldb, akoff; };

struct StaticOrder {
    int nM, nN, nwg, G, c;
    __host__ __device__ __forceinline__ void init(int M_, int N_, int G_, int c_) { nM = M_ / BM; nN = N_ / BM; nwg = nM * nN; G = G_; c = c_; }
    __host__ __device__ __forceinline__ bool next(int i, Unit& u) const {
        const long L = (long)i * G + c; if (L >= nwg) return false;
        int wgid = (int)L; { const int q = nwg / NXCD, r = nwg % NXCD, xcd = wgid % NXCD, off = wgid / NXCD; wgid = (xcd < r ? xcd * (q + 1) : r * (q + 1) + (xcd - r) * q) + off; }
        const int nig = WGM * nN, gid = wgid / nig, fm = gid * WGM, rem = wgid % nig;
        if (fm + WGM <= nM) { u.pm = uni(fm + rem % WGM); u.pn = uni(rem / WGM); }
        else { const int g2 = (nM % WGM) ? (nM % WGM) : 1; u.pm = uni(fm + rem % g2); u.pn = uni(rem / g2); }
        return true;
    }
};
struct KvOrder {
    int G, c;
    __host__ __device__ __forceinline__ bool next(int i, Unit& u) const {
        const int L = i * G + c; if (L >= 384) return false;
        const int l = L / 96, r = L % 96, b = r & 7, h = (r >> 3) & 3, ty = r >> 5;
        if (ty == 0) { u.pm = 32 + l * 8 + b; u.pn = l * 8 + h; } else if (ty == 1) { u.pm = 32 + l * 8 + b; u.pn = l * 8 + 4 + h; } else { u.pm = l * 8 + 4 + h; u.pn = 32 + l * 8 + b; }
        u.pm = uni(u.pm); u.pn = uni(u.pn);
        return true;
    }
};


struct EpiGU {
    static constexpr bool PERM = true;
    bf16_t* H;
    __device__ __forceinline__ void operator()(const f32x4 (&acc)[2][2][4][2], const Unit& u, int wr, int wc, int fr, int fq) const {
        const int row0 = u.pm * BM + wr * 64 + fr, col0 = u.pn * HALF + wc * 32 + 8 * fq;
#pragma unroll
        for (int ai = 0; ai < 2; ++ai)
#pragma unroll
            for (int m = 0; m < 4; ++m) {
                bf16_t* p = H + (unsigned)((row0 + ai * HALF + m * 16) * FF + col0);
                const f32x4 g0 = acc[ai][0][m][0], g1 = acc[ai][0][m][1], u0 = acc[ai][1][m][0], u1 = acc[ai][1][m][1];
                u32x4 w;
                w.x = cvt_pk_bf16(silu_f(g0[0]) * u0[0], silu_f(g0[1]) * u0[1]); w.y = cvt_pk_bf16(silu_f(g0[2]) * u0[2], silu_f(g0[3]) * u0[3]);
                w.z = cvt_pk_bf16(silu_f(g1[0]) * u1[0], silu_f(g1[1]) * u1[1]); w.w = cvt_pk_bf16(silu_f(g1[2]) * u1[2], silu_f(g1[3]) * u1[3]);
                *(u32x4*)p = w;
            }
    }
};
struct EpiRes {
    static constexpr bool PERM = false;
    const float* sp; const float* ss; float* X; float alpha; const float* scale;
    __device__ __forceinline__ void operator()(const f32x4 (&acc)[2][2][4][2], const Unit& u, int wr, int wc, int fr, int fq) const {
        const int row0 = u.pm * BM + wr * 64 + fr, col0 = u.pn * BM + wc * 32 + 4 * fq;
        const float* src = (u.pm < MP / BM) ? sp : (ss - (size_t)MP * D);
        f32x4 sc[2][2];
#pragma unroll
        for (int bj = 0; bj < 2; ++bj)
#pragma unroll
            for (int n = 0; n < 2; ++n) { sc[bj][n] = scale ? *(const f32x4*)(scale + col0 + bj * HALF + n * 16) : (f32x4){1.f, 1.f, 1.f, 1.f}; sc[bj][n] = sc[bj][n] * alpha; }
#pragma unroll
        for (int ai = 0; ai < 2; ++ai)
#pragma unroll
            for (int mp = 0; mp < 2; ++mp) {
                f32x4 v[2][2][2];
#pragma unroll
                for (int m2 = 0; m2 < 2; ++m2) { const unsigned off = (unsigned)((row0 + ai * HALF + (2 * mp + m2) * 16) * D + col0);
#pragma unroll
                    for (int bj = 0; bj < 2; ++bj)
#pragma unroll
                        for (int n = 0; n < 2; ++n) v[m2][bj][n] = *(const f32x4*)(src + (off + bj * HALF + n * 16)); }
#pragma unroll
                for (int m2 = 0; m2 < 2; ++m2) { const unsigned off = (unsigned)((row0 + ai * HALF + (2 * mp + m2) * 16) * D + col0);
#pragma unroll
                    for (int bj = 0; bj < 2; ++bj)
#pragma unroll
                        for (int n = 0; n < 2; ++n) *(f32x4*)(X + (off + bj * HALF + n * 16)) = v[m2][bj][n] + acc[ai][bj][2 * mp + m2][n] * sc[bj][n]; }
            }
    }
};
template <class T, class = void> struct epi_groups { static constexpr bool value = false; };
template <class T> struct epi_groups<T, decltype((void)T::GROUPS)> { static constexpr bool value = T::GROUPS; };
struct EpiResG : EpiRes {
    static constexpr bool GROUPS = true;
    const PG8_LAS float* tab;
    __device__ __forceinline__ void rescale_slab(f32x4 (&sa)[2], int gi, int fr) const { const float f = tab[(256 + fr) * 4 + gi]; sa[0] = sa[0] * f; sa[1] = sa[1] * f; }
    __device__ __forceinline__ void rescale(f32x4 (&acc)[2][2][4][2], int gi, int wr, int fr) const {
        const PG8_LAS float* t0 = tab + opaque((wr * 64 + fr) * 4 + gi);
#pragma unroll
        for (int ai = 0; ai < 2; ++ai)
#pragma unroll
            for (int m = 0; m < 4; ++m) {
                const float f = t0[(ai * HALF + m * 16) * 4];
#pragma unroll
                for (int bj = 0; bj < 2; ++bj)
#pragma unroll
                    for (int n = 0; n < 2; ++n) acc[ai][bj][m][n] = acc[ai][bj][m][n] * f;
            }
    }
};
struct EpiBf16 {
    static constexpr bool PERM = true;
    bf16_t* O; int ldc; int dt_tile; float* DT; const float* dt_bias;
    __device__ __forceinline__ void operator()(const f32x4 (&acc)[2][2][4][2], const Unit& u, int wr, int wc, int fr, int fq) const {
        const int row0 = u.pm * BM + wr * 64 + fr;
        if (u.pn == dt_tile) {
            if (wc == 0) {
#pragma unroll
                for (int n = 0; n < 2; ++n) { const f32x4 bv = *(const f32x4*)(dt_bias + 8 * fq + 4 * n);
#pragma unroll
                    for (int ai = 0; ai < 2; ++ai)
#pragma unroll
                        for (int m = 0; m < 4; ++m) { f32x4 v = acc[ai][0][m][n] + bv, o;
#pragma unroll
                            for (int i = 0; i < 4; ++i) o[i] = softplus_f(v[i]);
                            *(f32x4*)(DT + (unsigned)((row0 + ai * HALF + m * 16) * 32 + 8 * fq + 4 * n)) = o; } }
            }
            return;
        }
        const int col0 = u.pn * BM + wc * 32 + 8 * fq;
#pragma unroll
        for (int ai = 0; ai < 2; ++ai)
#pragma unroll
            for (int m = 0; m < 4; ++m) { bf16_t* rowp = O + (unsigned)((row0 + ai * HALF + m * 16) * ldc + col0);
#pragma unroll
                for (int bj = 0; bj < 2; ++bj) { const f32x4 v0 = acc[ai][bj][m][0], v1 = acc[ai][bj][m][1];
                    u32x4 w; w.x = cvt_pk_bf16(v0[0], v0[1]); w.y = cvt_pk_bf16(v0[2], v0[3]); w.z = cvt_pk_bf16(v1[0], v1[1]); w.w = cvt_pk_bf16(v1[2], v1[3]);
                    *(u32x4*)(rowp + bj * HALF) = w; } }
    }
};
struct EpiKV {
    static constexpr bool PERM = false;
    float* outK; float* outV; bf16_t* KB; bf16_t* VT;
    __device__ __forceinline__ void operator()(const f32x4 (&acc)[2][2][4][2], const Unit& u, int wr, int wc, int fr, int fq) const {
        const bool nat = u.pm >= 32;
        const int l = nat ? (u.pm - 32) >> 3 : u.pm >> 3, b = (nat ? u.pm - 32 : u.pn - 32) & 7, j = (nat ? u.pn : u.pm) & 7, h = j & 3;
        const bool wf = nat, wb = !(nat && j >= 4);
        const size_t boff = ((size_t)l * 2048 + b * 256) * D + h * 256;
        float* outp = (j >= 4 ? outV : outK) + boff;
        bf16_t* cp = nat ? KB + boff : VT + (size_t)((l * 8 + b) * 4 + h) * 65536;
        const int dl = wc * 32 + 4 * fq, rpitch = nat ? D : 256;
        int coff[2][2];
#pragma unroll
        for (int bj = 0; bj < 2; ++bj)
#pragma unroll
            for (int n = 0; n < 2; ++n) { const int kc = dl + bj * HALF + n * 16; coff[bj][n] = nat ? kc : ((kc & ~31) | (((kc >> 2) & 3) << 3) | (((kc >> 4) & 1) << 2)); }
#pragma unroll
        for (int ai = 0; ai < 2; ++ai)
#pragma unroll
            for (int m = 0; m < 4; ++m) {
                const int rowoff = (ai * HALF + wr * 64 + m * 16 + fr) * rpitch;
#pragma unroll
                for (int bj = 0; bj < 2; ++bj)
#pragma unroll
                    for (int n = 0; n < 2; ++n) {
                        const f32x4 v = acc[ai][bj][m][n];
                        const unsigned off = (unsigned)(rowoff + coff[bj][n]);
                        if (wf) *(f32x4*)(outp + off) = v;
                        if (wb) { u32x2 w; w.x = cvt_pk_bf16(v[0], v[1]); w.y = cvt_pk_bf16(v[2], v[3]); *(u32x2*)(cp + off) = w; }
                    }
            }
    }
};
constexpr int SLB_OFF = 131072 + 10240;
struct NoSlab { static constexpr bool ON = false; };
template <class E2> struct Slab { static constexpr bool ON = true; E2 e; };
template <class Epi, class Sched, bool ALIGN_EPI = false, bool SP2 = false, class SlabT = NoSlab>
__device__ __forceinline__ void gemm_phase(PG8_LAS unsigned char* lds, const Gemm g, const Sched& S, const Epi& E, int wave_, const SlabT& SL = SlabT{}) {
    static_assert(!SlabT::ON || SP2, "the slab rides in the SP2 schedule only");
    int tid_ = tid_now(wave_);
    const int tid = tid_, wid = __builtin_amdgcn_readfirstlane(tid >> 6), lane = tid & 63, wr = wid >> 2, wc = wid & 3, fr = lane & 15, fq = lane >> 4;
    const int K = g.K, nt = K / BK;
    unsigned voffA[2], voffB[2];
#pragma unroll
    for (int i = 0; i < 2; ++i) { int R, C; stage_rc(tid * 16 + i * 8192, R, C); const int Rb = Epi::PERM ? ((R & ~31) + perm32(R & 31)) : R;
        voffA[i] = (unsigned)(R * g.lda + C) * 2u; voffB[i] = (unsigned)(Rb * g.ldb + C) * 2u; }
    unsigned voffS = 0;
    if constexpr (SlabT::ON) { const int r = 2 * wid + (lane >> 5), p = lane & 31, c = (p >> 2) ^ (r & 7); voffS = (unsigned)(r * g.lda) * 2u + (unsigned)(c * 4 + (p & 3)) * 4u; }
    const int soff = (lane & 15) * 128, sq = lane >> 4, s7 = lane & 7;
    const size_t kstep = (size_t)(BK * 2);
    const size_t hstepA = (size_t)HALF * g.lda * 2, hstepB = (size_t)HALF * g.ldb * 2;
    const size_t tstepA = 2 * hstepA, tstepB = 2 * hstepB, akoffb = (size_t)g.akoff * 2;
    const unsigned ldsw = (unsigned)wid * 1024u;
    const int aoff = lds_byte(wr * 64 + fr, fq * 8), boff = lds_byte(wc * 32 + fr, fq * 8);
#define PG8_SA(b, h) (((b) * 2 + (h)) * HTB)
#define PG8_SB(b, h) ((4 + (b) * 2 + (h)) * HTB)
#define PG8_STAGE(bufoff, gbase, voff) do { _Pragma("unroll") for (int _i = 0; _i < 2; ++_i) \
        __builtin_amdgcn_global_load_lds((const unsigned*)((const char*)(gbase) + (voff)[_i]), (PG8_LAS unsigned*)(lds + (bufoff) + ldsw + _i * 8192), 16, 0, 0); } while (0)
#define PG8_LDA(dst, b, h) do { _Pragma("unroll") for (int m = 0; m < 4; ++m) _Pragma("unroll") for (int k = 0; k < 2; ++k) dst[m][k] = *(const PG8_LAS bf16x8*)(lds + PG8_SA(b, h) + aoff + m * 2048 + k * 1024); } while (0)
#define PG8_LDB(dst, b, h) do { _Pragma("unroll") for (int n = 0; n < 2; ++n) _Pragma("unroll") for (int k = 0; k < 2; ++k) dst[n][k] = *(const PG8_LAS bf16x8*)(lds + PG8_SB(b, h) + boff + n * 2048 + k * 1024); } while (0)
#define PG8_MMA(ai, bj, At, Bt) do { __builtin_amdgcn_s_setprio(1); _Pragma("unroll") for (int m = 0; m < 4; ++m) _Pragma("unroll") for (int n = 0; n < 2; ++n) _Pragma("unroll") for (int k = 0; k < 2; ++k) \
        acc[ai][bj][m][n] = __builtin_amdgcn_mfma_f32_16x16x32_bf16(Bt[n][k], At[m][k], acc[ai][bj][m][n], 0, 0, 0); __builtin_amdgcn_s_setprio(0); } while (0)
#define PG8_STAGE_S(b, gbase) do { if constexpr (SlabT::ON) __builtin_amdgcn_global_load_lds((const unsigned*)((const char*)(gbase) + voffS), (PG8_LAS unsigned*)(lds + SLB_OFF + (b) * 2048 + wid * 256), 4, 0, 0); } while (0)
#define PG8_LDS_S(b) do { if constexpr (SlabT::ON) { _Pragma("unroll") for (int k = 0; k < 2; ++k) SAf[k] = *(const PG8_LAS bf16x8*)(lds + SLB_OFF + (b) * 2048 + soff + (((4 * k + sq) ^ s7) << 4)); } } while (0)
#define PG8_MMA_S() do { if constexpr (SlabT::ON) { __builtin_amdgcn_s_setprio(1); if (wr == 0) { _Pragma("unroll") for (int n = 0; n < 2; ++n) _Pragma("unroll") for (int k = 0; k < 2; ++k) sacc[n] = __builtin_amdgcn_mfma_f32_16x16x32_bf16(B0[n][k], SAf[k], sacc[n], 0, 0, 0); } \
        else { _Pragma("unroll") for (int n = 0; n < 2; ++n) _Pragma("unroll") for (int k = 0; k < 2; ++k) sacc[n] = __builtin_amdgcn_mfma_f32_16x16x32_bf16(B1[n][k], SAf[k], sacc[n], 0, 0, 0); } __builtin_amdgcn_s_setprio(0); } } while (0)
#define PG8_WAIT_V8() do { if constexpr (SlabT::ON) asm volatile("s_waitcnt vmcnt(9)" ::: "memory"); else asm volatile("s_waitcnt vmcnt(8)" ::: "memory"); } while (0)
#define PG8_WAIT_V(n) asm volatile("s_waitcnt vmcnt(" #n ")" ::: "memory")
#define PG8_WAIT_L(n) asm volatile("s_waitcnt lgkmcnt(" #n ")" ::: "memory")
#define PG8_BAR __builtin_amdgcn_s_barrier()
#define PG8_SCHED __builtin_amdgcn_sched_barrier(0)
    Unit cur, nxt; int ui = 0;
    if (!S.next(0, cur)) return;
    f32x4 acc[2][2][4][2];
#pragma unroll
    for (int a = 0; a < 2; ++a)
#pragma unroll
        for (int b = 0; b < 2; ++b)
#pragma unroll
            for (int m = 0; m < 4; ++m)
#pragma unroll
                for (int n = 0; n < 2; ++n) acc[a][b][m][n] = (f32x4){0.f, 0.f, 0.f, 0.f};
    bf16x8 At[4][2], B0[2][2], B1[2][2];
    f32x4 sacc[2] = {{0.f, 0.f, 0.f, 0.f}, {0.f, 0.f, 0.f, 0.f}}; bf16x8 SAf[2];
    (void)sacc; (void)SAf; (void)soff; (void)sq; (void)s7; (void)voffS;
    const char* cA = (const char*)g.A + (size_t)cur.pm * tstepA + (size_t)cur.pn * akoffb; const char* cB = (const char*)g.Bt + (size_t)cur.pn * tstepB;
    const size_t sstep = (size_t)16 * g.lda * 2, sbase = (size_t)MP * g.lda * 2;
    const char* cS = (const char*)g.A + sbase + (size_t)cur.pm * sstep + (size_t)cur.pn * akoffb;
    if constexpr (SP2) {
        PG8_STAGE_S(0, cS);
        PG8_STAGE(PG8_SB(0, 0), cB, voffB); PG8_STAGE(PG8_SB(0, 1), cB + hstepB, voffB); PG8_STAGE(PG8_SA(0, 0), cA, voffA); PG8_STAGE(PG8_SA(0, 1), cA + hstepA, voffA);
        if (wr == 1) PG8_BAR;
        PG8_WAIT_V(2); PG8_BAR;
        PG8_STAGE_S(1, cS + kstep);
        PG8_STAGE(PG8_SB(1, 0), cB + kstep, voffB); PG8_STAGE(PG8_SA(1, 0), cA + kstep, voffA); PG8_STAGE(PG8_SB(1, 1), cB + hstepB + kstep, voffB);
        PG8_WAIT_V(6); PG8_BAR;
    } else {
        PG8_STAGE(PG8_SB(0, 0), cB, voffB); PG8_STAGE(PG8_SA(0, 0), cA, voffA); PG8_STAGE(PG8_SB(0, 1), cB + hstepB, voffB); PG8_STAGE(PG8_SA(0, 1), cA + hstepA, voffA);
        if (wr == 1) PG8_BAR;
        PG8_WAIT_V(4); PG8_BAR;
        PG8_STAGE(PG8_SB(1, 0), cB + kstep, voffB); PG8_STAGE(PG8_SA(1, 0), cA + kstep, voffA); PG8_STAGE(PG8_SB(1, 1), cB + hstepB + kstep, voffB);
        PG8_WAIT_V(6); PG8_BAR;
    }
    for (;;) {
        const bool has_next = S.next(ui + 1, nxt);
        const char* nA = has_next ? (const char*)g.A + (size_t)nxt.pm * tstepA + (size_t)nxt.pn * akoffb : cA; const char* nB = has_next ? (const char*)g.Bt + (size_t)nxt.pn * tstepB : cB;
        const char* nS = has_next ? (const char*)g.A + sbase + (size_t)nxt.pm * sstep + (size_t)nxt.pn * akoffb : cS;
        const int tspan = epi_groups<Epi>::value ? 8 : nt;
        for (int tg = 0; tg < nt; tg += tspan) {
        if constexpr (epi_groups<Epi>::value) { if (tg != 0) { const int lh = lane_now() & 15; E.rescale(acc, (tg >> 3) - 1, wr, lh); if constexpr (SlabT::ON) E.rescale_slab(sacc, (tg >> 3) - 1, lh); } }
        for (int t = tg; t < tg + tspan; t += 2) {
            const bool last = (t == nt - 2);
            const char* a1 = cA + (size_t)(t + 1) * kstep;
            const char* a2 = last ? nA : cA + (size_t)(t + 2) * kstep; const char* b2 = last ? nB : cB + (size_t)(t + 2) * kstep;
            const char* a3 = a2 + kstep; const char* b3 = b2 + kstep;
            const char* s2 = last ? nS : cS + (size_t)(t + 2) * kstep; const char* s3 = s2 + kstep; (void)s3;
            if constexpr (SP2) {
            PG8_LDB(B0, 0, 0); PG8_LDB(B1, 0, 1); PG8_SCHED; PG8_LDA(At, 0, 0); PG8_LDS_S(0); PG8_STAGE(PG8_SA(1, 1), a1 + hstepA, voffA);
            PG8_WAIT_V8(); PG8_WAIT_L(0); PG8_BAR; PG8_MMA(0, 0, At, B0); PG8_MMA(0, 1, At, B1); PG8_MMA_S(); PG8_BAR; PG8_SCHED;
            PG8_LDA(At, 0, 1); PG8_STAGE_S(0, s2); PG8_STAGE(PG8_SB(0, 0), b2, voffB); PG8_STAGE(PG8_SB(0, 1), b2 + hstepB, voffB); PG8_STAGE(PG8_SA(0, 0), a2, voffA);
            PG8_WAIT_V8(); PG8_WAIT_L(0); PG8_BAR; PG8_MMA(1, 0, At, B0); PG8_MMA(1, 1, At, B1); PG8_BAR; PG8_SCHED;
            PG8_LDB(B0, 1, 0); PG8_LDB(B1, 1, 1); PG8_SCHED; PG8_LDA(At, 1, 0); PG8_LDS_S(1); PG8_STAGE(PG8_SA(0, 1), a2 + hstepA, voffA);
            PG8_WAIT_V8(); PG8_WAIT_L(0); PG8_BAR; PG8_MMA(0, 0, At, B0); PG8_MMA(0, 1, At, B1); PG8_MMA_S(); PG8_BAR; PG8_SCHED;
            PG8_LDA(At, 1, 1); PG8_STAGE_S(1, s3); PG8_STAGE(PG8_SB(1, 0), b3, voffB); PG8_STAGE(PG8_SB(1, 1), b3 + hstepB, voffB); PG8_STAGE(PG8_SA(1, 0), a3, voffA);
            PG8_WAIT_V8(); PG8_WAIT_L(0); PG8_BAR; PG8_MMA(1, 0, At, B0); PG8_MMA(1, 1, At, B1); PG8_BAR; PG8_SCHED;
            } else {
            PG8_LDB(B0, 0, 0); PG8_SCHED; PG8_LDA(At, 0, 0); PG8_STAGE(PG8_SA(1, 1), a1 + hstepA, voffA);
            PG8_WAIT_L(8); PG8_BAR; PG8_WAIT_L(0); PG8_MMA(0, 0, At, B0); PG8_BAR; PG8_SCHED;
            PG8_LDB(B1, 0, 1); PG8_STAGE(PG8_SB(0, 0), b2, voffB);
            PG8_BAR; PG8_WAIT_L(0); PG8_MMA(0, 1, At, B1); PG8_BAR;
            PG8_LDA(At, 0, 1); PG8_STAGE(PG8_SA(0, 0), a2, voffA);
            PG8_BAR; PG8_WAIT_L(0); PG8_MMA(1, 0, At, B0); PG8_BAR; PG8_SCHED;
            PG8_STAGE(PG8_SB(0, 1), b2 + hstepB, voffB);
            PG8_WAIT_V(6); PG8_BAR; PG8_MMA(1, 1, At, B1); PG8_BAR;
            PG8_LDB(B0, 1, 0); PG8_SCHED; PG8_LDA(At, 1, 0); PG8_STAGE(PG8_SA(0, 1), a2 + hstepA, voffA);
            PG8_WAIT_L(8); PG8_BAR; PG8_WAIT_L(0); PG8_MMA(0, 0, At, B0); PG8_BAR; PG8_SCHED;
            PG8_LDB(B1, 1, 1); PG8_STAGE(PG8_SB(1, 0), b3, voffB);
            PG8_BAR; PG8_WAIT_L(0); PG8_MMA(0, 1, At, B1); PG8_BAR;
            PG8_LDA(At, 1, 1); PG8_STAGE(PG8_SA(1, 0), a3, voffA);
            PG8_BAR; PG8_WAIT_L(0); PG8_MMA(1, 0, At, B0); PG8_BAR; PG8_SCHED;
            PG8_STAGE(PG8_SB(1, 1), b3 + hstepB, voffB);
            PG8_WAIT_V(6); PG8_BAR; PG8_MMA(1, 1, At, B1); PG8_BAR;
            }
        }
        }
        if constexpr (ALIGN_EPI) { if (wr == 0) PG8_BAR; }
        const int le = lane_now();
        if constexpr (epi_groups<Epi>::value) E.rescale(acc, 3, wr, le & 15);
        E(acc, cur, wr, wc, le & 15, le >> 4);
        if constexpr (SlabT::ON) {
            if constexpr (epi_groups<Epi>::value) E.rescale_slab(sacc, 3, le & 15);
            const int srow = MP + 16 * cur.pm + (le & 15), scol = cur.pn * BM + wr * HALF + wc * 32 + (Epi::PERM ? 8 * (le >> 4) : 4 * (le >> 4));
#pragma unroll
            for (int n = 0; n < 2; ++n) { SL.e(srow, scol + (Epi::PERM ? 4 * n : 16 * n), sacc[n]); sacc[n] = (f32x4){0.f, 0.f, 0.f, 0.f}; }
        }
        if (!has_next) break;
#pragma unroll
        for (int a = 0; a < 2; ++a)
#pragma unroll
            for (int b = 0; b < 2; ++b)
#pragma unroll
                for (int m = 0; m < 4; ++m)
#pragma unroll
                    for (int n = 0; n < 2; ++n) acc[a][b][m][n] = (f32x4){0.f, 0.f, 0.f, 0.f};
        cur = nxt; cA = nA; cB = nB; ++ui;
        if constexpr (ALIGN_EPI) { if (wr == 1) PG8_BAR; }
    }
    PG8_WAIT_V(0);
    if constexpr (!ALIGN_EPI) { if (wr == 0) PG8_BAR; }
    PG8_BAR;
#undef PG8_SA
#undef PG8_SB
#undef PG8_STAGE
#undef PG8_LDA
#undef PG8_LDB
#undef PG8_MMA
#undef PG8_WAIT_V
#undef PG8_STAGE_S
#undef PG8_LDS_S
#undef PG8_MMA_S
#undef PG8_WAIT_V8
#undef PG8_WAIT_L
#undef PG8_BAR
#undef PG8_SCHED
}
}


constexpr int NWAVES = 8, NTHR = NWAVES * 64;
constexpr int RING_BYTES = 131072, MISC_OFF = RING_BYTES, LDS_BYTES = 147456;
#ifndef ONE_LAUNCH
#define ONE_LAUNCH 1
#endif

constexpr size_t al256(size_t x) { return (x + 255) & ~(size_t)255; }
constexpr size_t WS_CTL = 0, CTL_ZERO_BYTES = 1u << 20;
constexpr size_t SZ_WGU = (size_t)2 * FF * D * 2, SZ_WD = (size_t)D * FF * 2, SZ_WIN = (size_t)INP * D * 2, SZ_WOUT = (size_t)D * DI * 2, SZ_WSQ = (size_t)D * D * 2, SZ_WPOOL = (size_t)D * 256 * 2;
constexpr size_t WS_WGU = CTL_ZERO_BYTES;
constexpr size_t WS_WD = WS_WGU + 8 * SZ_WGU;
constexpr size_t WS_WIN = WS_WD + 8 * SZ_WD;
constexpr size_t WS_WOUT = WS_WIN + 2 * SZ_WIN;
constexpr size_t WS_WQ = WS_WOUT + 2 * SZ_WOUT;
constexpr size_t WS_WKV = WS_WQ + 4 * SZ_WSQ;
constexpr size_t WS_MN = WS_WKV + 8 * SZ_WSQ;
constexpr size_t WS_WO = WS_MN + 8 * SZ_WSQ;
constexpr size_t WS_WPOOL = WS_WO + 4 * SZ_WSQ;
constexpr size_t WS_X = al256(WS_WPOOL + 2 * SZ_WPOOL);
constexpr size_t WS_U = WS_X + (size_t)M * D * 4;
constexpr size_t WS_H = WS_U + (size_t)M * D * 2;
constexpr size_t WS_ZX = WS_H + (size_t)M * FF * 2;
constexpr size_t WS_DT = WS_ZX + (size_t)M * ZXP * 2;
constexpr size_t WS_SS = WS_DT + (size_t)M * 32 * 4;
constexpr size_t WS_V = WS_SS + (size_t)M * 32 * 4;
constexpr size_t WS_Q = WS_V + (size_t)M * DI * 2;
constexpr size_t WS_O = WS_Q + (size_t)M * D * 2;
constexpr size_t WS_R = WS_O + (size_t)M * D * 2;
constexpr size_t WS_KB = al256(WS_R + (size_t)M * 4);
constexpr size_t WS_VT = WS_KB + 4 * (size_t)2048 * D * 2;
constexpr size_t WS_XBC = WS_VT + 4 * (size_t)2048 * D * 2;
constexpr size_t WS_END = WS_XBC + (size_t)M * CONVD * 2;
constexpr int CW_BAR = 4096;

constexpr size_t OUT_Y = 0;
constexpr size_t OUT_SSM_P = (size_t)M * D;
constexpr size_t OUT_CONV_P = OUT_SSM_P + (size_t)2 * PB * NHEAD * HDIM * NST;
constexpr size_t OUT_POOL_P = OUT_CONV_P + (size_t)2 * PB * 3 * CONVD;
constexpr size_t OUT_MK = OUT_POOL_P + (size_t)2 * PB * 15 * D;
constexpr size_t OUT_MV = OUT_MK + (size_t)4 * PB * NMEM * D;
constexpr size_t OUT_SSM_S = OUT_MV + (size_t)4 * PB * NMEM * D;
constexpr size_t OUT_CONV_S = OUT_SSM_S + (size_t)2 * SB * NHEAD * HDIM * NST;
constexpr size_t OUT_POOL_S = OUT_CONV_S + (size_t)2 * SB * 3 * CONVD;
constexpr size_t OUT_END = OUT_POOL_S + (size_t)2 * SB * 15 * D;

#define XB_TMO      128
#define XB_XCNT(j)  (256  + 64 * (j))
#define XB_XSUB(j)  (1280 + 64 * (j))
#define XB_XGEN(j)  (2304 + 64 * (j))
#define XB_TOP      3328
#define XB_TOPGEN   3392
#define XCD_BAR_WORDS 3456
#define XB_SPIN_CAP (1u << 18)
__device__ __forceinline__ unsigned xb_ld(unsigned* p)              { return __hip_atomic_load(p, __ATOMIC_RELAXED, __HIP_MEMORY_SCOPE_AGENT); }
__device__ __forceinline__ unsigned xb_add(unsigned* p, unsigned v) { return __hip_atomic_fetch_add(p, v, __ATOMIC_RELAXED, __HIP_MEMORY_SCOPE_AGENT); }
__device__ __forceinline__ unsigned xb_xcc_id() { return (unsigned)__builtin_amdgcn_s_getreg((3 << 11) | 20) & 0xFu; }
#define XB_SPIN(cond, bar) do { unsigned _sp = 0; while (cond) { __builtin_amdgcn_s_sleep(1); \
    if ((++_sp & 255u) == 0u) { if (xb_ld(&(bar)[XB_TMO])) break; if (_sp > XB_SPIN_CAP) { atomicAdd(&(bar)[XB_TMO], 1u); break; } } } } while (0)
struct XcdBarrier { unsigned* bar; unsigned x; volatile LAS unsigned* st; int wave; };
__device__ __forceinline__ XcdBarrier xcd_barrier_post(unsigned* bar, volatile LAS unsigned* st, int wave) {
    XcdBarrier b; b.bar = bar; b.x = xb_xcc_id(); b.st = st; b.wave = wave;
    if (threadIdx.x == 0) (void)xb_add(&bar[XB_XCNT(b.x)], 1u);
    return b;
}
__device__ __forceinline__ void xcd_barrier_complete(unsigned* bar, unsigned x, unsigned& nloc, unsigned& nx) {
    const unsigned G = gridDim.x * gridDim.y * gridDim.z;
    unsigned sum, cnt, mine, sp = 0u;
    for (;;) {
        sum = 0u; cnt = 0u; mine = 0u;
#pragma unroll
        for (unsigned j = 0; j < 16; ++j) { const unsigned c = xb_ld(&bar[XB_XCNT(j)]); sum += c; cnt += (c > 0u) ? 1u : 0u; mine = (j == x) ? c : mine; }
        if (sum == G) break;
        __builtin_amdgcn_s_sleep(1);
        if ((++sp & 255u) == 0u) { if (xb_ld(&bar[XB_TMO])) break; if (sp > XB_SPIN_CAP) { atomicAdd(&bar[XB_TMO], 1u); break; } }
    }
    nloc = mine > 0u ? mine : 1u; nx = cnt > 0u ? cnt : 1u;
}
__device__ __forceinline__ void xcd_barrier(const XcdBarrier& b) {
    asm volatile("s_waitcnt vmcnt(0)" ::: "memory");
    __syncthreads();
    if (b.wave == 0 && lane_now() == 0) {
        unsigned* bar = b.bar;
        __builtin_amdgcn_s_waitcnt(0);
        unsigned nloc = b.st[0], nx = b.st[1];
        if (nloc == 0u) { xcd_barrier_complete(bar, b.x, nloc, nx); b.st[0] = nloc; b.st[1] = nx; }
        const unsigned old = xb_add(&bar[XB_XSUB(b.x)], 1u);
        const unsigned gen = old / nloc;
        if (old + 1u == (gen + 1u) * nloc) {
            __builtin_amdgcn_fence(__ATOMIC_RELEASE, "agent");
            asm volatile("s_waitcnt vmcnt(0)" ::: "memory");
            const unsigned og = xb_add(&bar[XB_TOP], 1u);
            const unsigned tg = og / nx;
            if (og + 1u == (tg + 1u) * nx) xb_add(&bar[XB_TOPGEN], 1u);
            else XB_SPIN(xb_ld(&bar[XB_TOPGEN]) == tg, bar);
            __builtin_amdgcn_fence(__ATOMIC_ACQUIRE, "agent");
            xb_add(&bar[XB_XGEN(b.x)], 1u);
            asm volatile("s_waitcnt vmcnt(0)" ::: "memory");
        } else {
            XB_SPIN(xb_ld(&bar[XB_XGEN(b.x)]) == gen, bar);
            __builtin_amdgcn_fence(__ATOMIC_ACQUIRE, "agent");
            asm volatile("s_waitcnt vmcnt(0)" ::: "memory");
        }
    }
    __syncthreads();
}

struct Args { const float* in[34]; float* out; unsigned char* ws; int ph_lo, ph_hi; };
enum { I_XP = 0, I_XS, I_MEM, I_CK, I_CV, I_SSM, I_SCONV, I_SPOOL, I_NF1, I_G1, I_U1, I_D1, I_NMIX, I_INW, I_CONVW, I_CONVB, I_DTB, I_ALOG, I_DSKIP, I_SNORM, I_OUTW,
       I_POOLW, I_POOLS, I_NCROSS, I_NMEM, I_WQ, I_WK, I_WV, I_WO, I_NF2, I_G2, I_U2, I_D2, I_NFIN };

struct Frame { LAS unsigned char* lds; unsigned char* ws; float* out; int tid, lane, wave, G, gw, ngw; };
__device__ __forceinline__ unsigned char* launder_u(unsigned char* p) { GAS unsigned char* g = (GAS unsigned char*)p; asm volatile("" : "+s"(g)); return (unsigned char*)g; }
__device__ __forceinline__ int launder_i(int x) { asm volatile("" : "+s"(x)); return x; }
__device__ __forceinline__ float* launder_f(float* p) { GAS float* g = (GAS float*)p; asm volatile("" : "+s"(g)); return (float*)g; }

__device__ __forceinline__ void transpose_item(const float* W, int ldw, int k0, int n0, bf16_t* WT, int ldt, int drow0, const float* ks, LAS float* scr, int lane) {
    { const int r8 = lane >> 3, c4 = lane & 7;
      f32x4 v[8];
#pragma unroll
      for (int i = 0; i < 8; ++i) v[i] = *(const f32x4*)(W + (size_t)(k0 + 8 * i + r8) * ldw + n0 + 4 * c4);
#pragma unroll
      for (int i = 0; i < 8; ++i) { const int kk = 8 * i + r8; f32x4 x = v[i]; if (ks) x = x * ks[k0 + kk];
          LAS float* d = scr + kk * 33 + 4 * c4; d[0] = x[0]; d[1] = x[1]; d[2] = x[2]; d[3] = x[3]; } }
    asm volatile("s_waitcnt lgkmcnt(0)" ::: "memory");
    const int c = lane & 7;
#pragma unroll
    for (int j = 0; j < 4; ++j) { const int n = (lane >> 3) + 8 * j; const LAS float* s = scr + (8 * c) * 33 + n;
        u32x4 o; o.x = pk2(s[0 * 33], s[1 * 33]); o.y = pk2(s[2 * 33], s[3 * 33]); o.z = pk2(s[4 * 33], s[5 * 33]); o.w = pk2(s[6 * 33], s[7 * 33]);
        *(u32x4*)(WT + (size_t)(drow0 + n) * ldt + k0 + 8 * c) = o; }
    asm volatile("s_waitcnt lgkmcnt(0)" ::: "memory");
}
__device__ __forceinline__ void p0_prologue(const Frame& F, const Args& a) {
    unsigned char* ws = F.ws;
    LAS float* scr = (LAS float*)(F.lds + F.wave * 16384);
    constexpr int I_GU = (D / 64) * (FF / 32), I_DN = (FF / 64) * (D / 32), I_IN = (D / 64) * (INW / 32), I_OUT = (DI / 64) * (D / 32), I_SQ = (D / 64) * (D / 32), I_PL = (256 / 64) * (256 / 32);
    constexpr int C0 = 16 * I_GU, C1 = C0 + 8 * I_DN, C2 = C1 + 2 * I_IN, C3 = C2 + 2 * I_OUT, C4 = C3 + 16 * I_SQ, C5 = C4 + 8 * I_PL;
    for (int it = F.gw; it < C5; it += F.ngw) {
        int r = it;
        if (r < C0) {
            const int q = r / I_GU, e = r % I_GU, which = q >> 2, layer = q & 3, kb = e / (FF / 32), nb = e % (FF / 32);
            const float* W = a.in[which == 0 ? I_G1 : which == 1 ? I_U1 : which == 2 ? I_G2 : I_U2] + (size_t)layer * D * FF;
            const int s = layer * 2 + (which >> 1), n0 = nb * 32, drow = (n0 >> 7) * 256 + (which & 1) * 128 + (n0 & 127);
            transpose_item(W, FF, kb * 64, n0, (bf16_t*)(ws + WS_WGU + (size_t)s * SZ_WGU), D, drow, nullptr, scr, F.lane);
        } else if (r < C1) {
            r -= C0; const int q = r / I_DN, e = r % I_DN, which = q >> 2, layer = q & 3, kb = e / (D / 32), nb = e % (D / 32);
            const float* W = a.in[which == 0 ? I_D1 : I_D2] + (size_t)layer * FF * D;
            transpose_item(W, D, kb * 64, nb * 32, (bf16_t*)(ws + WS_WD + (size_t)(layer * 2 + which) * SZ_WD), FF, nb * 32, nullptr, scr, F.lane);
        } else if (r < C2) {
            r -= C1; const int j = r / I_IN, e = r % I_IN, kb = e / (INW / 32), nb = e % (INW / 32);
            transpose_item(a.in[I_INW] + (size_t)j * D * INW, INW, kb * 64, nb * 32, (bf16_t*)(ws + WS_WIN + (size_t)j * SZ_WIN), D, nb * 32, nullptr, scr, F.lane);
        } else if (r < C3) {
            r -= C2; const int j = r / I_OUT, e = r % I_OUT, kb = e / (D / 32), nb = e % (D / 32);
            transpose_item(a.in[I_OUTW] + (size_t)j * DI * D, D, kb * 64, nb * 32, (bf16_t*)(ws + WS_WOUT + (size_t)j * SZ_WOUT), DI, nb * 32, a.in[I_SNORM] + j * DI, scr, F.lane);
        } else if (r < C4) {
            r -= C3; const int q = r / I_SQ, e = r % I_SQ, which = q >> 2, layer = q & 3, kb = e / (D / 32), nb = e % (D / 32);
            const float* W = a.in[which == 0 ? I_WQ : which == 1 ? I_WK : which == 2 ? I_WV : I_WO] + (size_t)layer * D * D;
            bf16_t* T = which == 0 ? (bf16_t*)(ws + WS_WQ + (size_t)layer * SZ_WSQ) : which == 3 ? (bf16_t*)(ws + WS_WO + (size_t)layer * SZ_WSQ)
                      : (bf16_t*)(ws + WS_WKV + (size_t)layer * 2 * SZ_WSQ + (which == 2 ? SZ_WSQ : 0));
            transpose_item(W, D, kb * 64, nb * 32, T, D, nb * 32, nullptr, scr, F.lane);
        } else {
            r -= C4; const int q = r / I_PL, e = r % I_PL, kb = e / 8, nb = e % 8;
            transpose_item(a.in[I_POOLW] + (size_t)q * 256 * 256, 256, kb * 64, nb * 32, (bf16_t*)(ws + WS_WPOOL) + (size_t)q * 256 * 256, 256, nb * 32, nullptr, scr, F.lane);
        }
    }
    for (int i = F.gw * 64 + F.lane; i < 2 * (INP - INW) * D / 8; i += F.ngw * 64) {
        const int j = i / ((INP - INW) * D / 8), e = i % ((INP - INW) * D / 8);
        *(u32x4*)((bf16_t*)(ws + WS_WIN + (size_t)j * SZ_WIN) + (size_t)INW * D + (size_t)e * 8) = (u32x4){0u, 0u, 0u, 0u};
    }
    for (int m = F.gw; m < PB * NMEM; m += F.ngw) {
        const f32x4* xr = (const f32x4*)(a.in[I_MEM] + (size_t)m * D) + F.lane;
        f32x4 v[4]; float s = 0.f;
#pragma unroll
        for (int j = 0; j < 4; ++j) { v[j] = xr[64 * j]; s += (v[j].x * v[j].x + v[j].y * v[j].y) + (v[j].z * v[j].z + v[j].w * v[j].w); }
        const float rstd = 1.f / sqrtf(wave_sum(s) * (1.f / D) + EPS);
#pragma unroll
        for (int i = 0; i < 4; ++i) {
            const f32x4* gr = (const f32x4*)(a.in[I_NMEM] + i * D) + F.lane;
            u32x2* o = (u32x2*)((bf16_t*)(ws + WS_MN) + ((size_t)i * 2048 + m) * D) + F.lane;
#pragma unroll
            for (int j = 0; j < 4; ++j) { const f32x4 g = gr[64 * j]; u32x2 w; w.x = pk2(v[j].x * rstd * g.x, v[j].y * rstd * g.y); w.y = pk2(v[j].z * rstd * g.z, v[j].w * rstd * g.w); o[64 * j] = w; }
        }
    }
}

template <bool FINAL, bool WU = true> __device__ __forceinline__ void norm_phase(const Frame& F, const float* sp, const float* ss, const float* gain, bf16_t* U, float* R, float* outf) {
    f32x4 g[4];
#pragma unroll
    for (int j = 0; j < 4; ++j) g[j] = ((const f32x4*)gain)[F.lane + 64 * j];
    for (int m0 = F.gw; m0 < M; m0 += 3 * F.ngw) {
        f32x4 v[3][4]; float s[3];
#pragma unroll
        for (int q = 0; q < 3; ++q) {
            const int m = m0 + q * F.ngw, mc = m < M ? m : m0;
            const float* xrow = mc < MP ? sp + (size_t)mc * D : ss + (size_t)(mc - MP) * D;
            const f32x4* xr = (const f32x4*)xrow + F.lane;
#pragma unroll
            for (int j = 0; j < 4; ++j) v[q][j] = xr[64 * j];
        }
#pragma unroll
        for (int q = 0; q < 3; ++q) { float t = 0.f;
#pragma unroll
            for (int j = 0; j < 4; ++j) t += (v[q][j].x * v[q][j].x + v[q][j].y * v[q][j].y) + (v[q][j].z * v[q][j].z + v[q][j].w * v[q][j].w);
            s[q] = t; }
#pragma unroll
        for (int o = 1; o < 64; o <<= 1) {
#pragma unroll
            for (int q = 0; q < 3; ++q) s[q] += shx(s[q], o);
        }
#pragma unroll
        for (int q = 0; q < 3; ++q) {
            const int m = m0 + q * F.ngw;
            if (m < M) {
                const float rstd = 1.f / sqrtf(s[q] * (1.f / D) + EPS);
                if constexpr (FINAL) {
                    f32x4* o = (f32x4*)(outf + (size_t)m * D) + F.lane;
#pragma unroll
                    for (int j = 0; j < 4; ++j) o[64 * j] = v[q][j] * rstd * g[j];
                } else {
                    u32x2* o = (u32x2*)(U + (size_t)m * D) + F.lane;
#pragma unroll
                    for (int j = 0; j < 4; ++j) if constexpr (WU) { u32x2 w; w.x = pk2(v[q][j].x * rstd * g[j].x, v[q][j].y * rstd * g[j].y); w.y = pk2(v[q][j].z * rstd * g[j].z, v[q][j].w * rstd * g[j].w); o[64 * j] = w; }
                    if (F.lane == 0) R[m] = rstd;
                }
            }
        }
    }
}

template <int W> __device__ __forceinline__ void pool_prompt_unit(const float* X, const float* R, const f32x4 g4, bf16_t* MIX, float* outp, int rb, int c, int vz) {
    const int row0 = rb * 32, b = row0 >> 11, t0 = row0 & 2047;
    f32x4 s = {0.f, 0.f, 0.f, 0.f};
#pragma unroll
    for (int j = 1; j < W; ++j) {
        const bool valid = t0 - j >= 0; const int rx = valid ? row0 - j : row0;
        const f32x4 x = *(const f32x4*)(X + (size_t)rx * D + c); const float r = R[rx + vz];
        s = s + x * (valid ? r : 0.f);
    }
#pragma unroll 1
    for (int q0 = 0; q0 < 32; q0 += 8) {
        f32x4 xn[8], xo[8]; float rn[8], rr[8];
#pragma unroll
        for (int i = 0; i < 8; ++i) {
            const int row = row0 + q0 + i, t = t0 + q0 + i;
            const bool vo = t - (W - 1) >= 0; const int ro = vo ? row - (W - 1) : row;
            xn[i] = *(const f32x4*)(X + (size_t)row * D + c); rn[i] = R[row + vz];
            xo[i] = *(const f32x4*)(X + (size_t)ro * D + c); rr[i] = vo ? R[ro + vz] : 0.f;
        }
#pragma unroll
        for (int i = 0; i < 8; ++i) {
            const int row = row0 + q0 + i, t = t0 + q0 + i;
            const f32x4 un = xn[i] * rn[i];
            s = s + un;
            const float inv = (t + 1 < W) ? 1.0f / (float)(t + 1) : 1.0f / (float)W;
            const f32x4 mix = (s * inv - un) * g4;
            u32x2 o; o.x = pk2(mix.x, mix.y); o.y = pk2(mix.z, mix.w);
            *(u32x2*)(MIX + (size_t)row * D + c) = o;
            if (t >= PL - 15) *(f32x4*)(outp + ((size_t)b * 15 + (t - (PL - 15))) * D + c) = un * g4;
            s = s - xo[i] * rr[i];
        }
    }
}
template <int W> __device__ __forceinline__ void pool_sample_unit(const float* X, const float* R, const float* sp, const f32x4 g4, bf16_t* MIX, float* ob, int b, int c, int vz) {
    const int row0 = MP + 8 * b;
    f32x4 s = {0.f, 0.f, 0.f, 0.f};
#pragma unroll
    for (int j = 1; j < W; ++j) s = s + *(const f32x4*)(sp + (size_t)(15 - j) * D + c);
    f32x4 xn[8]; float rn[8];
#pragma unroll
    for (int t = 0; t < 8; ++t) { xn[t] = *(const f32x4*)(X + (size_t)(row0 + t) * D + c); rn[t] = R[row0 + t + vz]; }
    f32x4 old[8];
#pragma unroll
    for (int t = 0; t < 8; ++t) if (t < W - 1) old[t] = *(const f32x4*)(sp + (size_t)(16 + t - W) * D + c);
#pragma unroll
    for (int t = 0; t < 8; ++t) {
        const f32x4 un = xn[t] * rn[t] * g4;
        s = s + un;
        const f32x4 mix = s * (1.0f / (float)W) - un;
        u32x2 o; o.x = pk2(mix.x, mix.y); o.y = pk2(mix.z, mix.w);
        *(u32x2*)(MIX + (size_t)(row0 + t) * D + c) = o;
        *(f32x4*)(ob + (size_t)(7 + t) * D + c) = un;
        if (t < W - 1) s = s - old[t]; else s = s - xn[t - (W - 1) < 0 ? 0 : t - (W - 1)] * rn[t - (W - 1) < 0 ? 0 : t - (W - 1)] * g4;
    }
}
__device__ __forceinline__ void pool_phase(const Frame& F, const Args& a, int jl, int layer) {
    const float* X = (const float*)(F.ws + WS_X); const float* R = (const float*)(F.ws + WS_R);
    bf16_t* MIX = (bf16_t*)(F.ws + WS_Q);
    const float* gain = a.in[I_NMIX] + layer * D;
    const float* spool = a.in[I_SPOOL] + (size_t)jl * SB * 15 * D;
    float* outp = F.out + OUT_POOL_P + (size_t)jl * PB * 15 * D;
    float* outs = F.out + OUT_POOL_S + (size_t)jl * SB * 15 * D;
    const int vz = opaque(0);
    for (int wu = F.gw; wu < (MP / 32) * 4; wu += F.ngw) {
        const int g = wu & 3, rb = wu >> 2, c = 256 * g + 4 * F.lane;
        const f32x4 g4 = *(const f32x4*)(gain + c);
        if (g == 0) pool_prompt_unit<2>(X, R, g4, MIX, outp, rb, c, vz);
        else if (g == 1) pool_prompt_unit<4>(X, R, g4, MIX, outp, rb, c, vz);
        else if (g == 2) pool_prompt_unit<8>(X, R, g4, MIX, outp, rb, c, vz);
        else pool_prompt_unit<16>(X, R, g4, MIX, outp, rb, c, vz);
    }
    if ((F.gw & 3) == 0) for (int su = F.gw >> 2; su < SB * 4; su += F.ngw >> 2) {
        const int g = su & 3, b = su >> 2, c = 256 * g + 4 * F.lane;
        const f32x4 g4 = *(const f32x4*)(gain + c);
        const float* sp = spool + (size_t)b * 15 * D; float* ob = outs + (size_t)b * 15 * D;
        if (g == 0) pool_sample_unit<2>(X, R, sp, g4, MIX, ob, b, c, vz);
        else if (g == 1) pool_sample_unit<4>(X, R, sp, g4, MIX, ob, b, c, vz);
        else if (g == 2) pool_sample_unit<8>(X, R, sp, g4, MIX, ob, b, c, vz);
        else pool_sample_unit<16>(X, R, sp, g4, MIX, ob, b, c, vz);
    }
    for (int i = F.gw * 64 + F.lane; i < SB * 7 * (D / 4); i += F.ngw * 64) {
        const int c4 = i % (D / 4), rr = (i / (D / 4)) % 7, b = i / (7 * (D / 4));
        *(f32x4*)(outs + ((size_t)b * 15 + rr) * D + c4 * 4) = *(const f32x4*)(spool + ((size_t)b * 15 + 8 + rr) * D + c4 * 4);
    }
}

__device__ __forceinline__ void gnorm_phase(const Frame& F, const Args& a) {
    bf16_t* V = (bf16_t*)(F.ws + WS_V); const float* SS = (const float*)(F.ws + WS_SS);
    for (int m0 = F.gw; m0 < M; m0 += 3 * F.ngw) {
        f32x4 s0[3]; u32x4 w[3][4];
#pragma unroll
        for (int q = 0; q < 3; ++q) {
            const int m = m0 + q * F.ngw, mc = m < M ? m : m0;
            s0[q] = *(const f32x4*)(SS + (size_t)mc * 32 + (F.lane & 7) * 4);
#pragma unroll
            for (int j = 0; j < 4; ++j) w[q][j] = *((const u32x4*)(V + (size_t)mc * DI + 512 * j) + F.lane);
        }
#pragma unroll
        for (int q = 0; q < 3; ++q) {
            const int m = m0 + q * F.ngw;
            float sg = (s0[q].x + s0[q].y) + (s0[q].z + s0[q].w);
            sg += shx(sg, 1);
#pragma unroll
            for (int j = 0; j < 4; ++j) {
                const float tot = shi(sg, 2 * j);
                const float r = __builtin_amdgcn_rsqf(tot * (1.f / 512.f) + EPS);
                u32x4 o;
#pragma unroll
                for (int e = 0; e < 4; ++e) { const unsigned x = w[q][j][e]; o[e] = cvt_pk_bf16(bf2f(x & 0xffffu) * r, bf2f(x >> 16) * r); }
                if (m < M) *((u32x4*)(V + (size_t)m * DI + 512 * j) + F.lane) = o;
            }
        }
    }
}


constexpr int GTAB_OFF = MISC_OFF + 4096;
static_assert(pg8::SLB_OFF == MISC_OFF + 10240 && GTAB_OFF + 272 * 16 <= pg8::SLB_OFF && pg8::SLB_OFF + 4096 <= LDS_BYTES, "slab buffers sit beyond the group-norm table inside the misc LDS region");
__device__ __forceinline__ void gnorm_table(const Frame& F, int pm) {
    const float* SS = (const float*)(F.ws + WS_SS);
    LAS float* tab = (LAS float*)(F.lds + GTAB_OFF);
    if (F.tid < 272) {
        const int row = F.tid < 256 ? pm * 256 + F.tid : MP + 16 * pm + (F.tid - 256);
        f32x4 v[8];
#pragma unroll
        for (int i = 0; i < 8; ++i) v[i] = *(const f32x4*)(SS + (size_t)row * 32 + 4 * i);
        float r[4];
#pragma unroll
        for (int g = 0; g < 4; ++g) { const f32x4 t = v[2 * g] + v[2 * g + 1]; r[g] = __builtin_amdgcn_rsqf(((t.x + t.y) + (t.z + t.w)) * (1.f / 512.f) + EPS); }
        f32x4 o; o.x = r[0] / r[1]; o.y = r[1] / r[2]; o.z = r[2] / r[3]; o.w = r[3];
        *(LAS f32x4*)(tab + F.tid * 4) = o;
    }
    __syncthreads();
}
__device__ __forceinline__ bf16x8 lfrag(const LAS bf16_t* base, int row, int pitch, int k) { return *(const LAS bf16x8*)(base + row * pitch + k); }
__device__ __forceinline__ void wave_lds_sync() { asm volatile("s_waitcnt lgkmcnt(0)" ::: "memory"); __builtin_amdgcn_wave_barrier(); }
__device__ __forceinline__ bf16x8 pack8(f32x4 a, f32x4 b) { u32x4 w; w.x = cvt_pk_bf16(a[0], a[1]); w.y = cvt_pk_bf16(a[2], a[3]); w.z = cvt_pk_bf16(b[0], b[1]); w.w = cvt_pk_bf16(b[2], b[3]); return __builtin_bit_cast(bf16x8, w); }

__device__ __forceinline__ void lds_barrier() { asm volatile("s_waitcnt lgkmcnt(0)" ::: "memory"); __builtin_amdgcn_s_barrier(); asm volatile("" ::: "memory"); }
__device__ __forceinline__ float row16_sum(float v) {
    v += __builtin_bit_cast(float, __builtin_amdgcn_update_dpp(0, __builtin_bit_cast(int, v), 0x128, 0xf, 0xf, false));
    v += __builtin_bit_cast(float, __builtin_amdgcn_update_dpp(0, __builtin_bit_cast(int, v), 0x124, 0xf, 0xf, false));
    v += __builtin_bit_cast(float, __builtin_amdgcn_update_dpp(0, __builtin_bit_cast(int, v), 0x122, 0xf, 0xf, false));
    v += __builtin_bit_cast(float, __builtin_amdgcn_update_dpp(0, __builtin_bit_cast(int, v), 0x121, 0xf, 0xf, false));
    return v;
}

struct MiniRes {
    const float* src; float* X; float alpha; const float* scale;
    __device__ __forceinline__ void operator()(int row, int col, f32x4 v) const {
        const unsigned off = (unsigned)(row * D + col);
        f32x4 sc = scale ? *(const f32x4*)(scale + col) : (f32x4){1.f, 1.f, 1.f, 1.f};
        *(f32x4*)(X + off) = *(const f32x4*)(src + off) + v * (sc * alpha);
    }
};
struct MiniBf16 {
    bf16_t* O; int ldc;
    __device__ __forceinline__ void operator()(int row, int col, f32x4 v) const {
        u32x2 w; w.x = cvt_pk_bf16(v[0], v[1]); w.y = cvt_pk_bf16(v[2], v[3]);
        *(u32x2*)(O + (unsigned)(row * ldc + col)) = w;
    }
};
__device__ __forceinline__ void conv_phase(const Frame& F, const Args& a, int jl) {
    const bf16_t* ZX = (const bf16_t*)(F.ws + WS_ZX); bf16_t* XBC = (bf16_t*)(F.ws + WS_XBC);
    const float* cw = a.in[I_CONVW] + (size_t)jl * 4 * CONVD; const float* cb = a.in[I_CONVB] + (size_t)jl * CONVD;
    const int lane = F.lane;
    constexpr int RPU = (M * 6) / 2048;
    static_assert(RPU * 2048 == M * 6, "conv runs");
#define CONV_UNPACK(dst, raw) do { dst[0] = (f32x4){bf2f((raw).x & 0xffffu), bf2f((raw).x >> 16), bf2f((raw).y & 0xffffu), bf2f((raw).y >> 16)}; dst[1] = (f32x4){bf2f((raw).z & 0xffffu), bf2f((raw).z >> 16), bf2f((raw).w & 0xffffu), bf2f((raw).w >> 16)}; } while (0)
    for (int u = F.gw; u < 2048; u += F.ngw) {
        int slab = -1, ch = 0;
        f32x4 w[4][2], bv[2], x0[2], x1[2], x2[2];
#pragma unroll
        for (int e = 0; e < 2; ++e) { x0[e] = (f32x4){0.f, 0.f, 0.f, 0.f}; x1[e] = x0[e]; x2[e] = x0[e]; bv[e] = x0[e];
#pragma unroll
            for (int k = 0; k < 4; ++k) w[k][e] = x0[e]; }
#pragma unroll 1
        for (int r0 = 0; r0 < RPU; r0 += 8) {
            u32x4 rq[8];
#pragma unroll
            for (int q = 0; q < 8; ++q) { const int rc = (r0 + q < RPU) ? r0 + q : RPU - 1; const int idx = u * RPU + rc, sl = idx / M, row = idx - sl * M;
                rq[q] = *(const u32x4*)(ZX + (size_t)row * ZXP + DI + sl * 512 + 8 * lane); }
#pragma unroll
            for (int q = 0; q < 8; ++q) {
                const int r = r0 + q;
                if (r < RPU) {
                    const int idx = u * RPU + r, sl = idx / M, row = idx - sl * M;
                    const bool isS = row >= MP;
                    const int t = isS ? ((row - MP) & 7) : (row & (PL - 1));
                    if (sl != slab) {
                        slab = sl; ch = sl * 512 + 8 * lane;
#pragma unroll
                        for (int k = 0; k < 4; ++k) { w[k][0] = *(const f32x4*)(cw + k * CONVD + ch); w[k][1] = *(const f32x4*)(cw + k * CONVD + ch + 4); }
                        bv[0] = *(const f32x4*)(cb + ch); bv[1] = *(const f32x4*)(cb + ch + 4);
                    }
                    if (r == 0 || t == 0) {
                        const float* sc = a.in[I_SCONV] + (((size_t)jl * SB + (isS ? ((row - MP) >> 3) : 0)) * 3) * CONVD + ch;
#pragma unroll
                        for (int j = 1; j <= 3; ++j) {
                            f32x4 h[2];
                            if (t - j >= 0) { const u32x4 rw = *(const u32x4*)(ZX + (size_t)(row - j) * ZXP + DI + ch); CONV_UNPACK(h, rw); }
                            else if (isS) { h[0] = *(const f32x4*)(sc + (size_t)(3 + t - j) * CONVD); h[1] = *(const f32x4*)(sc + (size_t)(3 + t - j) * CONVD + 4); }
                            else { h[0] = (f32x4){0.f, 0.f, 0.f, 0.f}; h[1] = h[0]; }
                            if (j == 1) { x2[0] = h[0]; x2[1] = h[1]; } else if (j == 2) { x1[0] = h[0]; x1[1] = h[1]; } else { x0[0] = h[0]; x0[1] = h[1]; }
                        }
                    }
                    f32x4 x3[2]; CONV_UNPACK(x3, rq[q]);
                    u32x4 o;
                    {   f32x4 v0 = bv[0] + w[0][0] * x0[0] + w[1][0] * x1[0] + w[2][0] * x2[0] + w[3][0] * x3[0];
                        f32x4 v1 = bv[1] + w[0][1] * x0[1] + w[1][1] * x1[1] + w[2][1] * x2[1] + w[3][1] * x3[1];
                        o.x = cvt_pk_bf16(silu_f(v0[0]), silu_f(v0[1])); o.y = cvt_pk_bf16(silu_f(v0[2]), silu_f(v0[3]));
                        o.z = cvt_pk_bf16(silu_f(v1[0]), silu_f(v1[1])); o.w = cvt_pk_bf16(silu_f(v1[2]), silu_f(v1[3])); }
                    *(u32x4*)(XBC + (size_t)row * CONVD + ch) = o;
#pragma unroll
                    for (int e = 0; e < 2; ++e) { x0[e] = x1[e]; x1[e] = x2[e]; x2[e] = x3[e]; }
                }
            }
        }
    }
#undef CONV_UNPACK
}

constexpr int SC_CM = 0, SC_XD = 17408, SC_BM = 34816, SC_XW = 53248, SC_LM = 70656, SC_XS = 80896, SC_HS = 90112, SC_ZT = 107520, SC_VT = 116736, SC_F32 = 125952;
__device__ __forceinline__ void scan_prompt_unit(const Frame& F, const Args& a, int jl, int b, int h) {
    LAS unsigned char* L = F.lds;
    LAS bf16_t* CM = (LAS bf16_t*)(L + SC_CM); LAS bf16_t* BM = (LAS bf16_t*)(L + SC_BM);
    LAS bf16_t* XD = (LAS bf16_t*)(L + SC_XD); LAS bf16_t* XW = (LAS bf16_t*)(L + SC_XW); LAS bf16_t* LM = (LAS bf16_t*)(L + SC_LM);
    LAS bf16_t* XS = (LAS bf16_t*)(L + SC_XS); LAS bf16_t* HS = (LAS bf16_t*)(L + SC_HS);
    LAS bf16_t* ZT = (LAS bf16_t*)(L + SC_ZT); LAS bf16_t* VT = (LAS bf16_t*)(L + SC_VT);
    LAS float* FB = (LAS float*)(L + SC_F32);
    LAS float* SSP = FB + 2 * 256;
    const int g = h >> 3, tid = F.tid, lane = F.lane, w = F.wave, fr = lane & 15, fq = lane >> 4;
    const bf16_t* ZX = (const bf16_t*)(F.ws + WS_ZX); const bf16_t* XBC = (const bf16_t*)(F.ws + WS_XBC); const float* DT = (const float*)(F.ws + WS_DT);
    bf16_t* V = (bf16_t*)(F.ws + WS_V); float* SS = (float*)(F.ws + WS_SS);
    const float A_h = -__expf(a.in[I_ALOG][jl * 32 + h]), dsk = a.in[I_DSKIP][jl * 32 + h];
    const size_t row0 = (size_t)b * PL;
    for (int i = tid; i < 64 * 136 / 2; i += NTHR) ((LAS unsigned*)HS)[i] = 0u;
    f32x4 hacc[4];
#pragma unroll
    for (int j = 0; j < 4; ++j) hacc[j] = (f32x4){0.f, 0.f, 0.f, 0.f};
    const int qt = w >> 1, xh = w & 1;
    const unsigned trq4 = (unsigned)(fr >> 2), trp4 = (unsigned)(fr & 3);
    const unsigned trx = (unsigned)(size_t)L + (8u * fq + trq4) * 160u + 8u * trp4 + 64u * (unsigned)xh;
    const unsigned trw = (unsigned)(size_t)L + (8u * fq + trq4) * 160u + 8u * trp4 + 32u * (unsigned)qt;
    const unsigned trb = (unsigned)(size_t)L + (8u * fq + trq4) * 288u + 8u * trp4 + 128u * (unsigned)xh;
    u32x4 pre[5], prez; float predt;
    const int zr = tid >> 3, zo = tid & 7;
#define SCAN_CH(it_) ((it_) == 0 ? h * 64 + 8 * w : ((it_) < 3 ? DI + g * 128 + 8 * (w + 8 * ((it_) - 1)) : DI + 512 + g * 128 + 8 * (w + 8 * ((it_) - 3))))
#define SCAN_LOAD(c_) do { const size_t rb_ = row0 + (size_t)(c_) * 64; \
        _Pragma("unroll") for (int it = 0; it < 5; ++it) pre[it] = *(const u32x4*)(XBC + (rb_ + lane) * CONVD + SCAN_CH(it)); \
        prez = *(const u32x4*)(ZX + (rb_ + zr) * ZXP + h * 64 + 8 * zo); predt = DT[(rb_ + lane) * 32 + h]; } while (0)
#define SCAN_STEP0(c_) do { if (w == 0) { LAS float* fb_ = FB + ((c_) & 1) * 256; \
        const float dtv = predt; float x = A_h * dtv; \
        _Pragma("unroll") for (int o = 1; o < 64; o <<= 1) { const float y = shup(x, o); if (lane >= o) x += y; } \
        const float tot = shi(x, 63); fb_[lane] = x; fb_[64 + lane] = dtv; fb_[128 + lane] = __expf(tot - x); if (lane == 0) fb_[192] = __expf(tot); } } while (0)
    SCAN_LOAD(0);
    SCAN_STEP0(0);
    __syncthreads();
    for (int c = 0; c < PL / 64; ++c) {
        const int t0 = c * 64;
        LAS float* fb = FB + (c & 1) * 256;
        {   const int r = lane;
            {   const u32x4 pk = pre[0];
                *(LAS u32x4*)(XS + r * 72 + 8 * w) = pk;
                const float dtl = fb[64 + r], dte = fb[128 + r];
                u32x4 d4, w4;
#pragma unroll
                for (int e = 0; e < 4; ++e) { const float x0 = bf2f(pk[e] & 0xffffu) * dtl, x1 = bf2f(pk[e] >> 16) * dtl; d4[e] = cvt_pk_bf16(x0, x1); w4[e] = cvt_pk_bf16(x0 * dte, x1 * dte); }
                *(LAS u32x4*)(XD + r * 80 + 8 * w) = d4; *(LAS u32x4*)(XW + r * 80 + 8 * w) = w4; }
#pragma unroll
            for (int it = 1; it < 3; ++it) *(LAS u32x4*)(BM + r * 144 + 8 * (w + 8 * (it - 1))) = pre[it];
#pragma unroll
            for (int it = 3; it < 5; ++it) *(LAS u32x4*)(CM + r * 136 + 8 * (w + 8 * (it - 3))) = pre[it];
        }
        *(LAS u32x4*)(ZT + zr * 72 + 8 * zo) = prez;
        lds_barrier();
        { const int cn = (c + 1 < PL / 64) ? c + 1 : c; SCAN_LOAD(cn); }
        const float cdec = fb[192];
        f32x4 yoff[2];
#pragma unroll
        for (int x = 0; x < 2; ++x) {
            const int ct = 2 * xh + x;
            f32x4 c1 = {0.f, 0.f, 0.f, 0.f}, c3 = {0.f, 0.f, 0.f, 0.f};
#pragma unroll
            for (int ks = 0; ks < 4; ++ks) {
                const bf16x8 af = lfrag(CM, qt * 16 + fr, 136, ks * 32 + 8 * fq);
                const bf16x8 b1 = lfrag(BM, ct * 16 + fr, 144, ks * 32 + 8 * fq);
                const bf16x8 b3 = lfrag(HS, ct * 16 + fr, 136, ks * 32 + 8 * fq);
                c1 = __builtin_amdgcn_mfma_f32_16x16x32_bf16(af, b1, c1, 0, 0, 0);
                c3 = __builtin_amdgcn_mfma_f32_16x16x32_bf16(af, b3, c3, 0, 0, 0);
            }
            const int kk = ct * 16 + fr; const float ak = fb[kk];
            float lv[4];
#pragma unroll
            for (int r = 0; r < 4; ++r) {
                const int q = qt * 16 + 4 * fq + r; const float aq = fb[q];
                lv[r] = (kk <= q) ? c1[r] * __expf(aq - ak) : 0.f;
                yoff[x][r] = c3[r] * __expf(aq);
            }
            { u32x2 lw; lw.x = cvt_pk_bf16(lv[0], lv[1]); lw.y = cvt_pk_bf16(lv[2], lv[3]); *(LAS u32x2*)(LM + kk * 80 + qt * 16 + 4 * fq) = lw; }
        }
        lds_barrier();
        float ssq[4] = {0.f, 0.f, 0.f, 0.f};
        bf16x8 xdf[2][2], lmf[2];
        {   u32x2 r0, r1, r2, r3, r4, r5, r6, r7, l0, l1, l2, l3; const unsigned ad = trx + SC_XD, al = trw + SC_LM;
            asm volatile("ds_read_b64_tr_b16 %0, %12\n\tds_read_b64_tr_b16 %1, %12 offset:640\n\tds_read_b64_tr_b16 %2, %12 offset:5120\n\tds_read_b64_tr_b16 %3, %12 offset:5760\n\t"
                         "ds_read_b64_tr_b16 %4, %12 offset:32\n\tds_read_b64_tr_b16 %5, %12 offset:672\n\tds_read_b64_tr_b16 %6, %12 offset:5152\n\tds_read_b64_tr_b16 %7, %12 offset:5792\n\t"
                         "ds_read_b64_tr_b16 %8, %13\n\tds_read_b64_tr_b16 %9, %13 offset:640\n\tds_read_b64_tr_b16 %10, %13 offset:5120\n\tds_read_b64_tr_b16 %11, %13 offset:5760\n\ts_waitcnt lgkmcnt(0)"
                         : "=&v"(r0), "=&v"(r1), "=&v"(r2), "=&v"(r3), "=&v"(r4), "=&v"(r5), "=&v"(r6), "=&v"(r7), "=&v"(l0), "=&v"(l1), "=&v"(l2), "=&v"(l3) : "v"(ad), "v"(al) : "memory");
            lmf[0] = __builtin_bit_cast(bf16x8, (u32x4){l0.x, l0.y, l1.x, l1.y}); lmf[1] = __builtin_bit_cast(bf16x8, (u32x4){l2.x, l2.y, l3.x, l3.y});
            xdf[0][0] = __builtin_bit_cast(bf16x8, (u32x4){r0.x, r0.y, r1.x, r1.y}); xdf[0][1] = __builtin_bit_cast(bf16x8, (u32x4){r2.x, r2.y, r3.x, r3.y});
            xdf[1][0] = __builtin_bit_cast(bf16x8, (u32x4){r4.x, r4.y, r5.x, r5.y}); xdf[1][1] = __builtin_bit_cast(bf16x8, (u32x4){r6.x, r6.y, r7.x, r7.y}); }
#pragma unroll
        for (int x = 0; x < 2; ++x) {
            const int pt = 2 * xh + x;
            f32x4 c2 = yoff[x];
#pragma unroll
            for (int ks = 0; ks < 2; ++ks)
                c2 = __builtin_amdgcn_mfma_f32_16x16x32_bf16(lmf[ks], xdf[x][ks], c2, 0, 0, 0);
            const int p = pt * 16 + fr;
#pragma unroll
            for (int r = 0; r < 4; ++r) {
                const int q = qt * 16 + 4 * fq + r;
                const float y = c2[r] + dsk * bf2f(XS[q * 72 + p]);
                const float vv = y * silu_f(bf2f(ZT[q * 72 + p]));
                VT[q * 72 + p] = (bf16_t)cvt_pk_bf16(vv, 0.f);
                ssq[r] += vv * vv;
            }
        }
#pragma unroll
        for (int r = 0; r < 4; ++r) { const float s = row16_sum(ssq[r]); if (fr == 0) SSP[xh * 64 + qt * 16 + 4 * fq + r] = s; }
        bf16x8 xwf[2], bmf[4][2];
        {   u32x2 r0, r1, r2, r3, r4, r5, r6, r7, r8, r9, r10, r11; const unsigned aw = trw + SC_XW, ab = trb + SC_BM;
            asm volatile("ds_read_b64_tr_b16 %0, %12\n\tds_read_b64_tr_b16 %1, %12 offset:640\n\tds_read_b64_tr_b16 %2, %12 offset:5120\n\tds_read_b64_tr_b16 %3, %12 offset:5760\n\t"
                         "ds_read_b64_tr_b16 %4, %13\n\tds_read_b64_tr_b16 %5, %13 offset:1152\n\tds_read_b64_tr_b16 %6, %13 offset:9216\n\tds_read_b64_tr_b16 %7, %13 offset:10368\n\t"
                         "ds_read_b64_tr_b16 %8, %13 offset:32\n\tds_read_b64_tr_b16 %9, %13 offset:1184\n\tds_read_b64_tr_b16 %10, %13 offset:9248\n\tds_read_b64_tr_b16 %11, %13 offset:10400\n\ts_waitcnt lgkmcnt(0)"
                         : "=&v"(r0), "=&v"(r1), "=&v"(r2), "=&v"(r3), "=&v"(r4), "=&v"(r5), "=&v"(r6), "=&v"(r7), "=&v"(r8), "=&v"(r9), "=&v"(r10), "=&v"(r11) : "v"(aw), "v"(ab) : "memory");
            xwf[0] = __builtin_bit_cast(bf16x8, (u32x4){r0.x, r0.y, r1.x, r1.y}); xwf[1] = __builtin_bit_cast(bf16x8, (u32x4){r2.x, r2.y, r3.x, r3.y});
            bmf[0][0] = __builtin_bit_cast(bf16x8, (u32x4){r4.x, r4.y, r5.x, r5.y}); bmf[0][1] = __builtin_bit_cast(bf16x8, (u32x4){r6.x, r6.y, r7.x, r7.y});
            bmf[1][0] = __builtin_bit_cast(bf16x8, (u32x4){r8.x, r8.y, r9.x, r9.y}); bmf[1][1] = __builtin_bit_cast(bf16x8, (u32x4){r10.x, r10.y, r11.x, r11.y}); }
        {   u32x2 r0, r1, r2, r3, r4, r5, r6, r7; const unsigned ab = trb + SC_BM;
            asm volatile("ds_read_b64_tr_b16 %0, %8 offset:64\n\tds_read_b64_tr_b16 %1, %8 offset:1216\n\tds_read_b64_tr_b16 %2, %8 offset:9280\n\tds_read_b64_tr_b16 %3, %8 offset:10432\n\t"
                         "ds_read_b64_tr_b16 %4, %8 offset:96\n\tds_read_b64_tr_b16 %5, %8 offset:1248\n\tds_read_b64_tr_b16 %6, %8 offset:9312\n\tds_read_b64_tr_b16 %7, %8 offset:10464\n\ts_waitcnt lgkmcnt(0)"
                         : "=&v"(r0), "=&v"(r1), "=&v"(r2), "=&v"(r3), "=&v"(r4), "=&v"(r5), "=&v"(r6), "=&v"(r7) : "v"(ab) : "memory");
            bmf[2][0] = __builtin_bit_cast(bf16x8, (u32x4){r0.x, r0.y, r1.x, r1.y}); bmf[2][1] = __builtin_bit_cast(bf16x8, (u32x4){r2.x, r2.y, r3.x, r3.y});
            bmf[3][0] = __builtin_bit_cast(bf16x8, (u32x4){r4.x, r4.y, r5.x, r5.y}); bmf[3][1] = __builtin_bit_cast(bf16x8, (u32x4){r6.x, r6.y, r7.x, r7.y}); }
#pragma unroll
        for (int j = 0; j < 4; ++j) {
            const int nt = 4 * xh + j;
            f32x4 acc = hacc[j] * cdec;
#pragma unroll
            for (int ks = 0; ks < 2; ++ks)
                acc = __builtin_amdgcn_mfma_f32_16x16x32_bf16(xwf[ks], bmf[j][ks], acc, 0, 0, 0);
            hacc[j] = acc;
#pragma unroll
            for (int r = 0; r < 4; ++r) HS[(qt * 16 + 4 * fq + r) * 136 + nt * 16 + fr] = (bf16_t)cvt_pk_bf16(acc[r], 0.f);
        }
        SCAN_STEP0(c + 1);
        lds_barrier();
        *(u32x4*)(V + (row0 + t0 + zr) * DI + h * 64 + 8 * zo) = *(const LAS u32x4*)(VT + zr * 72 + 8 * zo);
        if (tid < 64) SS[(row0 + t0 + tid) * 32 + h] = SSP[tid] + SSP[64 + tid];
    }
#undef SCAN_LOAD
#undef SCAN_CH
#undef SCAN_STEP0
    float* outS = F.out + OUT_SSM_P + (((size_t)jl * PB + b) * NHEAD + h) * HDIM * NST;
#pragma unroll
    for (int j = 0; j < 4; ++j)
#pragma unroll
        for (int r = 0; r < 4; ++r) outS[(qt * 16 + 4 * fq + r) * NST + (4 * xh + j) * 16 + fr] = hacc[j][r];
    __syncthreads();
}

__device__ __forceinline__ void scan_sample_unit(const Frame& F, const Args& a, int jl, int b, int h) {
    LAS float* S = (LAS float*)(F.lds + F.wave * 16384);
    LAS float* xsS = S; LAS float* bmS = S + 512; LAS float* cmS = bmS + 1056; LAS float* xdtS = cmS + 1056; LAS float* xdtwS = xdtS + 512; LAS float* LmS = xdtwS + 512; LAS float* acsS = LmS + 64;
    const int lane = F.lane, g = h >> 3;
    const bf16_t* ZX = (const bf16_t*)(F.ws + WS_ZX); const bf16_t* XBC = (const bf16_t*)(F.ws + WS_XBC); const float* DT = (const float*)(F.ws + WS_DT);
    bf16_t* V = (bf16_t*)(F.ws + WS_V); float* SS = (float*)(F.ws + WS_SS);
    const float A_h = -__expf(a.in[I_ALOG][jl * 32 + h]), dsk = a.in[I_DSKIP][jl * 32 + h];
    const size_t row0 = (size_t)MP + (size_t)b * SL;
    const size_t soff = ((((size_t)jl * SB + b) * NHEAD + h) * HDIM) * NST;
    const float* st = a.in[I_SSM] + soff; float* so = F.out + OUT_SSM_S + soff;
    const int pl = lane & 15, kq = lane >> 4, tq = lane & 7;
    f32x4 hc[4][8];
#pragma unroll
    for (int pt = 0; pt < 4; ++pt)
#pragma unroll
        for (int e = 0; e < 8; ++e) hc[pt][e] = *(const f32x4*)(st + (unsigned)((16 * pt + pl) * NST + 32 * (e >> 1) + 8 * kq + 4 * (e & 1)));
    float dtv[8], acs[8]; float run = 0.f;
    const int vz = opaque(0);
#pragma unroll
    for (int t = 0; t < 8; ++t) { dtv[t] = DT[(row0 + t) * 32 + h + vz]; run += A_h * dtv[t]; acs[t] = run; }
    const float tot = run, cdec = __expf(tot);
    { float v = acs[0];
#pragma unroll
      for (int t = 1; t < 8; ++t) v = (lane == t) ? acs[t] : v;
      if (lane < 8) acsS[lane] = v; }
#pragma unroll
    for (int it = 0; it < 10; ++it) {
        const int item = lane + 64 * it, t = item / 80, qd = item % 80;
        const int ch = qd < 16 ? h * 64 + 4 * qd : (qd < 48 ? DI + g * 128 + 4 * (qd - 16) : DI + 512 + g * 128 + 4 * (qd - 48));
        const u32x2 raw = *(const u32x2*)(XBC + (row0 + t) * CONVD + ch);
        LAS float* dst = qd < 16 ? xsS + t * 64 + 4 * qd : (qd < 48 ? bmS + t * 132 + 4 * (qd - 16) : cmS + t * 132 + 4 * (qd - 48));
        *(LAS f32x4*)dst = (f32x4){bf2f(raw.x & 0xffffu), bf2f(raw.x >> 16), bf2f(raw.y & 0xffffu), bf2f(raw.y >> 16)};
    }
    wave_lds_sync();
#pragma unroll
    for (int t = 0; t < 8; ++t) { const float xd = xsS[t * 64 + lane] * dtv[t]; xdtS[t * 64 + lane] = xd; xdtwS[t * 64 + lane] = xd * __expf(tot - acs[t]); }
    { const int t = lane >> 3, k = lane & 7; float s = 0.f;
#pragma unroll 8
      for (int n = 0; n < 128; n += 4) { const f32x4 c4 = *(const LAS f32x4*)(cmS + t * 132 + n), b4 = *(const LAS f32x4*)(bmS + k * 132 + n); s += (c4[0] * b4[0] + c4[1] * b4[1]) + (c4[2] * b4[2] + c4[3] * b4[3]); }
      LmS[lane] = (k <= t) ? s * __expf(acsS[t] - acsS[k]) : 0.f; }
    wave_lds_sync();
    bf16x8 cmF[4];
#pragma unroll
    for (int ks = 0; ks < 4; ++ks) cmF[ks] = pack8(*(const LAS f32x4*)(cmS + tq * 132 + 32 * ks + 8 * kq), *(const LAS f32x4*)(cmS + tq * 132 + 32 * ks + 8 * kq + 4));
    float Lrow[8];
#pragma unroll
    for (int k = 0; k < 8; ++k) Lrow[k] = LmS[tq * 8 + k];
    const float eacs = __expf(acsS[tq]);
    float ssacc = 0.f;
#pragma unroll
    for (int pt = 0; pt < 4; ++pt) {
        const int p = 16 * pt + pl;
        const int kqo = opaque(kq);
        float xw[8];
#pragma unroll
        for (int t = 0; t < 8; ++t) xw[t] = xdtwS[t * 64 + p];
        f32x4 yacc = {0.f, 0.f, 0.f, 0.f};
#pragma unroll
        for (int ks = 0; ks < 4; ++ks) {
            const f32x4 h0a = hc[pt][2 * ks], h0b = hc[pt][2 * ks + 1];
            yacc = __builtin_amdgcn_mfma_f32_16x16x32_bf16(pack8(h0a, h0b), cmF[ks], yacc, 0, 0, 0);
            f32x4 na = h0a * cdec, nb = h0b * cdec;
#pragma unroll
            for (int t = 0; t < 8; ++t) { na = na + *(const LAS f32x4*)(bmS + t * 132 + 32 * ks + 8 * kqo) * xw[t]; nb = nb + *(const LAS f32x4*)(bmS + t * 132 + 32 * ks + 8 * kqo + 4) * xw[t]; }
            *(f32x4*)(so + (unsigned)(p * NST + 32 * ks + 8 * kq)) = na; *(f32x4*)(so + (unsigned)(p * NST + 32 * ks + 8 * kq + 4)) = nb;
        }
#pragma unroll
        for (int r = 0; r < 4; ++r) {
            const int pp = 16 * pt + 4 * kq + r;
            float y = eacs * yacc[r] + dsk * xsS[tq * 64 + pp];
#pragma unroll
            for (int k = 0; k < 8; ++k) y += Lrow[k] * xdtS[k * 64 + pp];
            if (pl < 8) {
                const size_t grow = row0 + tq;
                const float z = bf2f(ZX[grow * ZXP + h * 64 + pp]);
                const float vv = y * silu_f(z);
                V[grow * DI + h * 64 + pp] = (bf16_t)f2bf(vv);
                ssacc += vv * vv;
            }
        }
        asm volatile("" ::: "memory");
    }
    ssacc += shx(ssacc, 16);
    ssacc += shx(ssacc, 32);
    if (lane < 8) SS[(row0 + lane) * 32 + h] = ssacc;
    wave_lds_sync();
}

__device__ __forceinline__ void scan_phase(const Frame& F, const Args& a, int jl) {
#ifndef REP_SP
#define REP_SP 1
#endif
#ifndef REP_SS
#define REP_SS 1
#endif
    for (int rep = 0; rep < REP_SP; ++rep)
    for (int u = blockIdx.x; u < PB * NHEAD; u += F.G) {
        const int x = u & 7, hi = (u >> 3) & 7, z = u >> 6, bg = x + 8 * z;
        scan_prompt_unit(F, a, jl, bg >> 2, (bg & 3) * 8 + hi);
    }
    for (int rep = 0; rep < REP_SS; ++rep)
    for (int u = F.gw; u < SB * NHEAD; u += F.ngw) scan_sample_unit(F, a, jl, u >> 5, u & 31);
    const bf16_t* ZX = (const bf16_t*)(F.ws + WS_ZX);
    for (int i = F.gw * 64 + F.lane; i < (PB + SB) * 3 * (CONVD / 4); i += F.ngw * 64) {
        const int c4 = i % (CONVD / 4), rr = (i / (CONVD / 4)) % 3, bb = i / (3 * (CONVD / 4));
        const size_t row = bb < PB ? (size_t)bb * PL + (PL - 3) + rr : (size_t)MP + (size_t)(bb - PB) * SL + (SL - 3) + rr;
        const u32x2 raw = *(const u32x2*)(ZX + row * ZXP + DI + c4 * 4);
        float* o = bb < PB ? F.out + OUT_CONV_P + (((size_t)jl * PB + bb) * 3 + rr) * CONVD + c4 * 4 : F.out + OUT_CONV_S + (((size_t)jl * SB + (bb - PB)) * 3 + rr) * CONVD + c4 * 4;
        *(f32x4*)o = (f32x4){bf2f(raw.x & 0xffffu), bf2f(raw.x >> 16), bf2f(raw.y & 0xffffu), bf2f(raw.y >> 16)};
    }
}

constexpr float ATT_C = 0.0625f * 1.4426950408889634f;
__device__ __forceinline__ void stage_256x256(LAS unsigned char* L, const bf16_t* src, int pitch, int tid) {
#pragma unroll 1
    for (int hseg = 0; hseg < 2; ++hseg) {
        u32x4 st[8];
#pragma unroll
        for (int i = 0; i < 8; ++i) { const int c = tid + NTHR * (i + 8 * hseg), row = c >> 5, ch = c & 31; st[i] = *(const u32x4*)(src + (unsigned)(row * pitch + ch * 8)); }
#pragma unroll
        for (int i = 0; i < 8; ++i) { const int c = tid + NTHR * (i + 8 * hseg), row = c >> 5, ch = c & 31; *(LAS u32x4*)(L + row * 512 + ((ch ^ (row & 15)) << 4)) = st[i]; }
    }
}
__device__ __forceinline__ void attn_prompt_wg(const Frame& F, const bf16_t* Qp, const bf16_t* Kp, const bf16_t* VTp, bf16_t* Op) {
    LAS unsigned char* L = F.lds;
    const int lane = opaque(F.lane), w = F.wave, tid = w * 64 + lane, fr = lane & 15, fq = lane >> 4;
    stage_256x256(L, Kp, D, tid);
    __syncthreads();
    bf16x8 pf[2][8];
#pragma unroll
    for (int qh = 0; qh < 2; ++qh) {
        const int qrow = qh * 128 + w * 16 + fr;
        bf16x8 qf[8];
#pragma unroll
        for (int ks = 0; ks < 8; ++ks) qf[ks] = *(const bf16x8*)(Qp + (unsigned)(qrow * D + ks * 32 + 8 * fq));
        f32x4 s[16];
#pragma unroll
        for (int kt = 0; kt < 16; ++kt) {
            f32x4 acc = {0.f, 0.f, 0.f, 0.f};
#pragma unroll
            for (int ks = 0; ks < 8; ++ks)
                acc = __builtin_amdgcn_mfma_f32_16x16x32_bf16(*(const LAS bf16x8*)(L + (kt * 16 + fr) * 512 + (((ks * 4 + fq) ^ fr) << 4)), qf[ks], acc, 0, 0, 0);
            s[kt] = acc;
            asm volatile("" ::: "memory");
        }
        float mx = -3.0e38f;
#pragma unroll
        for (int kt = 0; kt < 16; ++kt)
#pragma unroll
            for (int r = 0; r < 4; ++r) mx = fmaxf(mx, s[kt][r]);
        mx = fmaxf(mx, shx(mx, 16)); mx = fmaxf(mx, shx(mx, 32));
        float sum = 0.f;
#pragma unroll
        for (int kt = 0; kt < 16; ++kt)
#pragma unroll
            for (int r = 0; r < 4; ++r) { const float p = __builtin_amdgcn_exp2f((s[kt][r] - mx) * ATT_C); s[kt][r] = p; sum += p; }
        sum += shx(sum, 16); sum += shx(sum, 32);
        const float inv = 1.0f / sum;
#pragma unroll
        for (int k2 = 0; k2 < 8; ++k2) pf[qh][k2] = pack8(s[2 * k2] * inv, s[2 * k2 + 1] * inv);
        asm volatile("" ::: "memory");
    }
    __syncthreads();
    stage_256x256(L, VTp, 256, tid);
    __syncthreads();
    const int qrow0 = w * 16 + fr;
#pragma unroll 2
    for (int dt = 0; dt < 16; ++dt) {
        f32x4 o0 = {0.f, 0.f, 0.f, 0.f}, o1 = {0.f, 0.f, 0.f, 0.f};
#pragma unroll
        for (int k2 = 0; k2 < 8; ++k2) {
            const bf16x8 vf = *(const LAS bf16x8*)(L + (dt * 16 + fr) * 512 + (((k2 * 4 + fq) ^ fr) << 4));
            o0 = __builtin_amdgcn_mfma_f32_16x16x32_bf16(vf, pf[0][k2], o0, 0, 0, 0);
            o1 = __builtin_amdgcn_mfma_f32_16x16x32_bf16(vf, pf[1][k2], o1, 0, 0, 0);
        }
        u32x2 w0, w1; w0.x = cvt_pk_bf16(o0[0], o0[1]); w0.y = cvt_pk_bf16(o0[2], o0[3]); w1.x = cvt_pk_bf16(o1[0], o1[1]); w1.y = cvt_pk_bf16(o1[2], o1[3]);
        *(u32x2*)(Op + (unsigned)(qrow0 * D + dt * 16 + 4 * fq)) = w0;
        *(u32x2*)(Op + (unsigned)((qrow0 + 128) * D + dt * 16 + 4 * fq)) = w1;
        asm volatile("" ::: "memory");
    }
    __syncthreads();
}
constexpr int AS_STAT = MISC_OFF + 1024;
__device__ __forceinline__ void attn_sample_wg(const Frame& F, const bf16_t* Qp, const float* Kp, const float* Vp, bf16_t* Op) {
    LAS float* RED = (LAS float*)F.lds; LAS float* MXS = (LAS float*)(F.lds + AS_STAT); LAS float* SMS = MXS + 128;
    const int lane = F.lane, w = F.wave, fr = lane & 15, fq = lane >> 4;
    bf16x8 qf[8];
#pragma unroll
    for (int ks = 0; ks < 8; ++ks) qf[ks] = *(const bf16x8*)(Qp + (unsigned)((fr & 7) * D + ks * 32 + 8 * fq));
    f32x4 s[2];
#pragma unroll
    for (int x = 0; x < 2; ++x) {
        f32x4 acc = {0.f, 0.f, 0.f, 0.f};
        const float* kp = Kp + (unsigned)((w * 32 + x * 16 + fr) * D + 8 * fq);
#pragma unroll
        for (int ks = 0; ks < 8; ++ks) { const f32x4 k0 = *(const f32x4*)(kp + ks * 32), k1 = *(const f32x4*)(kp + ks * 32 + 4); acc = __builtin_amdgcn_mfma_f32_16x16x32_bf16(pack8(k0, k1), qf[ks], acc, 0, 0, 0); }
        s[x] = acc;
    }
#define AS_LOADV(dst_, db_) do { _Pragma("unroll") for (int j = 0; j < 8; ++j) { const int key = w * 32 + (j < 4 ? 4 * fq + j : 16 + 4 * fq + (j - 4)); dst_[j] = *(const f32x4*)(Vp + (unsigned)(key * D + (db_) * 64 + 4 * fr)); } } while (0)
#define AS_PROC(src_, db_) do { _Pragma("unroll") for (int i = 0; i < 4; ++i) { \
            u32x4 wv; wv.x = cvt_pk_bf16(src_[0][i], src_[1][i]); wv.y = cvt_pk_bf16(src_[2][i], src_[3][i]); wv.z = cvt_pk_bf16(src_[4][i], src_[5][i]); wv.w = cvt_pk_bf16(src_[6][i], src_[7][i]); \
            const f32x4 o = __builtin_amdgcn_mfma_f32_16x16x32_bf16(pf, __builtin_bit_cast(bf16x8, wv), (f32x4){0.f, 0.f, 0.f, 0.f}, 0, 0, 0); \
            *(LAS f32x4*)(RED + ((w * 16 + (db_) * 4 + i) * 64 + lane) * 4) = o; } } while (0)
    f32x4 va0[8], va1[8];
    AS_LOADV(va0, 0); AS_LOADV(va1, 1);
    float mx = fmaxf(fmaxf(fmaxf(s[0][0], s[0][1]), fmaxf(s[0][2], s[0][3])), fmaxf(fmaxf(s[1][0], s[1][1]), fmaxf(s[1][2], s[1][3])));
    mx = fmaxf(mx, shx(mx, 16)); mx = fmaxf(mx, shx(mx, 32));
    if (fq == 0) MXS[w * 16 + fr] = mx;
    lds_barrier();
    float gm = MXS[fr];
#pragma unroll
    for (int w2 = 1; w2 < 8; ++w2) gm = fmaxf(gm, MXS[w2 * 16 + fr]);
    float sum = 0.f;
#pragma unroll
    for (int x = 0; x < 2; ++x)
#pragma unroll
        for (int r = 0; r < 4; ++r) { const float p = __builtin_amdgcn_exp2f((s[x][r] - gm) * ATT_C); s[x][r] = p; sum += p; }
    sum += shx(sum, 16); sum += shx(sum, 32);
    if (fq == 0) SMS[w * 16 + fr] = sum;
    const bf16x8 pf = pack8(s[0], s[1]);
    {   f32x4 vb0[8], vb1[8];
        AS_LOADV(vb0, 2); AS_LOADV(vb1, 3);
        AS_PROC(va0, 0); AS_PROC(va1, 1); AS_PROC(vb0, 2); AS_PROC(vb1, 3);
    }
#undef AS_LOADV
#undef AS_PROC
    lds_barrier();
    {   const int db = w >> 1, i0 = 2 * (w & 1);
        f32x4 a0 = {0.f, 0.f, 0.f, 0.f}, a1 = {0.f, 0.f, 0.f, 0.f};
#pragma unroll
        for (int w2 = 0; w2 < 8; ++w2) { a0 = a0 + *(const LAS f32x4*)(RED + ((w2 * 16 + db * 4 + i0) * 64 + lane) * 4); a1 = a1 + *(const LAS f32x4*)(RED + ((w2 * 16 + db * 4 + i0 + 1) * 64 + lane) * 4); }
        if (fq < 2) {
#pragma unroll
            for (int r = 0; r < 4; ++r) {
                const int t = 4 * fq + r;
                float tot = 0.f;
#pragma unroll
                for (int w2 = 0; w2 < 8; ++w2) tot += SMS[w2 * 16 + t];
                const float inv = 1.0f / tot;
                *(unsigned*)(Op + (unsigned)(t * D + db * 64 + 4 * fr + i0)) = cvt_pk_bf16(a0[r] * inv, a1[r] * inv);
            }
        }
    }
    lds_barrier();
}
__device__ __forceinline__ void attn_phase(const Frame& F, const Args& a, int layer) {
    const bf16_t* Q = (const bf16_t*)(F.ws + WS_Q); bf16_t* O = (bf16_t*)(F.ws + WS_O);
    const bf16_t* KB = (const bf16_t*)(F.ws + WS_KB) + (size_t)layer * 2048 * D; const bf16_t* VT = (const bf16_t*)(F.ws + WS_VT) + (size_t)layer * 32 * 65536;
    const float* CK = a.in[I_CK] + (size_t)layer * SB * NMEM * D; const float* CV = a.in[I_CV] + (size_t)layer * SB * NMEM * D;
    for (int u = blockIdx.x; u < PB * 4 * (PL / 256); u += F.G) {
        const int x = u & 7, y = u >> 3, bh = x + 8 * (y >> 3), qb = y & 7, b = bh >> 2, h = bh & 3;
        const size_t row0 = (size_t)b * PL + qb * 256;
#ifndef NO_APW
        attn_prompt_wg(F, Q + row0 * D + h * 256, KB + (size_t)b * NMEM * D + h * 256, VT + (size_t)bh * 65536, O + row0 * D + h * 256);
#endif
    }
    Frame F2 = F; F2.tid = tid_now(F.wave); F2.lane = F2.tid & 63;
    for (int u = blockIdx.x; u < SB * 4; u += F.G) {
        const int b = u >> 2, h = u & 3; const size_t row0 = (size_t)MP + (size_t)b * SL;
#ifndef NO_ASW
        attn_sample_wg(F2, Q + row0 * D + h * 256, CK + (size_t)b * NMEM * D + h * 256, CV + (size_t)b * NMEM * D + h * 256, O + row0 * D + h * 256);
#endif
    }
}

constexpr int PH_PRO = 0, PH_KV = 1, PH_SEG0 = 2, PH_PER_SEG = 13, PH_FINAL = PH_SEG0 + 8 * PH_PER_SEG, PH_END = PH_FINAL + 1;
__global__ void __launch_bounds__(NTHR, 2) fwd(Args a) {
    extern __shared__ __attribute__((aligned(16))) unsigned char lds_raw[];
    Frame F;
    F.lds = (LAS unsigned char*)lds_raw;
    F.tid = threadIdx.x; F.lane = F.tid & 63; F.wave = __builtin_amdgcn_readfirstlane(F.tid >> 6);
    F.G = gridDim.x; F.gw = (int)blockIdx.x * NWAVES + F.wave; F.ngw = F.G * NWAVES;
    F.ws = a.ws; F.out = a.out;
    volatile LAS unsigned* MISC = (volatile LAS unsigned*)(F.lds + MISC_OFF);
    if (F.tid < 64) MISC[F.tid] = 0u;
    __syncthreads();
#if ONE_LAUNCH
    XcdBarrier bar = xcd_barrier_post((unsigned*)(a.ws + WS_CTL) + CW_BAR, MISC + 8, F.wave);
#define SEAM() xcd_barrier(bar)
#else
#define SEAM() do {} while (0)
#endif
#define PH(id) (a.ph_lo <= (id) && (id) < a.ph_hi)
#ifndef REP_SCAN
#define REP_SCAN 1
#endif
#ifndef REP_ATTN
#define REP_ATTN 1
#endif
#ifndef REP_NORM
#define REP_NORM 1
#endif
#ifndef REP_PRO
#define REP_PRO 1
#endif
#define REFRESH() do { F.tid = tid_now(F.wave); F.lane = F.tid & 63; F.ws = launder_u(a.ws); F.out = launder_f(a.out); F.gw = launder_i(F.gw); } while (0)
#define RELANE() do { F.tid = tid_now(F.wave); F.lane = F.tid & 63; } while (0)
#define WSB(off, T) ((T*)(F.ws + (off)))
#define XPTR WSB(WS_X, float)
#define SRC_P ((s == 0) ? a.in[I_XP] : (const float*)XPTR)
#define SRC_S ((s == 0) ? a.in[I_XS] : (const float*)XPTR + (size_t)MP * D)

#ifndef NO_PRO
    if (PH(PH_PRO)) for (int rep = 0; rep < REP_PRO; ++rep) { REFRESH(); p0_prologue(F, a); SEAM(); }
#endif
    const bool fill0 = (F.G == 256);
    if (PH(PH_KV)) {
        REFRESH();
        pg8::Gemm g{WSB(WS_WKV, const bf16_t), WSB(WS_WKV, const bf16_t), D, D, D, 0};
        pg8::KvOrder S{F.G, (int)blockIdx.x};
        pg8::EpiKV E{F.out + OUT_MK, F.out + OUT_MV, WSB(WS_KB, bf16_t), WSB(WS_VT, bf16_t)};
        pg8::gemm_phase<pg8::EpiKV, pg8::KvOrder, true, true>(F.lds, g, S, E, F.wave);
        if (fill0 && blockIdx.x >= 128) {
            RELANE(); Frame F2 = F; F2.gw = ((int)blockIdx.x - 128) * NWAVES + F.wave; F2.ngw = 128 * NWAVES;
            norm_phase<false>(F2, a.in[I_XP], a.in[I_XS], a.in[I_NF1], WSB(WS_U, bf16_t), WSB(WS_R, float), nullptr);
        }
        SEAM();
    }
#pragma unroll 1
    for (int s = 0; s < 8; ++s) {
        const int base = PH_SEG0 + s * PH_PER_SEG, layer = s >> 1, jl = layer >> 1;
        if (PH(base + 0) && !(fill0 && s == 0)) for (int rep = 0; rep < REP_NORM; ++rep) { REFRESH(); norm_phase<false>(F, SRC_P, SRC_S, a.in[(s & 1) ? I_NF2 : I_NF1] + layer * D, WSB(WS_U, bf16_t), WSB(WS_R, float), nullptr); SEAM(); }
#ifndef REP_GU
#define REP_GU 1
#endif
#ifndef REP_DOWN
#define REP_DOWN 1
#endif
        if (PH(base + 1)) for (int rep = 0; rep < REP_GU; ++rep) {
            REFRESH();
            pg8::Gemm g{WSB(WS_U, const bf16_t), WSB(WS_WGU + (size_t)s * SZ_WGU, const bf16_t), D, D, D, 0};
            pg8::StaticOrder S; S.init(M, 2 * FF, F.G, (int)blockIdx.x);
            pg8::EpiGU E{WSB(WS_H, bf16_t)};
            pg8::gemm_phase<pg8::EpiGU, pg8::StaticOrder, true, true>(F.lds, g, S, E, F.wave);
            SEAM();
        }
        if (PH(base + 2)) for (int rep = 0; rep < REP_DOWN; ++rep) {
            REFRESH(); const float alpha_ = (rep == REP_DOWN - 1) ? 0.5f : 0.0f;
            pg8::Gemm g{WSB(WS_H, const bf16_t), WSB(WS_WD + (size_t)s * SZ_WD, const bf16_t), FF, FF, FF, 0};
            pg8::StaticOrder S; S.init(MP, D, F.G, (int)blockIdx.x);
            pg8::EpiRes E{SRC_P, SRC_S, XPTR, alpha_, nullptr};
            pg8::Slab<MiniRes> SE{MiniRes{SRC_S - (size_t)MP * D, XPTR, alpha_, nullptr}};
            pg8::gemm_phase<pg8::EpiRes, pg8::StaticOrder, true, true, pg8::Slab<MiniRes>>(F.lds, g, S, E, F.wave, SE);
            SEAM();
        }
        if (s & 1) continue;
        if (PH(base + 3)) { REFRESH();
            if (layer & 1) norm_phase<false, false>(F, XPTR, XPTR + (size_t)MP * D, a.in[I_NMIX] + layer * D, WSB(WS_U, bf16_t), WSB(WS_R, float), nullptr);
            else norm_phase<false, true>(F, XPTR, XPTR + (size_t)MP * D, a.in[I_NMIX] + layer * D, WSB(WS_U, bf16_t), WSB(WS_R, float), nullptr);
            SEAM(); }
        if ((layer & 1) == 0) {
            if (PH(base + 4)) {
                REFRESH();
                pg8::Gemm g{WSB(WS_U, const bf16_t), WSB(WS_WIN + (size_t)jl * SZ_WIN, const bf16_t), D, D, D, 0};
                pg8::StaticOrder S; S.init(M, INP, F.G, (int)blockIdx.x);
                pg8::EpiBf16 E{WSB(WS_ZX, bf16_t), ZXP, ZXP / 256, WSB(WS_DT, float), a.in[I_DTB] + jl * 32};
                pg8::gemm_phase<pg8::EpiBf16, pg8::StaticOrder, true, true>(F.lds, g, S, E, F.wave);
                SEAM();
            }
#ifndef NO_SCAN
            if (PH(base + 12)) { REFRESH(); conv_phase(F, a, jl); SEAM(); }
            if (PH(base + 5)) for (int rep = 0; rep < REP_SCAN; ++rep) { REFRESH(); scan_phase(F, a, jl); SEAM(); }
#endif
            const bool gfold = (F.G == 256);
            if (PH(base + 6) && !gfold) { REFRESH(); gnorm_phase(F, a); SEAM(); }
            if (PH(base + 7)) {
                REFRESH();
                pg8::Gemm g{WSB(WS_V, const bf16_t), WSB(WS_WOUT + (size_t)jl * SZ_WOUT, const bf16_t), DI, DI, DI, 0};
                pg8::StaticOrder S; S.init(MP, D, F.G, (int)blockIdx.x);
                if (gfold) {
                    pg8::Unit u0; S.next(0, u0);
                    gnorm_table(F, u0.pm);
                    const LAS float* tab = (const LAS float*)(F.lds + GTAB_OFF);
                    pg8::EpiResG E{{XPTR, XPTR + (size_t)MP * D, XPTR, 1.0f, nullptr}, tab};
                    pg8::Slab<MiniRes> SE{MiniRes{XPTR, XPTR, 1.0f, nullptr}};
                    pg8::gemm_phase<pg8::EpiResG, pg8::StaticOrder, true, true, pg8::Slab<MiniRes>>(F.lds, g, S, E, F.wave, SE);
                } else {
                    pg8::EpiRes E{XPTR, XPTR + (size_t)MP * D, XPTR, 1.0f, nullptr};
                    pg8::Slab<MiniRes> SE{MiniRes{XPTR, XPTR, 1.0f, nullptr}};
                    pg8::gemm_phase<pg8::EpiRes, pg8::StaticOrder, true, true, pg8::Slab<MiniRes>>(F.lds, g, S, E, F.wave, SE);
                }
                SEAM();
            }
        } else {
#ifndef NO_POOL
            if (PH(base + 4)) { REFRESH(); pool_phase(F, a, jl, layer); SEAM(); }
#endif
            if (PH(base + 7)) {
                REFRESH();
                pg8::Gemm g{WSB(WS_Q, const bf16_t), WSB(WS_WPOOL + (size_t)jl * SZ_WPOOL, const bf16_t), 256, D, 256, 256};
                pg8::StaticOrder S; S.init(MP, D, F.G, (int)blockIdx.x);
                pg8::EpiRes E{XPTR, XPTR + (size_t)MP * D, XPTR, 1.0f, a.in[I_POOLS] + jl * D};
                pg8::Slab<MiniRes> SE{MiniRes{XPTR, XPTR, 1.0f, a.in[I_POOLS] + jl * D}};
                pg8::gemm_phase<pg8::EpiRes, pg8::StaticOrder, true, true, pg8::Slab<MiniRes>>(F.lds, g, S, E, F.wave, SE);
                SEAM();
            }
        }
        if (PH(base + 8)) for (int rep = 0; rep < REP_NORM; ++rep) { REFRESH(); norm_phase<false>(F, XPTR, XPTR + (size_t)MP * D, a.in[I_NCROSS] + layer * D, WSB(WS_U, bf16_t), WSB(WS_R, float), nullptr); SEAM(); }
        if (PH(base + 9)) {
            REFRESH();
            pg8::Gemm g{WSB(WS_U, const bf16_t), WSB(WS_WQ + (size_t)layer * SZ_WSQ, const bf16_t), D, D, D, 0};
            pg8::StaticOrder S; S.init(MP, D, F.G, (int)blockIdx.x);
            pg8::EpiBf16 E{WSB(WS_Q, bf16_t), D, -1, nullptr, nullptr};
            pg8::Slab<MiniBf16> SE{MiniBf16{WSB(WS_Q, bf16_t), D}};
            pg8::gemm_phase<pg8::EpiBf16, pg8::StaticOrder, true, true, pg8::Slab<MiniBf16>>(F.lds, g, S, E, F.wave, SE);
            SEAM();
        }
#ifndef NO_ATTN
        if (PH(base + 10)) for (int rep = 0; rep < REP_ATTN; ++rep) { REFRESH(); attn_phase(F, a, layer); SEAM(); }
#endif
        if (PH(base + 11)) {
            REFRESH();
            pg8::Gemm g{WSB(WS_O, const bf16_t), WSB(WS_WO + (size_t)layer * SZ_WSQ, const bf16_t), D, D, D, 0};
            pg8::StaticOrder S; S.init(MP, D, F.G, (int)blockIdx.x);
            pg8::EpiRes E{XPTR, XPTR + (size_t)MP * D, XPTR, 1.0f, nullptr};
            pg8::Slab<MiniRes> SE{MiniRes{XPTR, XPTR, 1.0f, nullptr}};
            pg8::gemm_phase<pg8::EpiRes, pg8::StaticOrder, true, true, pg8::Slab<MiniRes>>(F.lds, g, S, E, F.wave, SE);
            SEAM();
        }
    }
    if (PH(PH_FINAL)) { REFRESH(); norm_phase<true>(F, XPTR, XPTR + (size_t)MP * D, a.in[I_NFIN], nullptr, nullptr, F.out + OUT_Y); }
#undef PH
#undef SEAM
#undef REFRESH
#undef WSB
#undef XPTR
#undef SRC_P
#undef SRC_S
}

extern "C" void kernel_launch(void* const* d_in, const int* in_sizes, int n_in, void* d_out, int out_size, void* d_ws, size_t ws_size, hipStream_t stream) {
    static int grid = 0;
    if (grid == 0) {
        if (n_in != 34 || (size_t)out_size != OUT_END || ws_size < WS_END) { fprintf(stderr, "kernel_launch: unexpected shapes: n_in %d out %d (want %zu) ws %zu (want %zu)\n", n_in, out_size, (size_t)OUT_END, ws_size, (size_t)WS_END); grid = -1; return; }
        int dev = 0, cus = 0, per_cu = 0;
        if (hipGetDevice(&dev) != hipSuccess || hipDeviceGetAttribute(&cus, hipDeviceAttributeMultiprocessorCount, dev) != hipSuccess) { grid = -1; return; }
        if (hipFuncSetAttribute((const void*)fwd, hipFuncAttributeMaxDynamicSharedMemorySize, LDS_BYTES) != hipSuccess) { fprintf(stderr, "kernel_launch: hipFuncSetAttribute failed\n"); grid = -1; return; }
        if (hipOccupancyMaxActiveBlocksPerMultiprocessor(&per_cu, (const void*)fwd, NTHR, LDS_BYTES) != hipSuccess || per_cu < 1) { fprintf(stderr, "kernel_launch: occupancy query says %d\n", per_cu); }
        (void)hipGetLastError();
        grid = cus;
    }
    if (grid < 0) return;
    (void)hipMemsetAsync((char*)d_ws + WS_CTL, 0, CTL_ZERO_BYTES, stream);
    Args a{};
    for (int i = 0; i < 34; ++i) a.in[i] = (const float*)d_in[i];
    a.out = (float*)d_out; a.ws = (unsigned char*)d_ws;
#if ONE_LAUNCH
    a.ph_lo = 0; a.ph_hi = PH_END;
    hipLaunchKernelGGL(fwd, dim3(grid), dim3(NTHR), LDS_BYTES, stream, a);
#else
#ifndef PH_LIMIT
#define PH_LIMIT PH_END
#endif
    for (int id = 0; id < PH_END; ++id) {
        bool valid = false;
        if (id < PH_SEG0 || id == PH_FINAL) valid = true;
        else { const int s = (id - PH_SEG0) / PH_PER_SEG, k = (id - PH_SEG0) % PH_PER_SEG, layer = s >> 1;
               if (k <= 2) valid = true; else if (!(s & 1)) valid = (layer & 1) ? (k != 5 && k != 6 && k != 12) : true; }
        if (!valid) continue;
        if (id >= PH_LIMIT && id != PH_FINAL) continue;
        a.ph_lo = id; a.ph_hi = id + 1;
        hipLaunchKernelGGL(fwd, dim3(grid), dim3(NTHR), LDS_BYTES, stream, a);
    }
#endif
}
```

```cpp
#include <hip/hip_runtime.h>
#include <cstdio>
#include <cstdint>

#define GAS __attribute__((address_space(1)))
#define LAS __attribute__((address_space(3)))
typedef unsigned short bf16_t;
typedef short bf16x8 __attribute__((ext_vector_type(8)));
typedef float f32x4 __attribute__((ext_vector_type(4)));
typedef float f32x2 __attribute__((ext_vector_type(2)));
typedef unsigned u32x4 __attribute__((ext_vector_type(4)));
typedef unsigned u32x2 __attribute__((ext_vector_type(2)));

constexpr int D = 1024, FF = 2816, DI = 2048, CONVD = 3072, NHEAD = 32, HDIM = 64, NST = 128, NGRP = 4;
constexpr int INW = 5152, INP = 5376, ZXP = 5120;
constexpr int MP = 16384, MS = 1024, M = MP + MS;
constexpr int PB = 8, PL = 2048, SB = 128, SL = 8, NMEM = 256;
constexpr float EPS = 1e-5f;

__device__ __forceinline__ unsigned f2bf(float f) { unsigned u = __builtin_bit_cast(unsigned, f); return (u + 0x7fffu + ((u >> 16) & 1u)) >> 16; }
__device__ __forceinline__ float bf2f(unsigned h) { return __builtin_bit_cast(float, h << 16); }
__device__ __forceinline__ unsigned pk2(float lo, float hi) { return f2bf(lo) | (f2bf(hi) << 16); }
typedef __bf16 bf16x2_t __attribute__((ext_vector_type(2)));
__device__ __forceinline__ unsigned cvt_pk_bf16(float lo, float hi) { f32x2 v = {lo, hi}; bf16x2_t b = __builtin_convertvector(v, bf16x2_t); return __builtin_bit_cast(unsigned, b); }
__device__ __forceinline__ float fast_exp(float x) { return __builtin_amdgcn_exp2f(x * 1.4426950408889634f); }
__device__ __forceinline__ float silu_f(float x) { return x * __builtin_amdgcn_rcpf(1.0f + fast_exp(-x)); }
__device__ __forceinline__ float softplus_f(float x) { const float e = fast_exp(x); const float r = (x < -8.f) ? e : __builtin_amdgcn_logf(1.0f + e) * 0.6931471805599453f; return x > 20.f ? x : r; }
__device__ __forceinline__ int opaque(int x) { asm volatile("" : "+v"(x)); return x; }
__device__ __forceinline__ int lane_now() { int l; asm volatile("v_mbcnt_lo_u32_b32 %0, -1, 0\n\tv_mbcnt_hi_u32_b32 %0, -1, %0" : "=v"(l)); return l; }
__device__ __forceinline__ int tid_now(int wave) { return wave * 64 + lane_now(); }
__device__ __forceinline__ float shx(float v, int mask) { return __builtin_bit_cast(float, __builtin_amdgcn_ds_bpermute((lane_now() ^ mask) << 2, __builtin_bit_cast(int, v))); }
__device__ __forceinline__ float shi(float v, int src) { return __builtin_bit_cast(float, __builtin_amdgcn_ds_bpermute(src << 2, __builtin_bit_cast(int, v))); }
__device__ __forceinline__ float shup(float v, int o) { return __builtin_bit_cast(float, __builtin_amdgcn_ds_bpermute(((lane_now() - o) & 63) << 2, __builtin_bit_cast(int, v))); }
__device__ __forceinline__ float wave_sum(float v) {
#pragma unroll
    for (int o = 1; o < 64; o <<= 1) v += shx(v, o);
    return v;
}

namespace pg8 {
#define PG8_LAS __attribute__((address_space(3)))
constexpr int BM = 256, BK = 64, HALF = 128, HTB = HALF * BK * 2  , STAGE_BYTES = 8 * HTB, NXCD = 8, WGM = 8;

__host__ __device__ __forceinline__ int lds_byte(int r, int c) { const int st = (r >> 4) * 2 + (c >> 5), rr = r & 15, cc = c & 31, ob = rr * 64 + cc * 2; return st * 1024 + (ob ^ (((ob >> 9) & 1) << 5)); }
__host__ __device__ __forceinline__ void stage_rc(int b, int& R, int& C) { const int st = b / 1024, sb = b % 1024, swz = sb ^ (((sb >> 9) & 1) << 5); R = (st >> 1) * 16 + swz / 64; C = (st & 1) * 32 + (swz % 64) / 2; }
__host__ __device__ __forceinline__ int perm32(int rho) { const int n = rho >> 4, i = rho & 15; return 8 * (i >> 2) + 4 * n + (i & 3); }

struct Unit { int pm, pn; };
__host__ __device__ __forceinline__ int uni(int x) {
#if defined(__HIP_DEVICE_COMPILE__)
    x = __builtin_amdgcn_readfirstlane(x); asm volatile("" : "+s"(x)); return x;
#else
    return x;
#endif
}
struct Gemm { const bf16_t* A; const bf16_t* Bt; int K, lda, ldb, akoff; };

struct StaticOrder {
    int nM, nN, nwg, G, c;
    __host__ __device__ __forceinline__ void init(int M_, int N_, int G_, int c_) { nM = M_ / BM; nN = N_ / BM; nwg = nM * nN; G = G_; c = c_; }
    __host__ __device__ __forceinline__ bool next(int i, Unit& u) const {
        const long L = (long)i * G + c; if (L >= nwg) return false;
        int wgid = (int)L; { const int q = nwg / NXCD, r = nwg % NXCD, xcd = wgid % NXCD, off = wgid / NXCD; wgid = (xcd < r ? xcd * (q + 1) : r * (q + 1) + (xcd - r) * q) + off; }
        const int nig = WGM * nN, gid = wgid / nig, fm = gid * WGM, rem = wgid % nig;
        if (fm + WGM <= nM) { u.pm = uni(fm + rem % WGM); u.pn = uni(rem / WGM); }
        else { const int g2 = (nM % WGM) ? (nM % WGM) : 1; u.pm = uni(fm + rem % g2); u.pn = uni(rem / g2); }
        return true;
    }
};
struct KvOrder {
    int G, c;
    __host__ __device__ __forceinline__ bool next(int i, Unit& u) const {
        const int L = i * G + c; if (L >= 384) return false;
        const int l = L / 96, r = L % 96, b = r & 7, h = (r >> 3) & 3, ty = r >> 5;
        if (ty == 0) { u.pm = 32 + l * 8 + b; u.pn = l * 8 + h; } else if (ty == 1) { u.pm = 32 + l * 8 + b; u.pn = l * 8 + 4 + h; } else { u.pm = l * 8 + 4 + h; u.pn = 32 + l * 8 + b; }
        u.pm = uni(u.pm); u.pn = uni(u.pn);
        return true;
    }
};


struct EpiGU {
    static constexpr bool PERM = true;
    bf16_t* H;
    __device__ __forceinline__ void operator()(const f32x4 (&acc)[2][2][4][2], const Unit& u, int wr, int wc, int fr, int fq) const {
        const int row0 = u.pm * BM + wr * 64 + fr, col0 = u.pn * HALF + wc * 32 + 8 * fq;
#pragma unroll
        for (int ai = 0; ai < 2; ++ai)
#pragma unroll
            for (int m = 0; m < 4; ++m) {
                bf16_t* p = H + (unsigned)((row0 + ai * HALF + m * 16) * FF + col0);
                const f32x4 g0 = acc[ai][0][m][0], g1 = acc[ai][0][m][1], u0 = acc[ai][1][m][0], u1 = acc[ai][1][m][1];
                u32x4 w;
                w.x = cvt_pk_bf16(silu_f(g0[0]) * u0[0], silu_f(g0[1]) * u0[1]); w.y = cvt_pk_bf16(silu_f(g0[2]) * u0[2], silu_f(g0[3]) * u0[3]);
                w.z = cvt_pk_bf16(silu_f(g1[0]) * u1[0], silu_f(g1[1]) * u1[1]); w.w = cvt_pk_bf16(silu_f(g1[2]) * u1[2], silu_f(g1[3]) * u1[3]);
                *(u32x4*)p = w;
            }
    }
};
struct EpiRes {
    static constexpr bool PERM = false;
    const float* sp; const float* ss; float* X; float alpha; const float* scale;
    __device__ __forceinline__ void operator()(const f32x4 (&acc)[2][2][4][2], const Unit& u, int wr, int wc, int fr, int fq) const {
        const int row0 = u.pm * BM + wr * 64 + fr, col0 = u.pn * BM + wc * 32 + 4 * fq;
        const float* src = (u.pm < MP / BM) ? sp : (ss - (size_t)MP * D);
        f32x4 sc[2][2];
#pragma unroll
        for (int bj = 0; bj < 2; ++bj)
#pragma unroll
            for (int n = 0; n < 2; ++n) { sc[bj][n] = scale ? *(const f32x4*)(scale + col0 + bj * HALF + n * 16) : (f32x4){1.f, 1.f, 1.f, 1.f}; sc[bj][n] = sc[bj][n] * alpha; }
#pragma unroll
        for (int ai = 0; ai < 2; ++ai)
#pragma unroll
            for (int mp = 0; mp < 2; ++mp) {
                f32x4 v[2][2][2];
#pragma unroll
                for (int m2 = 0; m2 < 2; ++m2) { const unsigned off = (unsigned)((row0 + ai * HALF + (2 * mp + m2) * 16) * D + col0);
#pragma unroll
                    for (int bj = 0; bj < 2; ++bj)
#pragma unroll
                        for (int n = 0; n < 2; ++n) v[m2][bj][n] = *(const f32x4*)(src + (off + bj * HALF + n * 16)); }
#pragma unroll
                for (int m2 = 0; m2 < 2; ++m2) { const unsigned off = (unsigned)((row0 + ai * HALF + (2 * mp + m2) * 16) * D + col0);
#pragma unroll
                    for (int bj = 0; bj < 2; ++bj)
#pragma unroll
                        for (int n = 0; n < 2; ++n) *(f32x4*)(X + (off + bj * HALF + n * 16)) = v[m2][bj][n] + acc[ai][bj][2 * mp + m2][n] * sc[bj][n]; }
            }
    }
};
template <class T, class = void> struct epi_groups { static constexpr bool value = false; };
template <class T> struct epi_groups<T, decltype((void)T::GROUPS)> { static constexpr bool value = T::GROUPS; };
struct EpiResG : EpiRes {
    static constexpr bool GROUPS = true;
    const PG8_LAS float* tab;
    __device__ __forceinline__ void rescale_slab(f32x4 (&sa)[2], int gi, int fr) const { const float f = tab[(256 + fr) * 4 + gi]; sa[0] = sa[0] * f; sa[1] = sa[1] * f; }
    __device__ __forceinline__ void rescale(f32x4 (&acc)[2][2][4][2], int gi, int wr, int fr) const {
        const PG8_LAS float* t0 = tab + opaque((wr * 64 + fr) * 4 + gi);
#pragma unroll
        for (int ai = 0; ai < 2; ++ai)
#pragma unroll
            for (int m = 0; m < 4; ++m) {
                const float f = t0[(ai * HALF + m * 16) * 4];
#pragma unroll
                for (int bj = 0; bj < 2; ++bj)
#pragma unroll
                    for (int n = 0; n < 2; ++n) acc[ai][bj][m][n] = acc[ai][bj][m][n] * f;
            }
    }
};
struct EpiBf16 {
    static constexpr bool PERM = true;
    bf16_t* O; int ldc; int dt_tile; float* DT; const float* dt_bias;
    __device__ __forceinline__ void operator()(const f32x4 (&acc)[2][2][4][2], const Unit& u, int wr, int wc, int fr, int fq) const {
        const int row0 = u.pm * BM + wr * 64 + fr;
        if (u.pn == dt_tile) {
            if (wc == 0) {
#pragma unroll
                for (int n = 0; n < 2; ++n) { const f32x4 bv = *(const f32x4*)(dt_bias + 8 * fq + 4 * n);
#pragma unroll
                    for (int ai = 0; ai < 2; ++ai)
#pragma unroll
                        for (int m = 0; m < 4; ++m) { f32x4 v = acc[ai][0][m][n] + bv, o;
#pragma unroll
                            for (int i = 0; i < 4; ++i) o[i] = softplus_f(v[i]);
                            *(f32x4*)(DT + (unsigned)((row0 + ai * HALF + m * 16) * 32 + 8 * fq + 4 * n)) = o; } }
            }
            return;
        }
        const int col0 = u.pn * BM + wc * 32 + 8 * fq;
#pragma unroll
        for (int ai = 0; ai < 2; ++ai)
#pragma unroll
            for (int m = 0; m < 4; ++m) { bf16_t* rowp = O + (unsigned)((row0 + ai * HALF + m * 16) * ldc + col0);
#pragma unroll
                for (int bj = 0; bj < 2; ++bj) { const f32x4 v0 = acc[ai][bj][m][0], v1 = acc[ai][bj][m][1];
                    u32x4 w; w.x = cvt_pk_bf16(v0[0], v0[1]); w.y = cvt_pk_bf16(v0[2], v0[3]); w.z = cvt_pk_bf16(v1[0], v1[1]); w.w = cvt_pk_bf16(v1[2], v1[3]);
                    *(u32x4*)(rowp + bj * HALF) = w; } }
    }
};
struct EpiKV {
    static constexpr bool PERM = false;
    float* outK; float* outV; bf16_t* KB; bf16_t* VT;
    __device__ __forceinline__ void operator()(const f32x4 (&acc)[2][2][4][2], const Unit& u, int wr, int wc, int fr, int fq) const {
        const bool nat = u.pm >= 32;
        const int l = nat ? (u.pm - 32) >> 3 : u.pm >> 3, b = (nat ? u.pm - 32 : u.pn - 32) & 7, j = (nat ? u.pn : u.pm) & 7, h = j & 3;
        const bool wf = nat, wb = !(nat && j >= 4);
        const size_t boff = ((size_t)l * 2048 + b * 256) * D + h * 256;
        float* outp = (j >= 4 ? outV : outK) + boff;
        bf16_t* cp = nat ? KB + boff : VT + (size_t)((l * 8 + b) * 4 + h) * 65536;
        const int dl = wc * 32 + 4 * fq, rpitch = nat ? D : 256;
        int coff[2][2];
#pragma unroll
        for (int bj = 0; bj < 2; ++bj)
#pragma unroll
            for (int n = 0; n < 2; ++n) { const int kc = dl + bj * HALF + n * 16; coff[bj][n] = nat ? kc : ((kc & ~31) | (((kc >> 2) & 3) << 3) | (((kc >> 4) & 1) << 2)); }
#pragma unroll
        for (int ai = 0; ai < 2; ++ai)
#pragma unroll
            for (int m = 0; m < 4; ++m) {
                const int rowoff = (ai * HALF + wr * 64 + m * 16 + fr) * rpitch;
#pragma unroll
                for (int bj = 0; bj < 2; ++bj)
#pragma unroll
                    for (int n = 0; n < 2; ++n) {
                        const f32x4 v = acc[ai][bj][m][n];
                        const unsigned off = (unsigned)(rowoff + coff[bj][n]);
                        if (wf) *(f32x4*)(outp + off) = v;
                        if (wb) { u32x2 w; w.x = cvt_pk_bf16(v[0], v[1]); w.y = cvt_pk_bf16(v[2], v[3]); *(u32x2*)(cp + off) = w; }
                    }
            }
    }
};
constexpr int SLB_OFF = 131072 + 10240;
struct NoSlab { static constexpr bool ON = false; };
template <class E2> struct Slab { static constexpr bool ON = true; E2 e; };
template <class Epi, class Sched, bool ALIGN_EPI = false, bool SP2 = false, class SlabT = NoSlab>
__device__ __forceinline__ void gemm_phase(PG8_LAS unsigned char* lds, const Gemm g, const Sched& S, const Epi& E, int wave_, const SlabT& SL = SlabT{}) {
    static_assert(!SlabT::ON || SP2, "the slab rides in the SP2 schedule only");
    int tid_ = tid_now(wave_);
    const int tid = tid_, wid = __builtin_amdgcn_readfirstlane(tid >> 6), lane = tid & 63, wr = wid >> 2, wc = wid & 3, fr = lane & 15, fq = lane >> 4;
    const int K = g.K, nt = K / BK;
    unsigned voffA[2], voffB[2];
#pragma unroll
    for (int i = 0; i < 2; ++i) { int R, C; stage_rc(tid * 16 + i * 8192, R, C); const int Rb = Epi::PERM ? ((R & ~31) + perm32(R & 31)) : R;
        voffA[i] = (unsigned)(R * g.lda + C) * 2u; voffB[i] = (unsigned)(Rb * g.ldb + C) * 2u; }
    unsigned voffS = 0;
    if constexpr (SlabT::ON) { const int r = 2 * wid + (lane >> 5), p = lane & 31, c = (p >> 2) ^ (r & 7); voffS = (unsigned)(r * g.lda) * 2u + (unsigned)(c * 4 + (p & 3)) * 4u; }
    const int soff = (lane & 15) * 128, sq = lane >> 4, s7 = lane & 7;
    const size_t kstep = (size_t)(BK * 2);
    const size_t hstepA = (size_t)HALF * g.lda * 2, hstepB = (size_t)HALF * g.ldb * 2;
    const size_t tstepA = 2 * hstepA, tstepB = 2 * hstepB, akoffb = (size_t)g.akoff * 2;
    const unsigned ldsw = (unsigned)wid * 1024u;
    const int aoff = lds_byte(wr * 64 + fr, fq * 8), boff = lds_byte(wc * 32 + fr, fq * 8);
#define PG8_SA(b, h) (((b) * 2 + (h)) * HTB)
#define PG8_SB(b, h) ((4 + (b) * 2 + (h)) * HTB)
#define PG8_STAGE(bufoff, gbase, voff) do { _Pragma("unroll") for (int _i = 0; _i < 2; ++_i) \
        __builtin_amdgcn_global_load_lds((const unsigned*)((const char*)(gbase) + (voff)[_i]), (PG8_LAS unsigned*)(lds + (bufoff) + ldsw + _i * 8192), 16, 0, 0); } while (0)
#define PG8_LDA(dst, b, h) do { _Pragma("unroll") for (int m = 0; m < 4; ++m) _Pragma("unroll") for (int k = 0; k < 2; ++k) dst[m][k] = *(const PG8_LAS bf16x8*)(lds + PG8_SA(b, h) + aoff + m * 2048 + k * 1024); } while (0)
#define PG8_LDB(dst, b, h) do { _Pragma("unroll") for (int n = 0; n < 2; ++n) _Pragma("unroll") for (int k = 0; k < 2; ++k) dst[n][k] = *(const PG8_LAS bf16x8*)(lds + PG8_SB(b, h) + boff + n * 2048 + k * 1024); } while (0)
#define PG8_MMA(ai, bj, At, Bt) do { __builtin_amdgcn_s_setprio(1); _Pragma("unroll") for (int m = 0; m < 4; ++m) _Pragma("unroll") for (int n = 0; n < 2; ++n) _Pragma("unroll") for (int k = 0; k < 2; ++k) \
        acc[ai][bj][m][n] = __builtin_amdgcn_mfma_f32_16x16x32_bf16(Bt[n][k], At[m][k], acc[ai][bj][m][n], 0, 0, 0); __builtin_amdgcn_s_setprio(0); } while (0)
#define PG8_STAGE_S(b, gbase) do { if constexpr (SlabT::ON) __builtin_amdgcn_global_load_lds((const unsigned*)((const char*)(gbase) + voffS), (PG8_LAS unsigned*)(lds + SLB_OFF + (b) * 2048 + wid * 256), 4, 0, 0); } while (0)
#define PG8_LDS_S(b) do { if constexpr (SlabT::ON) { _Pragma("unroll") for (int k = 0; k < 2; ++k) SAf[k] = *(const PG8_LAS bf16x8*)(lds + SLB_OFF + (b) * 2048 + soff + (((4 * k + sq) ^ s7) << 4)); } } while (0)
#define PG8_MMA_S() do { if constexpr (SlabT::ON) { __builtin_amdgcn_s_setprio(1); if (wr == 0) { _Pragma("unroll") for (int n = 0; n < 2; ++n) _Pragma("unroll") for (int k = 0; k < 2; ++k) sacc[n] = __builtin_amdgcn_mfma_f32_16x16x32_bf16(B0[n][k], SAf[k], sacc[n], 0, 0, 0); } \
        else { _Pragma("unroll") for (int n = 0; n < 2; ++n) _Pragma("unroll") for (int k = 0; k < 2; ++k) sacc[n] = __builtin_amdgcn_mfma_f32_16x16x32_bf16(B1[n][k], SAf[k], sacc[n], 0, 0, 0); } __builtin_amdgcn_s_setprio(0); } } while (0)
#define PG8_WAIT_V8() do { if constexpr (SlabT::ON) asm volatile("s_waitcnt vmcnt(9)" ::: "memory"); else asm volatile("s_waitcnt vmcnt(8)" ::: "memory"); } while (0)
#define PG8_WAIT_V(n) asm volatile("s_waitcnt vmcnt(" #n ")" ::: "memory")
#define PG8_WAIT_L(n) asm volatile("s_waitcnt lgkmcnt(" #n ")" ::: "memory")
#define PG8_BAR __builtin_amdgcn_s_barrier()
#define PG8_SCHED __builtin_amdgcn_sched_barrier(0)
    Unit cur, nxt; int ui = 0;
    if (!S.next(0, cur)) return;
    f32x4 acc[2][2][4][2];
#pragma unroll
    for (int a = 0; a < 2; ++a)
#pragma unroll
        for (int b = 0; b < 2; ++b)
#pragma unroll
            for (int m = 0; m < 4; ++m)
#pragma unroll
                for (int n = 0; n < 2; ++n) acc[a][b][m][n] = (f32x4){0.f, 0.f, 0.f, 0.f};
    bf16x8 At[4][2], B0[2][2], B1[2][2];
    f32x4 sacc[2] = {{0.f, 0.f, 0.f, 0.f}, {0.f, 0.f, 0.f, 0.f}}; bf16x8 SAf[2];
    (void)sacc; (void)SAf; (void)soff; (void)sq; (void)s7; (void)voffS;
    const char* cA = (const char*)g.A + (size_t)cur.pm * tstepA + (size_t)cur.pn * akoffb; const char* cB = (const char*)g.Bt + (size_t)cur.pn * tstepB;
    const size_t sstep = (size_t)16 * g.lda * 2, sbase = (size_t)MP * g.lda * 2;
    const char* cS = (const char*)g.A + sbase + (size_t)cur.pm * sstep + (size_t)cur.pn * akoffb;
    if constexpr (SP2) {
        PG8_STAGE_S(0, cS);
        PG8_STAGE(PG8_SB(0, 0), cB, voffB); PG8_STAGE(PG8_SB(0, 1), cB + hstepB, voffB); PG8_STAGE(PG8_SA(0, 0), cA, voffA); PG8_STAGE(PG8_SA(0, 1), cA + hstepA, voffA);
        if (wr == 1) PG8_BAR;
        PG8_WAIT_V(2); PG8_BAR;
        PG8_STAGE_S(1, cS + kstep);
        PG8_STAGE(PG8_SB(1, 0), cB + kstep, voffB); PG8_STAGE(PG8_SA(1, 0), cA + kstep, voffA); PG8_STAGE(PG8_SB(1, 1), cB + hstepB + kstep, voffB);
        PG8_WAIT_V(6); PG8_BAR;
    } else {
        PG8_STAGE(PG8_SB(0, 0), cB, voffB); PG8_STAGE(PG8_SA(0, 0), cA, voffA); PG8_STAGE(PG8_SB(0, 1), cB + hstepB, voffB); PG8_STAGE(PG8_SA(0, 1), cA + hstepA, voffA);
        if (wr == 1) PG8_BAR;
        PG8_WAIT_V(4); PG8_BAR;
        PG8_STAGE(PG8_SB(1, 0), cB + kstep, voffB); PG8_STAGE(PG8_SA(1, 0), cA + kstep, voffA); PG8_STAGE(PG8_SB(1, 1), cB + hstepB + kstep, voffB);
        PG8_WAIT_V(6); PG8_BAR;
    }
    for (;;) {
        const bool has_next = S.next(ui + 1, nxt);
        const char* nA = has_next ? (const char*)g.A + (size_t)nxt.pm * tstepA + (size_t)nxt.pn * akoffb : cA; const char* nB = has_next ? (const char*)g.Bt + (size_t)nxt.pn * tstepB : cB;
        const char* nS = has_next ? (const char*)g.A + sbase + (size_t)nxt.pm * sstep + (size_t)nxt.pn * akoffb : cS;
        const int tspan = epi_groups<Epi>::value ? 8 : nt;
        for (int tg = 0; tg < nt; tg += tspan) {
        if constexpr (epi_groups<Epi>::value) { if (tg != 0) { const int lh = lane_now() & 15; E.rescale(acc, (tg >> 3) - 1, wr, lh); if constexpr (SlabT::ON) E.rescale_slab(sacc, (tg >> 3) - 1, lh); } }
        for (int t = tg; t < tg + tspan; t += 2) {
            const bool last = (t == nt - 2);
            const char* a1 = cA + (size_t)(t + 1) * kstep;
            const char* a2 = last ? nA : cA + (size_t)(t + 2) * kstep; const char* b2 = last ? nB : cB + (size_t)(t + 2) * kstep;
            const char* a3 = a2 + kstep; const char* b3 = b2 + kstep;
            const char* s2 = last ? nS : cS + (size_t)(t + 2) * kstep; const char* s3 = s2 + kstep; (void)s3;
            if constexpr (SP2) {
            PG8_LDB(B0, 0, 0); PG8_LDB(B1, 0, 1); PG8_SCHED; PG8_LDA(At, 0, 0); PG8_LDS_S(0); PG8_STAGE(PG8_SA(1, 1), a1 + hstepA, voffA);
            PG8_WAIT_V8(); PG8_WAIT_L(0); PG8_BAR; PG8_MMA(0, 0, At, B0); PG8_MMA(0, 1, At, B1); PG8_MMA_S(); PG8_BAR; PG8_SCHED;
            PG8_LDA(At, 0, 1); PG8_STAGE_S(0, s2); PG8_STAGE(PG8_SB(0, 0), b2, voffB); PG8_STAGE(PG8_SB(0, 1), b2 + hstepB, voffB); PG8_STAGE(PG8_SA(0, 0), a2, voffA);
            PG8_WAIT_V8(); PG8_WAIT_L(0); PG8_BAR; PG8_MMA(1, 0, At, B0); PG8_MMA(1, 1, At, B1); PG8_BAR; PG8_SCHED;
            PG8_LDB(B0, 1, 0); PG8_LDB(B1, 1, 1); PG8_SCHED; PG8_LDA(At, 1, 0); PG8_LDS_S(1); PG8_STAGE(PG8_SA(0, 1), a2 + hstepA, voffA);
            PG8_WAIT_V8(); PG8_WAIT_L(0); PG8_BAR; PG8_MMA(0, 0, At, B0); PG8_MMA(0, 1, At, B1); PG8_MMA_S(); PG8_BAR; PG8_SCHED;
            PG8_LDA(At, 1, 1); PG8_STAGE_S(1, s3); PG8_STAGE(PG8_SB(1, 0), b3, voffB); PG8_STAGE(PG8_SB(1, 1), b3 + hstepB, voffB); PG8_STAGE(PG8_SA(1, 0), a3, voffA);
            PG8_WAIT_V8(); PG8_WAIT_L(0); PG8_BAR; PG8_MMA(1, 0, At, B0); PG8_MMA(1, 1, At, B1); PG8_BAR; PG8_SCHED;
            } else {
            PG8_LDB(B0, 0, 0); PG8_SCHED; PG8_LDA(At, 0, 0); PG8_STAGE(PG8_SA(1, 1), a1 + hstepA, voffA);
            PG8_WAIT_L(8); PG8_BAR; PG8_WAIT_L(0); PG8_MMA(0, 0, At, B0); PG8_BAR; PG8_SCHED;
            PG8_LDB(B1, 0, 1); PG8_STAGE(PG8_SB(0, 0), b2, voffB);
            PG8_BAR; PG8_WAIT_L(0); PG8_MMA(0, 1, At, B1); PG8_BAR;
            PG8_LDA(At, 0, 1); PG8_STAGE(PG8_SA(0, 0), a2, voffA);
            PG8_BAR; PG8_WAIT_L(0); PG8_MMA(1, 0, At, B0); PG8_BAR; PG8_SCHED;
            PG8_STAGE(PG8_SB(0, 1), b2 + hstepB, voffB);
            PG8_WAIT_V(6); PG8_BAR; PG8_MMA(1, 1, At, B1); PG8_BAR;
            PG8_LDB(B0, 1, 0); PG8_SCHED; PG8_LDA(At, 1, 0); PG8_STAGE(PG8_SA(0, 1), a2 + hstepA, voffA);
            PG8_WAIT_L(8); PG8_BAR; PG8_WAIT_L(0); PG8_MMA(0, 0, At, B0); PG8_BAR; PG8_SCHED;
            PG8_LDB(B1, 1, 1); PG8_STAGE(PG8_SB(1, 0), b3, voffB);
            PG8_BAR; PG8_WAIT_L(0); PG8_MMA(0, 1, At, B1); PG8_BAR;
            PG8_LDA(At, 1, 1); PG8_STAGE(PG8_SA(1, 0), a3, voffA);
            PG8_BAR; PG8_WAIT_L(0); PG8_MMA(1, 0, At, B0); PG8_BAR; PG8_SCHED;
            PG8_STAGE(PG8_SB(1, 1), b3 + hstepB, voffB);
            PG8_WAIT_V(6); PG8_BAR; PG8_MMA(1, 1, At, B1); PG8_BAR;
            }
        }
        }
        if constexpr (ALIGN_EPI) { if (wr == 0) PG8_BAR; }
        const int le = lane_now();
        if constexpr (epi_groups<Epi>::value) E.rescale(acc, 3, wr, le & 15);
        E(acc, cur, wr, wc, le & 15, le >> 4);
        if constexpr (SlabT::ON) {
            if constexpr (epi_groups<Epi>::value) E.rescale_slab(sacc, 3, le & 15);
            const int srow = MP + 16 * cur.pm + (le & 15), scol = cur.pn * BM + wr * HALF + wc * 32 + (Epi::PERM ? 8 * (le >> 4) : 4 * (le >> 4));
#pragma unroll
            for (int n = 0; n < 2; ++n) { SL.e(srow, scol + (Epi::PERM ? 4 * n : 16 * n), sacc[n]); sacc[n] = (f32x4){0.f, 0.f, 0.f, 0.f}; }
        }
        if (!has_next) break;
#pragma unroll
        for (int a = 0; a < 2; ++a)
#pragma unroll
            for (int b = 0; b < 2; ++b)
#pragma unroll
                for (int m = 0; m < 4; ++m)
#pragma unroll
                    for (int n = 0; n < 2; ++n) acc[a][b][m][n] = (f32x4){0.f, 0.f, 0.f, 0.f};
        cur = nxt; cA = nA; cB = nB; ++ui;
        if constexpr (ALIGN_EPI) { if (wr == 1) PG8_BAR; }
    }
    PG8_WAIT_V(0);
    if constexpr (!ALIGN_EPI) { if (wr == 0) PG8_BAR; }
    PG8_BAR;
#undef PG8_SA
#undef PG8_SB
#undef PG8_STAGE
#undef PG8_LDA
#undef PG8_LDB
#undef PG8_MMA
#undef PG8_WAIT_V
#undef PG8_STAGE_S
#undef PG8_LDS_S
#undef PG8_MMA_S
#undef PG8_WAIT_V8
#undef PG8_WAIT_L
#undef PG8_BAR
#undef PG8_SCHED
}
}


constexpr int NWAVES = 8, NTHR = NWAVES * 64;
constexpr int RING_BYTES = 131072, MISC_OFF = RING_BYTES, LDS_BYTES = 147456;
#ifndef ONE_LAUNCH
#define ONE_LAUNCH 1
#endif

constexpr size_t al256(size_t x) { return (x + 255) & ~(size_t)255; }
constexpr size_t WS_CTL = 0, CTL_ZERO_BYTES = 1u << 20;
constexpr size_t SZ_WGU = (size_t)2 * FF * D * 2, SZ_WD = (size_t)D * FF * 2, SZ_WIN = (size_t)INP * D * 2, SZ_WOUT = (size_t)D * DI * 2, SZ_WSQ = (size_t)D * D * 2, SZ_WPOOL = (size_t)D * 256 * 2;
constexpr size_t WS_WGU = CTL_ZERO_BYTES;
constexpr size_t WS_WD = WS_WGU + 8 * SZ_WGU;
constexpr size_t WS_WIN = WS_WD + 8 * SZ_WD;
constexpr size_t WS_WOUT = WS_WIN + 2 * SZ_WIN;
constexpr size_t WS_WQ = WS_WOUT + 2 * SZ_WOUT;
constexpr size_t WS_WKV = WS_WQ + 4 * SZ_WSQ;
constexpr size_t WS_MN = WS_WKV + 8 * SZ_WSQ;
constexpr size_t WS_WO = WS_MN + 8 * SZ_WSQ;
constexpr size_t WS_WPOOL = WS_WO + 4 * SZ_WSQ;
constexpr size_t WS_X = al256(WS_WPOOL + 2 * SZ_WPOOL);
constexpr size_t WS_U = WS_X + (size_t)M * D * 4;
constexpr size_t WS_H = WS_U + (size_t)M * D * 2;
constexpr size_t WS_ZX = WS_H + (size_t)M * FF * 2;
constexpr size_t WS_DT = WS_ZX + (size_t)M * ZXP * 2;
constexpr size_t WS_SS = WS_DT + (size_t)M * 32 * 4;
constexpr size_t WS_V = WS_SS + (size_t)M * 32 * 4;
constexpr size_t WS_Q = WS_V + (size_t)M * DI * 2;
constexpr size_t WS_O = WS_Q + (size_t)M * D * 2;
constexpr size_t WS_R = WS_O + (size_t)M * D * 2;
constexpr size_t WS_KB = al256(WS_R + (size_t)M * 4);
constexpr size_t WS_VT = WS_KB + 4 * (size_t)2048 * D * 2;
constexpr size_t WS_XBC = WS_VT + 4 * (size_t)2048 * D * 2;
constexpr size_t WS_END = WS_XBC + (size_t)M * CONVD * 2;
constexpr int CW_BAR = 4096;

constexpr size_t OUT_Y = 0;
constexpr size_t OUT_SSM_P = (size_t)M * D;
constexpr size_t OUT_CONV_P = OUT_SSM_P + (size_t)2 * PB * NHEAD * HDIM * NST;
constexpr size_t OUT_POOL_P = OUT_CONV_P + (size_t)2 * PB * 3 * CONVD;
constexpr size_t OUT_MK = OUT_POOL_P + (size_t)2 * PB * 15 * D;
constexpr size_t OUT_MV = OUT_MK + (size_t)4 * PB * NMEM * D;
constexpr size_t OUT_SSM_S = OUT_MV + (size_t)4 * PB * NMEM * D;
constexpr size_t OUT_CONV_S = OUT_SSM_S + (size_t)2 * SB * NHEAD * HDIM * NST;
constexpr size_t OUT_POOL_S = OUT_CONV_S + (size_t)2 * SB * 3 * CONVD;
constexpr size_t OUT_END = OUT_POOL_S + (size_t)2 * SB * 15 * D;

#define XB_TMO      128
#define XB_XCNT(j)  (256  + 64 * (j))
#define XB_XSUB(j)  (1280 + 64 * (j))
#define XB_XGEN(j)  (2304 + 64 * (j))
#define XB_TOP      3328
#define XB_TOPGEN   3392
#define XCD_BAR_WORDS 3456
#define XB_SPIN_CAP (1u << 18)
__device__ __forceinline__ unsigned xb_ld(unsigned* p)              { return __hip_atomic_load(p, __ATOMIC_RELAXED, __HIP_MEMORY_SCOPE_AGENT); }
__device__ __forceinline__ unsigned xb_add(unsigned* p, unsigned v) { return __hip_atomic_fetch_add(p, v, __ATOMIC_RELAXED, __HIP_MEMORY_SCOPE_AGENT); }
__device__ __forceinline__ unsigned xb_xcc_id() { return (unsigned)__builtin_amdgcn_s_getreg((3 << 11) | 20) & 0xFu; }
#define XB_SPIN(cond, bar) do { unsigned _sp = 0; while (cond) { __builtin_amdgcn_s_sleep(1); \
    if ((++_sp & 255u) == 0u) { if (xb_ld(&(bar)[XB_TMO])) break; if (_sp > XB_SPIN_CAP) { atomicAdd(&(bar)[XB_TMO], 1u); break; } } } } while (0)
struct XcdBarrier { unsigned* bar; unsigned x; volatile LAS unsigned* st; int wave; };
__device__ __forceinline__ XcdBarrier xcd_barrier_post(unsigned* bar, volatile LAS unsigned* st, int wave) {
    XcdBarrier b; b.bar = bar; b.x = xb_xcc_id(); b.st = st; b.wave = wave;
    if (threadIdx.x == 0) (void)xb_add(&bar[XB_XCNT(b.x)], 1u);
    return b;
}
__device__ __forceinline__ void xcd_barrier_complete(unsigned* bar, unsigned x, unsigned& nloc, unsigned& nx) {
    const unsigned G = gridDim.x * gridDim.y * gridDim.z;
    unsigned sum, cnt, mine, sp = 0u;
    for (;;) {
        sum = 0u; cnt = 0u; mine = 0u;
#pragma unroll
        for (unsigned j = 0; j < 16; ++j) { const unsigned c = xb_ld(&bar[XB_XCNT(j)]); sum += c; cnt += (c > 0u) ? 1u : 0u; mine = (j == x) ? c : mine; }
        if (sum == G) break;
        __builtin_amdgcn_s_sleep(1);
        if ((++sp & 255u) == 0u) { if (xb_ld(&bar[XB_TMO])) break; if (sp > XB_SPIN_CAP) { atomicAdd(&bar[XB_TMO], 1u); break; } }
    }
    nloc = mine > 0u ? mine : 1u; nx = cnt > 0u ? cnt : 1u;
}
__device__ __forceinline__ void xcd_barrier(const XcdBarrier& b) {
    asm volatile("s_waitcnt vmcnt(0)" ::: "memory");
    __syncthreads();
    if (b.wave == 0 && lane_now() == 0) {
        unsigned* bar = b.bar;
        __builtin_amdgcn_s_waitcnt(0);
        unsigned nloc = b.st[0], nx = b.st[1];
        if (nloc == 0u) { xcd_barrier_complete(bar, b.x, nloc, nx); b.st[0] = nloc; b.st[1] = nx; }
        const unsigned old = xb_add(&bar[XB_XSUB(b.x)], 1u);
        const unsigned gen = old / nloc;
        if (old + 1u == (gen + 1u) * nloc) {
            __builtin_amdgcn_fence(__ATOMIC_RELEASE, "agent");
            asm volatile("s_waitcnt vmcnt(0)" ::: "memory");
            const unsigned og = xb_add(&bar[XB_TOP], 1u);
            const unsigned tg = og / nx;
            if (og + 1u == (tg + 1u) * nx) xb_add(&bar[XB_TOPGEN], 1u);
            else XB_SPIN(xb_ld(&bar[XB_TOPGEN]) == tg, bar);
            __builtin_amdgcn_fence(__ATOMIC_ACQUIRE, "agent");
            xb_add(&bar[XB_XGEN(b.x)], 1u);
            asm volatile("s_waitcnt vmcnt(0)" ::: "memory");
        } else {
            XB_SPIN(xb_ld(&bar[XB_XGEN(b.x)]) == gen, bar);
            __builtin_amdgcn_fence(__ATOMIC_ACQUIRE, "agent");
            asm volatile("s_waitcnt vmcnt(0)" ::: "memory");
        }
    }
    __syncthreads();
}

struct Args { const float* in[34]; float* out; unsigned char* ws; int ph_lo, ph_hi; };
enum { I_XP = 0, I_XS, I_MEM, I_CK, I_CV, I_SSM, I_SCONV, I_SPOOL, I_NF1, I_G1, I_U1, I_D1, I_NMIX, I_INW, I_CONVW, I_CONVB, I_DTB, I_ALOG, I_DSKIP, I_SNORM, I_OUTW,
       I_POOLW, I_POOLS, I_NCROSS, I_NMEM, I_WQ, I_WK, I_WV, I_WO, I_NF2, I_G2, I_U2, I_D2, I_NFIN };

struct Frame { LAS unsigned char* lds; unsigned char* ws; float* out; int tid, lane, wave, G, gw, ngw; };
__device__ __forceinline__ unsigned char* launder_u(unsigned char* p) { GAS unsigned char* g = (GAS unsigned char*)p; asm volatile("" : "+s"(g)); return (unsigned char*)g; }
__device__ __forceinline__ int launder_i(int x) { asm volatile("" : "+s"(x)); return x; }
__device__ __forceinline__ float* launder_f(float* p) { GAS float* g = (GAS float*)p; asm volatile("" : "+s"(g)); return (float*)g; }

__device__ __forceinline__ void transpose_item(const float* W, int ldw, int k0, int n0, bf16_t* WT, int ldt, int drow0, const float* ks, LAS float* scr, int lane) {
    { const int r8 = lane >> 3, c4 = lane & 7;
      f32x4 v[8];
#pragma unroll
      for (int i = 0; i < 8; ++i) v[i] = *(const f32x4*)(W + (size_t)(k0 + 8 * i + r8) * ldw + n0 + 4 * c4);
#pragma unroll
      for (int i = 0; i < 8; ++i) { const int kk = 8 * i + r8; f32x4 x = v[i]; if (ks) x = x * ks[k0 + kk];
          LAS float* d = scr + kk * 33 + 4 * c4; d[0] = x[0]; d[1] = x[1]; d[2] = x[2]; d[3] = x[3]; } }
    asm volatile("s_waitcnt lgkmcnt(0)" ::: "memory");
    const int c = lane & 7;
#pragma unroll
    for (int j = 0; j < 4; ++j) { const int n = (lane >> 3) + 8 * j; const LAS float* s = scr + (8 * c) * 33 + n;
        u32x4 o; o.x = pk2(s[0 * 33], s[1 * 33]); o.y = pk2(s[2 * 33], s[3 * 33]); o.z = pk2(s[4 * 33], s[5 * 33]); o.w = pk2(s[6 * 33], s[7 * 33]);
        *(u32x4*)(WT + (size_t)(drow0 + n) * ldt + k0 + 8 * c) = o; }
    asm volatile("s_waitcnt lgkmcnt(0)" ::: "memory");
}
__device__ __forceinline__ void p0_prologue(const Frame& F, const Args& a) {
    unsigned char* ws = F.ws;
    LAS float* scr = (LAS float*)(F.lds + F.wave * 16384);
    constexpr int I_GU = (D / 64) * (FF / 32), I_DN = (FF / 64) * (D / 32), I_IN = (D / 64) * (INW / 32), I_OUT = (DI / 64) * (D / 32), I_SQ = (D / 64) * (D / 32), I_PL = (256 / 64) * (256 / 32);
    constexpr int C0 = 16 * I_GU, C1 = C0 + 8 * I_DN, C2 = C1 + 2 * I_IN, C3 = C2 + 2 * I_OUT, C4 = C3 + 16 * I_SQ, C5 = C4 + 8 * I_PL;
    for (int it = F.gw; it < C5; it += F.ngw) {
        int r = it;
        if (r < C0) {
            const int q = r / I_GU, e = r % I_GU, which = q >> 2, layer = q & 3, kb = e / (FF / 32), nb = e % (FF / 32);
            const float* W = a.in[which == 0 ? I_G1 : which == 1 ? I_U1 : which == 2 ? I_G2 : I_U2] + (size_t)layer * D * FF;
            const int s = layer * 2 + (which >> 1), n0 = nb * 32, drow = (n0 >> 7) * 256 + (which & 1) * 128 + (n0 & 127);
            transpose_item(W, FF, kb * 64, n0, (bf16_t*)(ws + WS_WGU + (size_t)s * SZ_WGU), D, drow, nullptr, scr, F.lane);
        } else if (r < C1) {
            r -= C0; const int q = r / I_DN, e = r % I_DN, which = q >> 2, layer = q & 3, kb = e / (D / 32), nb = e % (D / 32);
            const float* W = a.in[which == 0 ? I_D1 : I_D2] + (size_t)layer * FF * D;
            transpose_item(W, D, kb * 64, nb * 32, (bf16_t*)(ws + WS_WD + (size_t)(layer * 2 + which) * SZ_WD), FF, nb * 32, nullptr, scr, F.lane);
        } else if (r < C2) {
            r -= C1; const int j = r / I_IN, e = r % I_IN, kb = e / (INW / 32), nb = e % (INW / 32);
            transpose_item(a.in[I_INW] + (size_t)j * D * INW, INW, kb * 64, nb * 32, (bf16_t*)(ws + WS_WIN + (size_t)j * SZ_WIN), D, nb * 32, nullptr, scr, F.lane);
        } else if (r < C3) {
            r -= C2; const int j = r / I_OUT, e = r % I_OUT, kb = e / (D / 32), nb = e % (D / 32);
            transpose_item(a.in[I_OUTW] + (size_t)j * DI * D, D, kb * 64, nb * 32, (bf16_t*)(ws + WS_WOUT + (size_t)j * SZ_WOUT), DI, nb * 32, a.in[I_SNORM] + j * DI, scr, F.lane);
        } else if (r < C4) {
            r -= C3; const int q = r / I_SQ, e = r % I_SQ, which = q >> 2, layer = q & 3, kb = e / (D / 32), nb = e % (D / 32);
            const float* W = a.in[which == 0 ? I_WQ : which == 1 ? I_WK : which == 2 ? I_WV : I_WO] + (size_t)layer * D * D;
            bf16_t* T = which == 0 ? (bf16_t*)(ws + WS_WQ + (size_t)layer * SZ_WSQ) : which == 3 ? (bf16_t*)(ws + WS_WO + (size_t)layer * SZ_WSQ)
                      : (bf16_t*)(ws + WS_WKV + (size_t)layer * 2 * SZ_WSQ + (which == 2 ? SZ_WSQ : 0));
            transpose_item(W, D, kb * 64, nb * 32, T, D, nb * 32, nullptr, scr, F.lane);
        } else {
            r -= C4; const int q = r / I_PL, e = r % I_PL, kb = e / 8, nb = e % 8;
            transpose_item(a.in[I_POOLW] + (size_t)q * 256 * 256, 256, kb * 64, nb * 32, (bf16_t*)(ws + WS_WPOOL) + (size_t)q * 256 * 256, 256, nb * 32, nullptr, scr, F.lane);
        }
    }
    for (int i = F.gw * 64 + F.lane; i < 2 * (INP - INW) * D / 8; i += F.ngw * 64) {
        const int j = i / ((INP - INW) * D / 8), e = i % ((INP - INW) * D / 8);
        *(u32x4*)((bf16_t*)(ws + WS_WIN + (size_t)j * SZ_WIN) + (size_t)INW * D + (size_t)e * 8) = (u32x4){0u, 0u, 0u, 0u};
    }
    for (int m = F.gw; m < PB * NMEM; m += F.ngw) {
        const f32x4* xr = (const f32x4*)(a.in[I_MEM] + (size_t)m * D) + F.lane;
        f32x4 v[4]; float s = 0.f;
#pragma unroll
        for (int j = 0; j < 4; ++j) { v[j] = xr[64 * j]; s += (v[j].x * v[j].x + v[j].y * v[j].y) + (v[j].z * v[j].z + v[j].w * v[j].w); }
        const float rstd = 1.f / sqrtf(wave_sum(s) * (1.f / D) + EPS);
#pragma unroll
        for (int i = 0; i < 4; ++i) {
            const f32x4* gr = (const f32x4*)(a.in[I_NMEM] + i * D) + F.lane;
            u32x2* o = (u32x2*)((bf16_t*)(ws + WS_MN) + ((size_t)i * 2048 + m) * D) + F.lane;
#pragma unroll
            for (int j = 0; j < 4; ++j) { const f32x4 g = gr[64 * j]; u32x2 w; w.x = pk2(v[j].x * rstd * g.x, v[j].y * rstd * g.y); w.y = pk2(v[j].z * rstd * g.z, v[j].w * rstd * g.w); o[64 * j] = w; }
        }
    }
}

template <bool FINAL, bool WU = true> __device__ __forceinline__ void norm_phase(const Frame& F, const float* sp, const float* ss, const float* gain, bf16_t* U, float* R, float* outf) {
    f32x4 g[4];
#pragma unroll
    for (int j = 0; j < 4; ++j) g[j] = ((const f32x4*)gain)[F.lane + 64 * j];
    for (int m0 = F.gw; m0 < M; m0 += 3 * F.ngw) {
        f32x4 v[3][4]; float s[3];
#pragma unroll
        for (int q = 0; q < 3; ++q) {
            const int m = m0 + q * F.ngw, mc = m < M ? m : m0;
            const float* xrow = mc < MP ? sp + (size_t)mc * D : ss + (size_t)(mc - MP) * D;
            const f32x4* xr = (const f32x4*)xrow + F.lane;
#pragma unroll
            for (int j = 0; j < 4; ++j) v[q][j] = xr[64 * j];
        }
#pragma unroll
        for (int q = 0; q < 3; ++q) { float t = 0.f;
#pragma unroll
            for (int j = 0; j < 4; ++j) t += (v[q][j].x * v[q][j].x + v[q][j].y * v[q][j].y) + (v[q][j].z * v[q][j].z + v[q][j].w * v[q][j].w);
            s[q] = t; }
#pragma unroll
        for (int o = 1; o < 64; o <<= 1) {
#pragma unroll
            for (int q = 0; q < 3; ++q) s[q] += shx(s[q], o);
        }
#pragma unroll
        for (int q = 0; q < 3; ++q) {
            const int m = m0 + q * F.ngw;
            if (m < M) {
                const float rstd = 1.f / sqrtf(s[q] * (1.f / D) + EPS);
                if constexpr (FINAL) {
                    f32x4* o = (f32x4*)(outf + (size_t)m * D) + F.lane;
#pragma unroll
                    for (int j = 0; j < 4; ++j) o[64 * j] = v[q][j] * rstd * g[j];
                } else {
                    u32x2* o = (u32x2*)(U + (size_t)m * D) + F.lane;
#pragma unroll
                    for (int j = 0; j < 4; ++j) if constexpr (WU) { u32x2 w; w.x = pk2(v[q][j].x * rstd * g[j].x, v[q][j].y * rstd * g[j].y); w.y = pk2(v[q][j].z * rstd * g[j].z, v[q][j].w * rstd * g[j].w); o[64 * j] = w; }
                    if (F.lane == 0) R[m] = rstd;
                }
            }
        }
    }
}

template <int W> __device__ __forceinline__ void pool_prompt_unit(const float* X, const float* R, const f32x4 g4, bf16_t* MIX, float* outp, int rb, int c, int vz) {
    const int row0 = rb * 32, b = row0 >> 11, t0 = row0 & 2047;
    f32x4 s = {0.f, 0.f, 0.f, 0.f};
#pragma unroll
    for (int j = 1; j < W; ++j) {
        const bool valid = t0 - j >= 0; const int rx = valid ? row0 - j : row0;
        const f32x4 x = *(const f32x4*)(X + (size_t)rx * D + c); const float r = R[rx + vz];
        s = s + x * (valid ? r : 0.f);
    }
#pragma unroll 1
    for (int q0 = 0; q0 < 32; q0 += 8) {
        f32x4 xn[8], xo[8]; float rn[8], rr[8];
#pragma unroll
        for (int i = 0; i < 8; ++i) {
            const int row = row0 + q0 + i, t = t0 + q0 + i;
            const bool vo = t - (W - 1) >= 0; const int ro = vo ? row - (W - 1) : row;
            xn[i] = *(const f32x4*)(X + (size_t)row * D + c); rn[i] = R[row + vz];
            xo[i] = *(const f32x4*)(X + (size_t)ro * D + c); rr[i] = vo ? R[ro + vz] : 0.f;
        }
#pragma unroll
        for (int i = 0; i < 8; ++i) {
            const int row = row0 + q0 + i, t = t0 + q0 + i;
            const f32x4 un = xn[i] * rn[i];
            s = s + un;
            const float inv = (t + 1 < W) ? 1.0f / (float)(t + 1) : 1.0f / (float)W;
            const f32x4 mix = (s * inv - un) * g4;
            u32x2 o; o.x = pk2(mix.x, mix.y); o.y = pk2(mix.z, mix.w);
            *(u32x2*)(MIX + (size_t)row * D + c) = o;
            if (t >= PL - 15) *(f32x4*)(outp + ((size_t)b * 15 + (t - (PL - 15))) * D + c) = un * g4;
            s = s - xo[i] * rr[i];
        }
    }
}
template <int W> __device__ __forceinline__ void pool_sample_unit(const float* X, const float* R, const float* sp, const f32x4 g4, bf16_t* MIX, float* ob, int b, int c, int vz) {
    const int row0 = MP + 8 * b;
    f32x4 s = {0.f, 0.f, 0.f, 0.f};
#pragma unroll
    for (int j = 1; j < W; ++j) s = s + *(const f32x4*)(sp + (size_t)(15 - j) * D + c);
    f32x4 xn[8]; float rn[8];
#pragma unroll
    for (int t = 0; t < 8; ++t) { xn[t] = *(const f32x4*)(X + (size_t)(row0 + t) * D + c); rn[t] = R[row0 + t + vz]; }
    f32x4 old[8];
#pragma unroll
    for (int t = 0; t < 8; ++t) if (t < W - 1) old[t] = *(const f32x4*)(sp + (size_t)(16 + t - W) * D + c);
#pragma unroll
    for (int t = 0; t < 8; ++t) {
        const f32x4 un = xn[t] * rn[t] * g4;
        s = s + un;
        const f32x4 mix = s * (1.0f / (float)W) - un;
        u32x2 o; o.x = pk2(mix.x, mix.y); o.y = pk2(mix.z, mix.w);
        *(u32x2*)(MIX + (size_t)(row0 + t) * D + c) = o;
        *(f32x4*)(ob + (size_t)(7 + t) * D + c) = un;
        if (t < W - 1) s = s - old[t]; else s = s - xn[t - (W - 1) < 0 ? 0 : t - (W - 1)] * rn[t - (W - 1) < 0 ? 0 : t - (W - 1)] * g4;
    }
}
__device__ __forceinline__ void pool_phase(const Frame& F, const Args& a, int jl, int layer) {
    const float* X = (const float*)(F.ws + WS_X); const float* R = (const float*)(F.ws + WS_R);
    bf16_t* MIX = (bf16_t*)(F.ws + WS_Q);
    const float* gain = a.in[I_NMIX] + layer * D;
    const float* spool = a.in[I_SPOOL] + (size_t)jl * SB * 15 * D;
    float* outp = F.out + OUT_POOL_P + (size_t)jl * PB * 15 * D;
    float* outs = F.out + OUT_POOL_S + (size_t)jl * SB * 15 * D;
    const int vz = opaque(0);
    for (int wu = F.gw; wu < (MP / 32) * 4; wu += F.ngw) {
        const int g = wu & 3, rb = wu >> 2, c = 256 * g + 4 * F.lane;
        const f32x4 g4 = *(const f32x4*)(gain + c);
        if (g == 0) pool_prompt_unit<2>(X, R, g4, MIX, outp, rb, c, vz);
        else if (g == 1) pool_prompt_unit<4>(X, R, g4, MIX, outp, rb, c, vz);
        else if (g == 2) pool_prompt_unit<8>(X, R, g4, MIX, outp, rb, c, vz);
        else pool_prompt_unit<16>(X, R, g4, MIX, outp, rb, c, vz);
    }
    if ((F.gw & 3) == 0) for (int su = F.gw >> 2; su < SB * 4; su += F.ngw >> 2) {
        const int g = su & 3, b = su >> 2, c = 256 * g + 4 * F.lane;
        const f32x4 g4 = *(const f32x4*)(gain + c);
        const float* sp = spool + (size_t)b * 15 * D; float* ob = outs + (size_t)b * 15 * D;
        if (g == 0) pool_sample_unit<2>(X, R, sp, g4, MIX, ob, b, c, vz);
        else if (g == 1) pool_sample_unit<4>(X, R, sp, g4, MIX, ob, b, c, vz);
        else if (g == 2) pool_sample_unit<8>(X, R, sp, g4, MIX, ob, b, c, vz);
        else pool_sample_unit<16>(X, R, sp, g4, MIX, ob, b, c, vz);
    }
    for (int i = F.gw * 64 + F.lane; i < SB * 7 * (D / 4); i += F.ngw * 64) {
        const int c4 = i % (D / 4), rr = (i / (D / 4)) % 7, b = i / (7 * (D / 4));
        *(f32x4*)(outs + ((size_t)b * 15 + rr) * D + c4 * 4) = *(const f32x4*)(spool + ((size_t)b * 15 + 8 + rr) * D + c4 * 4);
    }
}

__device__ __forceinline__ void gnorm_phase(const Frame& F, const Args& a) {
    bf16_t* V = (bf16_t*)(F.ws + WS_V); const float* SS = (const float*)(F.ws + WS_SS);
    for (int m0 = F.gw; m0 < M; m0 += 3 * F.ngw) {
        f32x4 s0[3]; u32x4 w[3][4];
#pragma unroll
        for (int q = 0; q < 3; ++q) {
            const int m = m0 + q * F.ngw, mc = m < M ? m : m0;
            s0[q] = *(const f32x4*)(SS + (size_t)mc * 32 + (F.lane & 7) * 4);
#pragma unroll
            for (int j = 0; j < 4; ++j) w[q][j] = *((const u32x4*)(V + (size_t)mc * DI + 512 * j) + F.lane);
        }
#pragma unroll
        for (int q = 0; q < 3; ++q) {
            const int m = m0 + q * F.ngw;
            float sg = (s0[q].x + s0[q].y) + (s0[q].z + s0[q].w);
            sg += shx(sg, 1);
#pragma unroll
            for (int j = 0; j < 4; ++j) {
                const float tot = shi(sg, 2 * j);
                const float r = __builtin_amdgcn_rsqf(tot * (1.f / 512.f) + EPS);
                u32x4 o;
#pragma unroll
                for (int e = 0; e < 4; ++e) { const unsigned x = w[q][j][e]; o[e] = cvt_pk_bf16(bf2f(x & 0xffffu) * r, bf2f(x >> 16) * r); }
                if (m < M) *((u32x4*)(V + (size_t)m * DI + 512 * j) + F.lane) = o;
            }
        }
    }
}


constexpr int GTAB_OFF = MISC_OFF + 4096;
static_assert(pg8::SLB_OFF == MISC_OFF + 10240 && GTAB_OFF + 272 * 16 <= pg8::SLB_OFF && pg8::SLB_OFF + 4096 <= LDS_BYTES, "slab buffers sit beyond the group-norm table inside the misc LDS region");
__device__ __forceinline__ void gnorm_table(const Frame& F, int pm) {
    const float* SS = (const float*)(F.ws + WS_SS);
    LAS float* tab = (LAS float*)(F.lds + GTAB_OFF);
    if (F.tid < 272) {
        const int row = F.tid < 256 ? pm * 256 + F.tid : MP + 16 * pm + (F.tid - 256);
        f32x4 v[8];
#pragma unroll
        for (int i = 0; i < 8; ++i) v[i] = *(const f32x4*)(SS + (size_t)row * 32 + 4 * i);
        float r[4];
#pragma unroll
        for (int g = 0; g < 4; ++g) { const f32x4 t = v[2 * g] + v[2 * g + 1]; r[g] = __builtin_amdgcn_rsqf(((t.x + t.y) + (t.z + t.w)) * (1.f / 512.f) + EPS); }
        f32x4 o; o.x = r[0] / r[1]; o.y = r[1] / r[2]; o.z = r[2] / r[3]; o.w = r[3];
        *(LAS f32x4*)(tab + F.tid * 4) = o;
    }
    __syncthreads();
}
__device__ __forceinline__ bf16x8 lfrag(const LAS bf16_t* base, int row, int pitch, int k) { return *(const LAS bf16x8*)(base + row * pitch + k); }
__device__ __forceinline__ void wave_lds_sync() { asm volatile("s_waitcnt lgkmcnt(0)" ::: "memory"); __builtin_amdgcn_wave_barrier(); }
__device__ __forceinline__ bf16x8 pack8(f32x4 a, f32x4 b) { u32x4 w; w.x = cvt_pk_bf16(a[0], a[1]); w.y = cvt_pk_bf16(a[2], a[3]); w.z = cvt_pk_bf16(b[0], b[1]); w.w = cvt_pk_bf16(b[2], b[3]); return __builtin_bit_cast(bf16x8, w); }

__device__ __forceinline__ void lds_barrier() { asm volatile("s_waitcnt lgkmcnt(0)" ::: "memory"); __builtin_amdgcn_s_barrier(); asm volatile("" ::: "memory"); }
__device__ __forceinline__ float row16_sum(float v) {
    v += __builtin_bit_cast(float, __builtin_amdgcn_update_dpp(0, __builtin_bit_cast(int, v), 0x128, 0xf, 0xf, false));
    v += __builtin_bit_cast(float, __builtin_amdgcn_update_dpp(0, __builtin_bit_cast(int, v), 0x124, 0xf, 0xf, false));
    v += __builtin_bit_cast(float, __builtin_amdgcn_update_dpp(0, __builtin_bit_cast(int, v), 0x122, 0xf, 0xf, false));
    v += __builtin_bit_cast(float, __builtin_amdgcn_update_dpp(0, __builtin_bit_cast(int, v), 0x121, 0xf, 0xf, false));
    return v;
}

struct MiniRes {
    const float* src; float* X; float alpha; const float* scale;
    __device__ __forceinline__ void operator()(int row, int col, f32x4 v) const {
        const unsigned off = (unsigned)(row * D + col);
        f32x4 sc = scale ? *(const f32x4*)(scale + col) : (f32x4){1.f, 1.f, 1.f, 1.f};
        *(f32x4*)(X + off) = *(const f32x4*)(src + off) + v * (sc * alpha);
    }
};
struct MiniBf16 {
    bf16_t* O; int ldc;
    __device__ __forceinline__ void operator()(int row, int col, f32x4 v) const {
        u32x2 w; w.x = cvt_pk_bf16(v[0], v[1]); w.y = cvt_pk_bf16(v[2], v[3]);
        *(u32x2*)(O + (unsigned)(row * ldc + col)) = w;
    }
};
__device__ __forceinline__ void conv_phase(const Frame& F, const Args& a, int jl) {
    const bf16_t* ZX = (const bf16_t*)(F.ws + WS_ZX); bf16_t* XBC = (bf16_t*)(F.ws + WS_XBC);
    const float* cw = a.in[I_CONVW] + (size_t)jl * 4 * CONVD; const float* cb = a.in[I_CONVB] + (size_t)jl * CONVD;
    const int lane = F.lane;
    constexpr int RPU = (M * 6) / 2048;
    static_assert(RPU * 2048 == M * 6, "conv runs");
#define CONV_UNPACK(dst, raw) do { dst[0] = (f32x4){bf2f((raw).x & 0xffffu), bf2f((raw).x >> 16), bf2f((raw).y & 0xffffu), bf2f((raw).y >> 16)}; dst[1] = (f32x4){bf2f((raw).z & 0xffffu), bf2f((raw).z >> 16), bf2f((raw).w & 0xffffu), bf2f((raw).w >> 16)}; } while (0)
    for (int u = F.gw; u < 2048; u += F.ngw) {
        int slab = -1, ch = 0;
        f32x4 w[4][2], bv[2], x0[2], x1[2], x2[2];
#pragma unroll
        for (int e = 0; e < 2; ++e) { x0[e] = (f32x4){0.f, 0.f, 0.f, 0.f}; x1[e] = x0[e]; x2[e] = x0[e]; bv[e] = x0[e];
#pragma unroll
            for (int k = 0; k < 4; ++k) w[k][e] = x0[e]; }
#pragma unroll 1
        for (int r0 = 0; r0 < RPU; r0 += 8) {
            u32x4 rq[8];
#pragma unroll
            for (int q = 0; q < 8; ++q) { const int rc = (r0 + q < RPU) ? r0 + q : RPU - 1; const int idx = u * RPU + rc, sl = idx / M, row = idx - sl * M;
                rq[q] = *(const u32x4*)(ZX + (size_t)row * ZXP + DI + sl * 512 + 8 * lane); }
#pragma unroll
            for (int q = 0; q < 8; ++q) {
                const int r = r0 + q;
                if (r < RPU) {
                    const int idx = u * RPU + r, sl = idx / M, row = idx - sl * M;
                    const bool isS = row >= MP;
                    const int t = isS ? ((row - MP) & 7) : (row & (PL - 1));
                    if (sl != slab) {
                        slab = sl; ch = sl * 512 + 8 * lane;
#pragma unroll
                        for (int k = 0; k < 4; ++k) { w[k][0] = *(const f32x4*)(cw + k * CONVD + ch); w[k][1] = *(const f32x4*)(cw + k * CONVD + ch + 4); }
                        bv[0] = *(const f32x4*)(cb + ch); bv[1] = *(const f32x4*)(cb + ch + 4);
                    }
                    if (r == 0 || t == 0) {
                        const float* sc = a.in[I_SCONV] + (((size_t)jl * SB + (isS ? ((row - MP) >> 3) : 0)) * 3) * CONVD + ch;
#pragma unroll
                        for (int j = 1; j <= 3; ++j) {
                            f32x4 h[2];
                            if (t - j >= 0) { const u32x4 rw = *(const u32x4*)(ZX + (size_t)(row - j) * ZXP + DI + ch); CONV_UNPACK(h, rw); }
                            else if (isS) { h[0] = *(const f32x4*)(sc + (size_t)(3 + t - j) * CONVD); h[1] = *(const f32x4*)(sc + (size_t)(3 + t - j) * CONVD + 4); }
                            else { h[0] = (f32x4){0.f, 0.f, 0.f, 0.f}; h[1] = h[0]; }
                            if (j == 1) { x2[0] = h[0]; x2[1] = h[1]; } else if (j == 2) { x1[0] = h[0]; x1[1] = h[1]; } else { x0[0] = h[0]; x0[1] = h[1]; }
                        }
                    }
                    f32x4 x3[2]; CONV_UNPACK(x3, rq[q]);
                    u32x4 o;
                    {   f32x4 v0 = bv[0] + w[0][0] * x0[0] + w[1][0] * x1[0] + w[2][0] * x2[0] + w[3][0] * x3[0];
                        f32x4 v1 = bv[1] + w[0][1] * x0[1] + w[1][1] * x1[1] + w[2][1] * x2[1] + w[3][1] * x3[1];
                        o.x = cvt_pk_bf16(silu_f(v0[0]), silu_f(v0[1])); o.y = cvt_pk_bf16(silu_f(v0[2]), silu_f(v0[3]));
                        o.z = cvt_pk_bf16(silu_f(v1[0]), silu_f(v1[1])); o.w = cvt_pk_bf16(silu_f(v1[2]), silu_f(v1[3])); }
                    *(u32x4*)(XBC + (size_t)row * CONVD + ch) = o;
#pragma unroll
                    for (int e = 0; e < 2; ++e) { x0[e] = x1[e]; x1[e] = x2[e]; x2[e] = x3[e]; }
                }
            }
        }
    }
#undef CONV_UNPACK
}

constexpr int SC_CM = 0, SC_XD = 17408, SC_BM = 34816, SC_XW = 53248, SC_LM = 71680, SC_XS = 80896, SC_HS = 90112, SC_ZT = 107520, SC_VT = 116736, SC_F32 = 125952;
__device__ __forceinline__ void scan_prompt_unit(const Frame& F, const Args& a, int jl, int b, int h) {
    LAS unsigned char* L = F.lds;
    LAS bf16_t* CM = (LAS bf16_t*)(L + SC_CM); LAS bf16_t* BM = (LAS bf16_t*)(L + SC_BM);
    LAS bf16_t* XD = (LAS bf16_t*)(L + SC_XD); LAS bf16_t* XW = (LAS bf16_t*)(L + SC_XW); LAS bf16_t* LM = (LAS bf16_t*)(L + SC_LM);
    LAS bf16_t* XS = (LAS bf16_t*)(L + SC_XS); LAS bf16_t* HS = (LAS bf16_t*)(L + SC_HS);
    LAS bf16_t* ZT = (LAS bf16_t*)(L + SC_ZT); LAS bf16_t* VT = (LAS bf16_t*)(L + SC_VT);
    LAS float* FB = (LAS float*)(L + SC_F32);
    LAS float* SSP = FB + 2 * 256;
    const int g = h >> 3, tid = F.tid, lane = F.lane, w = F.wave, fr = lane & 15, fq = lane >> 4;
    const bf16_t* ZX = (const bf16_t*)(F.ws + WS_ZX); const bf16_t* XBC = (const bf16_t*)(F.ws + WS_XBC); const float* DT = (const float*)(F.ws + WS_DT);
    bf16_t* V = (bf16_t*)(F.ws + WS_V); float* SS = (float*)(F.ws + WS_SS);
    const float A_h = -__expf(a.in[I_ALOG][jl * 32 + h]), dsk = a.in[I_DSKIP][jl * 32 + h];
    const size_t row0 = (size_t)b * PL;
    for (int i = tid; i < 64 * 136 / 2; i += NTHR) ((LAS unsigned*)HS)[i] = 0u;
    f32x4 hacc[4];
#pragma unroll
    for (int j = 0; j < 4; ++j) hacc[j] = (f32x4){0.f, 0.f, 0.f, 0.f};
    const int qt = w >> 1, xh = w & 1;
    const unsigned trq4 = (unsigned)(fr >> 2), trp4 = (unsigned)(fr & 3);
    const unsigned trx = (unsigned)(size_t)L + (8u * fq + trq4) * 160u + 8u * trp4 + 64u * (unsigned)xh;
    const unsigned trw = (unsigned)(size_t)L + (8u * fq + trq4) * 160u + 8u * trp4 + 32u * (unsigned)qt;
    const unsigned trb = (unsigned)(size_t)L + (8u * fq + trq4) * 288u + 8u * trp4 + 128u * (unsigned)xh;
    u32x4 pre[5], prez; float predt;
    const int zr = tid >> 3, zo = tid & 7;
#define SCAN_CH(it_) ((it_) == 0 ? h * 64 + 8 * w : ((it_) < 3 ? DI + g * 128 + 8 * (w + 8 * ((it_) - 1)) : DI + 512 + g * 128 + 8 * (w + 8 * ((it_) - 3))))
#define SCAN_LOAD(c_) do { const size_t rb_ = row0 + (size_t)(c_) * 64; \
        _Pragma("unroll") for (int it = 0; it < 5; ++it) pre[it] = *(const u32x4*)(XBC + (rb_ + lane) * CONVD + SCAN_CH(it)); \
        prez = *(const u32x4*)(ZX + (rb_ + zr) * ZXP + h * 64 + 8 * zo); predt = DT[(rb_ + lane) * 32 + h]; } while (0)
#define SCAN_STEP0(c_) do { if (w == 0) { LAS float* fb_ = FB + ((c_) & 1) * 256; \
        const float dtv = predt; float x = A_h * dtv; \
        _Pragma("unroll") for (int o = 1; o < 64; o <<= 1) { const float y = shup(x, o); if (lane >= o) x += y; } \
        const float tot = shi(x, 63); fb_[lane] = x; fb_[64 + lane] = dtv; fb_[128 + lane] = __expf(tot - x); if (lane == 0) fb_[192] = __expf(tot); } } while (0)
    SCAN_LOAD(0);
    SCAN_STEP0(0);
    __syncthreads();
    for (int c = 0; c < PL / 64; ++c) {
        const int t0 = c * 64;
        LAS float* fb = FB + (c & 1) * 256;
        {   const int r = lane;
            {   const u32x4 pk = pre[0];
                *(LAS u32x4*)(XS + r * 72 + 8 * w) = pk;
                const float dtl = fb[64 + r], dte = fb[128 + r];
                u32x4 d4, w4;
#pragma unroll
                for (int e = 0; e < 4; ++e) { const float x0 = bf2f(pk[e] & 0xffffu) * dtl, x1 = bf2f(pk[e] >> 16) * dtl; d4[e] = cvt_pk_bf16(x0, x1); w4[e] = cvt_pk_bf16(x0 * dte, x1 * dte); }
                *(LAS u32x4*)(XD + r * 80 + 8 * w) = d4; *(LAS u32x4*)(XW + r * 80 + 8 * w) = w4; }
#pragma unroll
            for (int it = 1; it < 3; ++it) *(LAS u32x4*)(BM + r * 144 + 8 * (w + 8 * (it - 1))) = pre[it];
#pragma unroll
            for (int it = 3; it < 5; ++it) *(LAS u32x4*)(CM + r * 136 + 8 * (w + 8 * (it - 3))) = pre[it];
        }
        *(LAS u32x4*)(ZT + zr * 72 + 8 * zo) = prez;
        lds_barrier();
        { const int cn = (c + 1 < PL / 64) ? c + 1 : c; SCAN_LOAD(cn); }
        const float cdec = fb[192];
        f32x4 yoff[2];
#pragma unroll
        for (int x = 0; x < 2; ++x) {
            const int ct = 2 * xh + x;
            f32x4 c1 = {0.f, 0.f, 0.f, 0.f}, c3 = {0.f, 0.f, 0.f, 0.f};
#pragma unroll
            for (int ks = 0; ks < 4; ++ks) {
                const bf16x8 af = lfrag(CM, qt * 16 + fr, 136, ks * 32 + 8 * fq);
                const bf16x8 b1 = lfrag(BM, ct * 16 + fr, 144, ks * 32 + 8 * fq);
                const bf16x8 b3 = lfrag(HS, ct * 16 + fr, 136, ks * 32 + 8 * fq);
                c1 = __builtin_amdgcn_mfma_f32_16x16x32_bf16(af, b1, c1, 0, 0, 0);
                c3 = __builtin_amdgcn_mfma_f32_16x16x32_bf16(af, b3, c3, 0, 0, 0);
            }
            const int kk = ct * 16 + fr; const float ak = fb[kk];
#pragma unroll
            for (int r = 0; r < 4; ++r) {
                const int q = qt * 16 + 4 * fq + r; const float aq = fb[q];
                const float lv = (kk <= q) ? c1[r] * __expf(aq - ak) : 0.f;
                LM[q * 72 + kk] = (bf16_t)cvt_pk_bf16(lv, 0.f);
                yoff[x][r] = c3[r] * __expf(aq);
            }
        }
        lds_barrier();
        float ssq[4] = {0.f, 0.f, 0.f, 0.f};
        bf16x8 xdf[2][2];
        {   u32x2 r0, r1, r2, r3, r4, r5, r6, r7; const unsigned ad = trx + SC_XD;
            asm volatile("ds_read_b64_tr_b16 %0, %8\n\tds_read_b64_tr_b16 %1, %8 offset:640\n\tds_read_b64_tr_b16 %2, %8 offset:5120\n\tds_read_b64_tr_b16 %3, %8 offset:5760\n\t"
                         "ds_read_b64_tr_b16 %4, %8 offset:32\n\tds_read_b64_tr_b16 %5, %8 offset:672\n\tds_read_b64_tr_b16 %6, %8 offset:5152\n\tds_read_b64_tr_b16 %7, %8 offset:5792\n\ts_waitcnt lgkmcnt(0)"
                         : "=&v"(r0), "=&v"(r1), "=&v"(r2), "=&v"(r3), "=&v"(r4), "=&v"(r5), "=&v"(r6), "=&v"(r7) : "v"(ad) : "memory");
            xdf[0][0] = __builtin_bit_cast(bf16x8, (u32x4){r0.x, r0.y, r1.x, r1.y}); xdf[0][1] = __builtin_bit_cast(bf16x8, (u32x4){r2.x, r2.y, r3.x, r3.y});
            xdf[1][0] = __builtin_bit_cast(bf16x8, (u32x4){r4.x, r4.y, r5.x, r5.y}); xdf[1][1] = __builtin_bit_cast(bf16x8, (u32x4){r6.x, r6.y, r7.x, r7.y}); }
#pragma unroll
        for (int x = 0; x < 2; ++x) {
            const int pt = 2 * xh + x;
            f32x4 c2 = yoff[x];
#pragma unroll
            for (int ks = 0; ks < 2; ++ks)
                c2 = __builtin_amdgcn_mfma_f32_16x16x32_bf16(lfrag(LM, qt * 16 + fr, 72, ks * 32 + 8 * fq), xdf[x][ks], c2, 0, 0, 0);
            const int p = pt * 16 + fr;
#pragma unroll
            for (int r = 0; r < 4; ++r) {
                const int q = qt * 16 + 4 * fq + r;
                const float y = c2[r] + dsk * bf2f(XS[q * 72 + p]);
                const float vv = y * silu_f(bf2f(ZT[q * 72 + p]));
                VT[q * 72 + p] = (bf16_t)cvt_pk_bf16(vv, 0.f);
                ssq[r] += vv * vv;
            }
        }
#pragma unroll
        for (int r = 0; r < 4; ++r) { const float s = row16_sum(ssq[r]); if (fr == 0) SSP[xh * 64 + qt * 16 + 4 * fq + r] = s; }
        bf16x8 xwf[2], bmf[4][2];
        {   u32x2 r0, r1, r2, r3, r4, r5, r6, r7, r8, r9, r10, r11; const unsigned aw = trw + SC_XW, ab = trb + SC_BM;
            asm volatile("ds_read_b64_tr_b16 %0, %12\n\tds_read_b64_tr_b16 %1, %12 offset:640\n\tds_read_b64_tr_b16 %2, %12 offset:5120\n\tds_read_b64_tr_b16 %3, %12 offset:5760\n\t"
                         "ds_read_b64_tr_b16 %4, %13\n\tds_read_b64_tr_b16 %5, %13 offset:1152\n\tds_read_b64_tr_b16 %6, %13 offset:9216\n\tds_read_b64_tr_b16 %7, %13 offset:10368\n\t"
                         "ds_read_b64_tr_b16 %8, %13 offset:32\n\tds_read_b64_tr_b16 %9, %13 offset:1184\n\tds_read_b64_tr_b16 %10, %13 offset:9248\n\tds_read_b64_tr_b16 %11, %13 offset:10400\n\ts_waitcnt lgkmcnt(0)"
                         : "=&v"(r0), "=&v"(r1), "=&v"(r2), "=&v"(r3), "=&v"(r4), "=&v"(r5), "=&v"(r6), "=&v"(r7), "=&v"(r8), "=&v"(r9), "=&v"(r10), "=&v"(r11) : "v"(aw), "v"(ab) : "memory");
            xwf[0] = __builtin_bit_cast(bf16x8, (u32x4){r0.x, r0.y, r1.x, r1.y}); xwf[1] = __builtin_bit_cast(bf16x8, (u32x4){r2.x, r2.y, r3.x, r3.y});
            bmf[0][0] = __builtin_bit_cast(bf16x8, (u32x4){r4.x, r4.y, r5.x, r5.y}); bmf[0][1] = __builtin_bit_cast(bf16x8, (u32x4){r6.x, r6.y, r7.x, r7.y});
            bmf[1][0] = __builtin_bit_cast(bf16x8, (u32x4){r8.x, r8.y, r9.x, r9.y}); bmf[1][1] = __builtin_bit_cast(bf16x8, (u32x4){r10.x, r10.y, r11.x, r11.y}); }
        {   u32x2 r0, r1, r2, r3, r4, r5, r6, r7; const unsigned ab = trb + SC_BM;
            asm volatile("ds_read_b64_tr_b16 %0, %8 offset:64\n\tds_read_b64_tr_b16 %1, %8 offset:1216\n\tds_read_b64_tr_b16 %2, %8 offset:9280\n\tds_read_b64_tr_b16 %3, %8 offset:10432\n\t"
                         "ds_read_b64_tr_b16 %4, %8 offset:96\n\tds_read_b64_tr_b16 %5, %8 offset:1248\n\tds_read_b64_tr_b16 %6, %8 offset:9312\n\tds_read_b64_tr_b16 %7, %8 offset:10464\n\ts_waitcnt lgkmcnt(0)"
                         : "=&v"(r0), "=&v"(r1), "=&v"(r2), "=&v"(r3), "=&v"(r4), "=&v"(r5), "=&v"(r6), "=&v"(r7) : "v"(ab) : "memory");
            bmf[2][0] = __builtin_bit_cast(bf16x8, (u32x4){r0.x, r0.y, r1.x, r1.y}); bmf[2][1] = __builtin_bit_cast(bf16x8, (u32x4){r2.x, r2.y, r3.x, r3.y});
            bmf[3][0] = __builtin_bit_cast(bf16x8, (u32x4){r4.x, r4.y, r5.x, r5.y}); bmf[3][1] = __builtin_bit_cast(bf16x8, (u32x4){r6.x, r6.y, r7.x, r7.y}); }
#pragma unroll
        for (int j = 0; j < 4; ++j) {
            const int nt = 4 * xh + j;
            f32x4 acc = hacc[j] * cdec;
#pragma unroll
            for (int ks = 0; ks < 2; ++ks)
                acc = __builtin_amdgcn_mfma_f32_16x16x32_bf16(xwf[ks], bmf[j][ks], acc, 0, 0, 0);
            hacc[j] = acc;
#pragma unroll
            for (int r = 0; r < 4; ++r) HS[(qt * 16 + 4 * fq + r) * 136 + nt * 16 + fr] = (bf16_t)cvt_pk_bf16(acc[r], 0.f);
        }
        SCAN_STEP0(c + 1);
        lds_barrier();
        *(u32x4*)(V + (row0 + t0 + zr) * DI + h * 64 + 8 * zo) = *(const LAS u32x4*)(VT + zr * 72 + 8 * zo);
        if (tid < 64) SS[(row0 + t0 + tid) * 32 + h] = SSP[tid] + SSP[64 + tid];
    }
#undef SCAN_LOAD
#undef SCAN_CH
#undef SCAN_STEP0
    float* outS = F.out + OUT_SSM_P + (((size_t)jl * PB + b) * NHEAD + h) * HDIM * NST;
#pragma unroll
    for (int j = 0; j < 4; ++j)
#pragma unroll
        for (int r = 0; r < 4; ++r) outS[(qt * 16 + 4 * fq + r) * NST + (4 * xh + j) * 16 + fr] = hacc[j][r];
    __syncthreads();
}

__device__ __forceinline__ void scan_sample_unit(const Frame& F, const Args& a, int jl, int b, int h) {
    LAS float* S = (LAS float*)(F.lds + F.wave * 16384);
    LAS float* xsS = S; LAS float* bmS = S + 512; LAS float* cmS = bmS + 1056; LAS float* xdtS = cmS + 1056; LAS float* xdtwS = xdtS + 512; LAS float* LmS = xdtwS + 512; LAS float* acsS = LmS + 64;
    const int lane = F.lane, g = h >> 3;
    const bf16_t* ZX = (const bf16_t*)(F.ws + WS_ZX); const bf16_t* XBC = (const bf16_t*)(F.ws + WS_XBC); const float* DT = (const float*)(F.ws + WS_DT);
    bf16_t* V = (bf16_t*)(F.ws + WS_V); float* SS = (float*)(F.ws + WS_SS);
    const float A_h = -__expf(a.in[I_ALOG][jl * 32 + h]), dsk = a.in[I_DSKIP][jl * 32 + h];
    const size_t row0 = (size_t)MP + (size_t)b * SL;
    const size_t soff = ((((size_t)jl * SB + b) * NHEAD + h) * HDIM) * NST;
    const float* st = a.in[I_SSM] + soff; float* so = F.out + OUT_SSM_S + soff;
    const int pl = lane & 15, kq = lane >> 4, tq = lane & 7;
    f32x4 hc[4][8];
#pragma unroll
    for (int pt = 0; pt < 4; ++pt)
#pragma unroll
        for (int e = 0; e < 8; ++e) hc[pt][e] = *(const f32x4*)(st + (unsigned)((16 * pt + pl) * NST + 32 * (e >> 1) + 8 * kq + 4 * (e & 1)));
    float dtv[8], acs[8]; float run = 0.f;
    const int vz = opaque(0);
#pragma unroll
    for (int t = 0; t < 8; ++t) { dtv[t] = DT[(row0 + t) * 32 + h + vz]; run += A_h * dtv[t]; acs[t] = run; }
    const float tot = run, cdec = __expf(tot);
    { float v = acs[0];
#pragma unroll
      for (int t = 1; t < 8; ++t) v = (lane == t) ? acs[t] : v;
      if (lane < 8) acsS[lane] = v; }
#pragma unroll
    for (int it = 0; it < 10; ++it) {
        const int item = lane + 64 * it, t = item / 80, qd = item % 80;
        const int ch = qd < 16 ? h * 64 + 4 * qd : (qd < 48 ? DI + g * 128 + 4 * (qd - 16) : DI + 512 + g * 128 + 4 * (qd - 48));
        const u32x2 raw = *(const u32x2*)(XBC + (row0 + t) * CONVD + ch);
        LAS float* dst = qd < 16 ? xsS + t * 64 + 4 * qd : (qd < 48 ? bmS + t * 132 + 4 * (qd - 16) : cmS + t * 132 + 4 * (qd - 48));
        *(LAS f32x4*)dst = (f32x4){bf2f(raw.x & 0xffffu), bf2f(raw.x >> 16), bf2f(raw.y & 0xffffu), bf2f(raw.y >> 16)};
    }
    wave_lds_sync();
#pragma unroll
    for (int t = 0; t < 8; ++t) { const float xd = xsS[t * 64 + lane] * dtv[t]; xdtS[t * 64 + lane] = xd; xdtwS[t * 64 + lane] = xd * __expf(tot - acs[t]); }
    { const int t = lane >> 3, k = lane & 7; float s = 0.f;
#pragma unroll 8
      for (int n = 0; n < 128; n += 4) { const f32x4 c4 = *(const LAS f32x4*)(cmS + t * 132 + n), b4 = *(const LAS f32x4*)(bmS + k * 132 + n); s += (c4[0] * b4[0] + c4[1] * b4[1]) + (c4[2] * b4[2] + c4[3] * b4[3]); }
      LmS[lane] = (k <= t) ? s * __expf(acsS[t] - acsS[k]) : 0.f; }
    wave_lds_sync();
    bf16x8 cmF[4];
#pragma unroll
    for (int ks = 0; ks < 4; ++ks) cmF[ks] = pack8(*(const LAS f32x4*)(cmS + tq * 132 + 32 * ks + 8 * kq), *(const LAS f32x4*)(cmS + tq * 132 + 32 * ks + 8 * kq + 4));
    float Lrow[8];
#pragma unroll
    for (int k = 0; k < 8; ++k) Lrow[k] = LmS[tq * 8 + k];
    const float eacs = __expf(acsS[tq]);
    float ssacc = 0.f;
#pragma unroll
    for (int pt = 0; pt < 4; ++pt) {
        const int p = 16 * pt + pl;
        const int kqo = opaque(kq);
        float xw[8];
#pragma unroll
        for (int t = 0; t < 8; ++t) xw[t] = xdtwS[t * 64 + p];
        f32x4 yacc = {0.f, 0.f, 0.f, 0.f};
#pragma unroll
        for (int ks = 0; ks < 4; ++ks) {
            const f32x4 h0a = hc[pt][2 * ks], h0b = hc[pt][2 * ks + 1];
            yacc = __builtin_amdgcn_mfma_f32_16x16x32_bf16(pack8(h0a, h0b), cmF[ks], yacc, 0, 0, 0);
            f32x4 na = h0a * cdec, nb = h0b * cdec;
#pragma unroll
            for (int t = 0; t < 8; ++t) { na = na + *(const LAS f32x4*)(bmS + t * 132 + 32 * ks + 8 * kqo) * xw[t]; nb = nb + *(const LAS f32x4*)(bmS + t * 132 + 32 * ks + 8 * kqo + 4) * xw[t]; }
            *(f32x4*)(so + (unsigned)(p * NST + 32 * ks + 8 * kq)) = na; *(f32x4*)(so + (unsigned)(p * NST + 32 * ks + 8 * kq + 4)) = nb;
        }
#pragma unroll
        for (int r = 0; r < 4; ++r) {
            const int pp = 16 * pt + 4 * kq + r;
            float y = eacs * yacc[r] + dsk * xsS[tq * 64 + pp];
#pragma unroll
            for (int k = 0; k < 8; ++k) y += Lrow[k] * xdtS[k * 64 + pp];
            if (pl < 8) {
                const size_t grow = row0 + tq;
                const float z = bf2f(ZX[grow * ZXP + h * 64 + pp]);
                const float vv = y * silu_f(z);
                V[grow * DI + h * 64 + pp] = (bf16_t)f2bf(vv);
                ssacc += vv * vv;
            }
        }
        asm volatile("" ::: "memory");
    }
    ssacc += shx(ssacc, 16);
    ssacc += shx(ssacc, 32);
    if (lane < 8) SS[(row0 + lane) * 32 + h] = ssacc;
    wave_lds_sync();
}

__device__ __forceinline__ void scan_phase(const Frame& F, const Args& a, int jl) {
#ifndef REP_SP
#define REP_SP 1
#endif
#ifndef REP_SS
#define REP_SS 1
#endif
    for (int rep = 0; rep < REP_SP; ++rep)
    for (int u = blockIdx.x; u < PB * NHEAD; u += F.G) {
        const int x = u & 7, hi = (u >> 3) & 7, z = u >> 6, bg = x + 8 * z;
        scan_prompt_unit(F, a, jl, bg >> 2, (bg & 3) * 8 + hi);
    }
    for (int rep = 0; rep < REP_SS; ++rep)
    for (int u = F.gw; u < SB * NHEAD; u += F.ngw) scan_sample_unit(F, a, jl, u >> 5, u & 31);
    const bf16_t* ZX = (const bf16_t*)(F.ws + WS_ZX);
    for (int i = F.gw * 64 + F.lane; i < (PB + SB) * 3 * (CONVD / 4); i += F.ngw * 64) {
        const int c4 = i % (CONVD / 4), rr = (i / (CONVD / 4)) % 3, bb = i / (3 * (CONVD / 4));
        const size_t row = bb < PB ? (size_t)bb * PL + (PL - 3) + rr : (size_t)MP + (size_t)(bb - PB) * SL + (SL - 3) + rr;
        const u32x2 raw = *(const u32x2*)(ZX + row * ZXP + DI + c4 * 4);
        float* o = bb < PB ? F.out + OUT_CONV_P + (((size_t)jl * PB + bb) * 3 + rr) * CONVD + c4 * 4 : F.out + OUT_CONV_S + (((size_t)jl * SB + (bb - PB)) * 3 + rr) * CONVD + c4 * 4;
        *(f32x4*)o = (f32x4){bf2f(raw.x & 0xffffu), bf2f(raw.x >> 16), bf2f(raw.y & 0xffffu), bf2f(raw.y >> 16)};
    }
}

constexpr float ATT_C = 0.0625f * 1.4426950408889634f;
__device__ __forceinline__ void stage_256x256(LAS unsigned char* L, const bf16_t* src, int pitch, int tid) {
#pragma unroll 1
    for (int hseg = 0; hseg < 2; ++hseg) {
        u32x4 st[8];
#pragma unroll
        for (int i = 0; i < 8; ++i) { const int c = tid + NTHR * (i + 8 * hseg), row = c >> 5, ch = c & 31; st[i] = *(const u32x4*)(src + (unsigned)(row * pitch + ch * 8)); }
#pragma unroll
        for (int i = 0; i < 8; ++i) { const int c = tid + NTHR * (i + 8 * hseg), row = c >> 5, ch = c & 31; *(LAS u32x4*)(L + row * 512 + ((ch ^ (row & 15)) << 4)) = st[i]; }
    }
}
__device__ __forceinline__ void attn_prompt_wg(const Frame& F, const bf16_t* Qp, const bf16_t* Kp, const bf16_t* VTp, bf16_t* Op) {
    LAS unsigned char* L = F.lds;
    const int lane = opaque(F.lane), w = F.wave, tid = w * 64 + lane, fr = lane & 15, fq = lane >> 4;
    stage_256x256(L, Kp, D, tid);
    __syncthreads();
    bf16x8 pf[2][8];
#pragma unroll
    for (int qh = 0; qh < 2; ++qh) {
        const int qrow = qh * 128 + w * 16 + fr;
        bf16x8 qf[8];
#pragma unroll
        for (int ks = 0; ks < 8; ++ks) qf[ks] = *(const bf16x8*)(Qp + (unsigned)(qrow * D + ks * 32 + 8 * fq));
        f32x4 s[16];
#pragma unroll
        for (int kt = 0; kt < 16; ++kt) {
            f32x4 acc = {0.f, 0.f, 0.f, 0.f};
#pragma unroll
            for (int ks = 0; ks < 8; ++ks)
                acc = __builtin_amdgcn_mfma_f32_16x16x32_bf16(*(const LAS bf16x8*)(L + (kt * 16 + fr) * 512 + (((ks * 4 + fq) ^ fr) << 4)), qf[ks], acc, 0, 0, 0);
            s[kt] = acc;
            asm volatile("" ::: "memory");
        }
        float mx = -3.0e38f;
#pragma unroll
        for (int kt = 0; kt < 16; ++kt)
#pragma unroll
            for (int r = 0; r < 4; ++r) mx = fmaxf(mx, s[kt][r]);
        mx = fmaxf(mx, shx(mx, 16)); mx = fmaxf(mx, shx(mx, 32));
        float sum = 0.f;
#pragma unroll
        for (int kt = 0; kt < 16; ++kt)
#pragma unroll
            for (int r = 0; r < 4; ++r) { const float p = __builtin_amdgcn_exp2f((s[kt][r] - mx) * ATT_C); s[kt][r] = p; sum += p; }
        sum += shx(sum, 16); sum += shx(sum, 32);
        const float inv = 1.0f / sum;
#pragma unroll
        for (int k2 = 0; k2 < 8; ++k2) pf[qh][k2] = pack8(s[2 * k2] * inv, s[2 * k2 + 1] * inv);
        asm volatile("" ::: "memory");
    }
    __syncthreads();
    stage_256x256(L, VTp, 256, tid);
    __syncthreads();
    const int qrow0 = w * 16 + fr;
#pragma unroll 2
    for (int dt = 0; dt < 16; ++dt) {
        f32x4 o0 = {0.f, 0.f, 0.f, 0.f}, o1 = {0.f, 0.f, 0.f, 0.f};
#pragma unroll
        for (int k2 = 0; k2 < 8; ++k2) {
            const bf16x8 vf = *(const LAS bf16x8*)(L + (dt * 16 + fr) * 512 + (((k2 * 4 + fq) ^ fr) << 4));
            o0 = __builtin_amdgcn_mfma_f32_16x16x32_bf16(vf, pf[0][k2], o0, 0, 0, 0);
            o1 = __builtin_amdgcn_mfma_f32_16x16x32_bf16(vf, pf[1][k2], o1, 0, 0, 0);
        }
        u32x2 w0, w1; w0.x = cvt_pk_bf16(o0[0], o0[1]); w0.y = cvt_pk_bf16(o0[2], o0[3]); w1.x = cvt_pk_bf16(o1[0], o1[1]); w1.y = cvt_pk_bf16(o1[2], o1[3]);
        *(u32x2*)(Op + (unsigned)(qrow0 * D + dt * 16 + 4 * fq)) = w0;
        *(u32x2*)(Op + (unsigned)((qrow0 + 128) * D + dt * 16 + 4 * fq)) = w1;
        asm volatile("" ::: "memory");
    }
    __syncthreads();
}
constexpr int AS_STAT = MISC_OFF + 1024;
__device__ __forceinline__ void attn_sample_wg(const Frame& F, const bf16_t* Qp, const float* Kp, const float* Vp, bf16_t* Op) {
    LAS float* RED = (LAS float*)F.lds; LAS float* MXS = (LAS float*)(F.lds + AS_STAT); LAS float* SMS = MXS + 128;
    const int lane = F.lane, w = F.wave, fr = lane & 15, fq = lane >> 4;
    bf16x8 qf[8];
#pragma unroll
    for (int ks = 0; ks < 8; ++ks) qf[ks] = *(const bf16x8*)(Qp + (unsigned)((fr & 7) * D + ks * 32 + 8 * fq));
    f32x4 s[2];
#pragma unroll
    for (int x = 0; x < 2; ++x) {
        f32x4 acc = {0.f, 0.f, 0.f, 0.f};
        const float* kp = Kp + (unsigned)((w * 32 + x * 16 + fr) * D + 8 * fq);
#pragma unroll
        for (int ks = 0; ks < 8; ++ks) { const f32x4 k0 = *(const f32x4*)(kp + ks * 32), k1 = *(const f32x4*)(kp + ks * 32 + 4); acc = __builtin_amdgcn_mfma_f32_16x16x32_bf16(pack8(k0, k1), qf[ks], acc, 0, 0, 0); }
        s[x] = acc;
    }
#define AS_LOADV(dst_, db_) do { _Pragma("unroll") for (int j = 0; j < 8; ++j) { const int key = w * 32 + (j < 4 ? 4 * fq + j : 16 + 4 * fq + (j - 4)); dst_[j] = *(const f32x4*)(Vp + (unsigned)(key * D + (db_) * 64 + 4 * fr)); } } while (0)
#define AS_PROC(src_, db_) do { _Pragma("unroll") for (int i = 0; i < 4; ++i) { \
            u32x4 wv; wv.x = cvt_pk_bf16(src_[0][i], src_[1][i]); wv.y = cvt_pk_bf16(src_[2][i], src_[3][i]); wv.z = cvt_pk_bf16(src_[4][i], src_[5][i]); wv.w = cvt_pk_bf16(src_[6][i], src_[7][i]); \
            const f32x4 o = __builtin_amdgcn_mfma_f32_16x16x32_bf16(pf, __builtin_bit_cast(bf16x8, wv), (f32x4){0.f, 0.f, 0.f, 0.f}, 0, 0, 0); \
            *(LAS f32x4*)(RED + ((w * 16 + (db_) * 4 + i) * 64 + lane) * 4) = o; } } while (0)
    f32x4 va0[8], va1[8];
    AS_LOADV(va0, 0); AS_LOADV(va1, 1);
    float mx = fmaxf(fmaxf(fmaxf(s[0][0], s[0][1]), fmaxf(s[0][2], s[0][3])), fmaxf(fmaxf(s[1][0], s[1][1]), fmaxf(s[1][2], s[1][3])));
    mx = fmaxf(mx, shx(mx, 16)); mx = fmaxf(mx, shx(mx, 32));
    if (fq == 0) MXS[w * 16 + fr] = mx;
    lds_barrier();
    float gm = MXS[fr];
#pragma unroll
    for (int w2 = 1; w2 < 8; ++w2) gm = fmaxf(gm, MXS[w2 * 16 + fr]);
    float sum = 0.f;
#pragma unroll
    for (int x = 0; x < 2; ++x)
#pragma unroll
        for (int r = 0; r < 4; ++r) { const float p = __builtin_amdgcn_exp2f((s[x][r] - gm) * ATT_C); s[x][r] = p; sum += p; }
    sum += shx(sum, 16); sum += shx(sum, 32);
    if (fq == 0) SMS[w * 16 + fr] = sum;
    const bf16x8 pf = pack8(s[0], s[1]);
    {   f32x4 vb0[8], vb1[8];
        AS_LOADV(vb0, 2); AS_LOADV(vb1, 3);
        AS_PROC(va0, 0); AS_PROC(va1, 1); AS_PROC(vb0, 2); AS_PROC(vb1, 3);
    }
#undef AS_LOADV
#undef AS_PROC
    lds_barrier();
    {   const int db = w >> 1, i0 = 2 * (w & 1);
        f32x4 a0 = {0.f, 0.f, 0.f, 0.f}, a1 = {0.f, 0.f, 0.f, 0.f};
#pragma unroll
        for (int w2 = 0; w2 < 8; ++w2) { a0 = a0 + *(const LAS f32x4*)(RED + ((w2 * 16 + db * 4 + i0) * 64 + lane) * 4); a1 = a1 + *(const LAS f32x4*)(RED + ((w2 * 16 + db * 4 + i0 + 1) * 64 + lane) * 4); }
        if (fq < 2) {
#pragma unroll
            for (int r = 0; r < 4; ++r) {
                const int t = 4 * fq + r;
                float tot = 0.f;
#pragma unroll
                for (int w2 = 0; w2 < 8; ++w2) tot += SMS[w2 * 16 + t];
                const float inv = 1.0f / tot;
                *(unsigned*)(Op + (unsigned)(t * D + db * 64 + 4 * fr + i0)) = cvt_pk_bf16(a0[r] * inv, a1[r] * inv);
            }
        }
    }
    lds_barrier();
}
__device__ __forceinline__ void attn_phase(const Frame& F, const Args& a, int layer) {
    const bf16_t* Q = (const bf16_t*)(F.ws + WS_Q); bf16_t* O = (bf16_t*)(F.ws + WS_O);
    const bf16_t* KB = (const bf16_t*)(F.ws + WS_KB) + (size_t)layer * 2048 * D; const bf16_t* VT = (const bf16_t*)(F.ws + WS_VT) + (size_t)layer * 32 * 65536;
    const float* CK = a.in[I_CK] + (size_t)layer * SB * NMEM * D; const float* CV = a.in[I_CV] + (size_t)layer * SB * NMEM * D;
    for (int u = blockIdx.x; u < PB * 4 * (PL / 256); u += F.G) {
        const int x = u & 7, y = u >> 3, bh = x + 8 * (y >> 3), qb = y & 7, b = bh >> 2, h = bh & 3;
        const size_t row0 = (size_t)b * PL + qb * 256;
#ifndef NO_APW
        attn_prompt_wg(F, Q + row0 * D + h * 256, KB + (size_t)b * NMEM * D + h * 256, VT + (size_t)bh * 65536, O + row0 * D + h * 256);
#endif
    }
    Frame F2 = F; F2.tid = tid_now(F.wave); F2.lane = F2.tid & 63;
    for (int u = blockIdx.x; u < SB * 4; u += F.G) {
        const int b = u >> 2, h = u & 3; const size_t row0 = (size_t)MP + (size_t)b * SL;
#ifndef NO_ASW
        attn_sample_wg(F2, Q + row0 * D + h * 256, CK + (size_t)b * NMEM * D + h * 256, CV + (size_t)b * NMEM * D + h * 256, O + row0 * D + h * 256);
#endif
    }
}

constexpr int PH_PRO = 0, PH_KV = 1, PH_SEG0 = 2, PH_PER_SEG = 13, PH_FINAL = PH_SEG0 + 8 * PH_PER_SEG, PH_END = PH_FINAL + 1;
__global__ void __launch_bounds__(NTHR, 2) fwd(Args a) {
    extern __shared__ __attribute__((aligned(16))) unsigned char lds_raw[];
    Frame F;
    F.lds = (LAS unsigned char*)lds_raw;
    F.tid = threadIdx.x; F.lane = F.tid & 63; F.wave = __builtin_amdgcn_readfirstlane(F.tid >> 6);
    F.G = gridDim.x; F.gw = (int)blockIdx.x * NWAVES + F.wave; F.ngw = F.G * NWAVES;
    F.ws = a.ws; F.out = a.out;
    volatile LAS unsigned* MISC = (volatile LAS unsigned*)(F.lds + MISC_OFF);
    if (F.tid < 64) MISC[F.tid] = 0u;
    __syncthreads();
#if ONE_LAUNCH
    XcdBarrier bar = xcd_barrier_post((unsigned*)(a.ws + WS_CTL) + CW_BAR, MISC + 8, F.wave);
#define SEAM() xcd_barrier(bar)
#else
#define SEAM() do {} while (0)
#endif
#define PH(id) (a.ph_lo <= (id) && (id) < a.ph_hi)
#ifndef REP_SCAN
#define REP_SCAN 1
#endif
#ifndef REP_ATTN
#define REP_ATTN 1
#endif
#ifndef REP_NORM
#define REP_NORM 1
#endif
#ifndef REP_PRO
#define REP_PRO 1
#endif
#define REFRESH() do { F.tid = tid_now(F.wave); F.lane = F.tid & 63; F.ws = launder_u(a.ws); F.out = launder_f(a.out); F.gw = launder_i(F.gw); } while (0)
#define RELANE() do { F.tid = tid_now(F.wave); F.lane = F.tid & 63; } while (0)
#define WSB(off, T) ((T*)(F.ws + (off)))
#define XPTR WSB(WS_X, float)
#define SRC_P ((s == 0) ? a.in[I_XP] : (const float*)XPTR)
#define SRC_S ((s == 0) ? a.in[I_XS] : (const float*)XPTR + (size_t)MP * D)

#ifndef NO_PRO
    if (PH(PH_PRO)) for (int rep = 0; rep < REP_PRO; ++rep) { REFRESH(); p0_prologue(F, a); SEAM(); }
#endif
    const bool fill0 = (F.G == 256);
    if (PH(PH_KV)) {
        REFRESH();
        pg8::Gemm g{WSB(WS_WKV, const bf16_t), WSB(WS_WKV, const bf16_t), D, D, D, 0};
        pg8::KvOrder S{F.G, (int)blockIdx.x};
        pg8::EpiKV E{F.out + OUT_MK, F.out + OUT_MV, WSB(WS_KB, bf16_t), WSB(WS_VT, bf16_t)};
        pg8::gemm_phase<pg8::EpiKV, pg8::KvOrder, true, true>(F.lds, g, S, E, F.wave);
        if (fill0 && blockIdx.x >= 128) {
            RELANE(); Frame F2 = F; F2.gw = ((int)blockIdx.x - 128) * NWAVES + F.wave; F2.ngw = 128 * NWAVES;
            norm_phase<false>(F2, a.in[I_XP], a.in[I_XS], a.in[I_NF1], WSB(WS_U, bf16_t), WSB(WS_R, float), nullptr);
        }
        SEAM();
    }
#pragma unroll 1
    for (int s = 0; s < 8; ++s) {
        const int base = PH_SEG0 + s * PH_PER_SEG, layer = s >> 1, jl = layer >> 1;
        if (PH(base + 0) && !(fill0 && s == 0)) for (int rep = 0; rep < REP_NORM; ++rep) { REFRESH(); norm_phase<false>(F, SRC_P, SRC_S, a.in[(s & 1) ? I_NF2 : I_NF1] + layer * D, WSB(WS_U, bf16_t), WSB(WS_R, float), nullptr); SEAM(); }
#ifndef REP_GU
#define REP_GU 1
#endif
#ifndef REP_DOWN
#define REP_DOWN 1
#endif
        if (PH(base + 1)) for (int rep = 0; rep < REP_GU; ++rep) {
            REFRESH();
            pg8::Gemm g{WSB(WS_U, const bf16_t), WSB(WS_WGU + (size_t)s * SZ_WGU, const bf16_t), D, D, D, 0};
            pg8::StaticOrder S; S.init(M, 2 * FF, F.G, (int)blockIdx.x);
            pg8::EpiGU E{WSB(WS_H, bf16_t)};
            pg8::gemm_phase<pg8::EpiGU, pg8::StaticOrder, true, true>(F.lds, g, S, E, F.wave);
            SEAM();
        }
        if (PH(base + 2)) for (int rep = 0; rep < REP_DOWN; ++rep) {
            REFRESH(); const float alpha_ = (rep == REP_DOWN - 1) ? 0.5f : 0.0f;
            pg8::Gemm g{WSB(WS_H, const bf16_t), WSB(WS_WD + (size_t)s * SZ_WD, const bf16_t), FF, FF, FF, 0};
            pg8::StaticOrder S; S.init(MP, D, F.G, (int)blockIdx.x);
            pg8::EpiRes E{SRC_P, SRC_S, XPTR, alpha_, nullptr};
            pg8::Slab<MiniRes> SE{MiniRes{SRC_S - (size_t)MP * D, XPTR, alpha_, nullptr}};
            pg8::gemm_phase<pg8::EpiRes, pg8::StaticOrder, false, true, pg8::Slab<MiniRes>>(F.lds, g, S, E, F.wave, SE);
            SEAM();
        }
        if (s & 1) continue;
        if (PH(base + 3)) { REFRESH();
            if (layer & 1) norm_phase<false, false>(F, XPTR, XPTR + (size_t)MP * D, a.in[I_NMIX] + layer * D, WSB(WS_U, bf16_t), WSB(WS_R, float), nullptr);
            else norm_phase<false, true>(F, XPTR, XPTR + (size_t)MP * D, a.in[I_NMIX] + layer * D, WSB(WS_U, bf16_t), WSB(WS_R, float), nullptr);
            SEAM(); }
        if ((layer & 1) == 0) {
            if (PH(base + 4)) {
                REFRESH();
                pg8::Gemm g{WSB(WS_U, const bf16_t), WSB(WS_WIN + (size_t)jl * SZ_WIN, const bf16_t), D, D, D, 0};
                pg8::StaticOrder S; S.init(M, INP, F.G, (int)blockIdx.x);
                pg8::EpiBf16 E{WSB(WS_ZX, bf16_t), ZXP, ZXP / 256, WSB(WS_DT, float), a.in[I_DTB] + jl * 32};
                pg8::gemm_phase<pg8::EpiBf16, pg8::StaticOrder, true, true>(F.lds, g, S, E, F.wave);
                SEAM();
            }
#ifndef NO_SCAN
            if (PH(base + 12)) { REFRESH(); conv_phase(F, a, jl); SEAM(); }
            if (PH(base + 5)) for (int rep = 0; rep < REP_SCAN; ++rep) { REFRESH(); scan_phase(F, a, jl); SEAM(); }
#endif
            const bool gfold = (F.G == 256);
            if (PH(base + 6) && !gfold) { REFRESH(); gnorm_phase(F, a); SEAM(); }
            if (PH(base + 7)) {
                REFRESH();
                pg8::Gemm g{WSB(WS_V, const bf16_t), WSB(WS_WOUT + (size_t)jl * SZ_WOUT, const bf16_t), DI, DI, DI, 0};
                pg8::StaticOrder S; S.init(MP, D, F.G, (int)blockIdx.x);
                if (gfold) {
                    pg8::Unit u0; S.next(0, u0);
                    gnorm_table(F, u0.pm);
                    const LAS float* tab = (const LAS float*)(F.lds + GTAB_OFF);
                    pg8::EpiResG E{{XPTR, XPTR + (size_t)MP * D, XPTR, 1.0f, nullptr}, tab};
                    pg8::Slab<MiniRes> SE{MiniRes{XPTR, XPTR, 1.0f, nullptr}};
                    pg8::gemm_phase<pg8::EpiResG, pg8::StaticOrder, false, true, pg8::Slab<MiniRes>>(F.lds, g, S, E, F.wave, SE);
                } else {
                    pg8::EpiRes E{XPTR, XPTR + (size_t)MP * D, XPTR, 1.0f, nullptr};
                    pg8::Slab<MiniRes> SE{MiniRes{XPTR, XPTR, 1.0f, nullptr}};
                    pg8::gemm_phase<pg8::EpiRes, pg8::StaticOrder, false, true, pg8::Slab<MiniRes>>(F.lds, g, S, E, F.wave, SE);
                }
                SEAM();
            }
        } else {
#ifndef NO_POOL
            if (PH(base + 4)) { REFRESH(); pool_phase(F, a, jl, layer); SEAM(); }
#endif
            if (PH(base + 7)) {
                REFRESH();
                pg8::Gemm g{WSB(WS_Q, const bf16_t), WSB(WS_WPOOL + (size_t)jl * SZ_WPOOL, const bf16_t), 256, D, 256, 256};
                pg8::StaticOrder S; S.init(MP, D, F.G, (int)blockIdx.x);
                pg8::EpiRes E{XPTR, XPTR + (size_t)MP * D, XPTR, 1.0f, a.in[I_POOLS] + jl * D};
                pg8::Slab<MiniRes> SE{MiniRes{XPTR, XPTR, 1.0f, a.in[I_POOLS] + jl * D}};
                pg8::gemm_phase<pg8::EpiRes, pg8::StaticOrder, false, true, pg8::Slab<MiniRes>>(F.lds, g, S, E, F.wave, SE);
                SEAM();
            }
        }
        if (PH(base + 8)) for (int rep = 0; rep < REP_NORM; ++rep) { REFRESH(); norm_phase<false>(F, XPTR, XPTR + (size_t)MP * D, a.in[I_NCROSS] + layer * D, WSB(WS_U, bf16_t), WSB(WS_R, float), nullptr); SEAM(); }
        if (PH(base + 9)) {
            REFRESH();
            pg8::Gemm g{WSB(WS_U, const bf16_t), WSB(WS_WQ + (size_t)layer * SZ_WSQ, const bf16_t), D, D, D, 0};
            pg8::StaticOrder S; S.init(MP, D, F.G, (int)blockIdx.x);
            pg8::EpiBf16 E{WSB(WS_Q, bf16_t), D, -1, nullptr, nullptr};
            pg8::Slab<MiniBf16> SE{MiniBf16{WSB(WS_Q, bf16_t), D}};
            pg8::gemm_phase<pg8::EpiBf16, pg8::StaticOrder, false, true, pg8::Slab<MiniBf16>>(F.lds, g, S, E, F.wave, SE);
            SEAM();
        }
#ifndef NO_ATTN
        if (PH(base + 10)) for (int rep = 0; rep < REP_ATTN; ++rep) { REFRESH(); attn_phase(F, a, layer); SEAM(); }
#endif
        if (PH(base + 11)) {
            REFRESH();
            pg8::Gemm g{WSB(WS_O, const bf16_t), WSB(WS_WO + (size_t)layer * SZ_WSQ, const bf16_t), D, D, D, 0};
            pg8::StaticOrder S; S.init(MP, D, F.G, (int)blockIdx.x);
            pg8::EpiRes E{XPTR, XPTR + (size_t)MP * D, XPTR, 1.0f, nullptr};
            pg8::Slab<MiniRes> SE{MiniRes{XPTR, XPTR, 1.0f, nullptr}};
            pg8::gemm_phase<pg8::EpiRes, pg8::StaticOrder, false, true, pg8::Slab<MiniRes>>(F.lds, g, S, E, F.wave, SE);
            SEAM();
        }
    }
    if (PH(PH_FINAL)) { REFRESH(); norm_phase<true>(F, XPTR, XPTR + (size_t)MP * D, a.in[I_NFIN], nullptr, nullptr, F.out + OUT_Y); }
#undef PH
#undef SEAM
#undef REFRESH
#undef WSB
#undef XPTR
#undef SRC_P
#undef SRC_S
}

extern "C" void kernel_launch(void* const* d_in, const int* in_sizes, int n_in, void* d_out, int out_size, void* d_ws, size_t ws_size, hipStream_t stream) {
    static int grid = 0;
    if (grid == 0) {
        if (n_in != 34 || (size_t)out_size != OUT_END || ws_size < WS_END) { fprintf(stderr, "kernel_launch: unexpected shapes: n_in %d out %d (want %zu) ws %zu (want %zu)\n", n_in, out_size, (size_t)OUT_END, ws_size, (size_t)WS_END); grid = -1; return; }
        int dev = 0, cus = 0, per_cu = 0;
        if (hipGetDevice(&dev) != hipSuccess || hipDeviceGetAttribute(&cus, hipDeviceAttributeMultiprocessorCount, dev) != hipSuccess) { grid = -1; return; }
        if (hipFuncSetAttribute((const void*)fwd, hipFuncAttributeMaxDynamicSharedMemorySize, LDS_BYTES) != hipSuccess) { fprintf(stderr, "kernel_launch: hipFuncSetAttribute failed\n"); grid = -1; return; }
        if (hipOccupancyMaxActiveBlocksPerMultiprocessor(&per_cu, (const void*)fwd, NTHR, LDS_BYTES) != hipSuccess || per_cu < 1) { fprintf(stderr, "kernel_launch: occupancy query says %d\n", per_cu); }
        (void)hipGetLastError();
        grid = cus;
    }
    if (grid < 0) return;
    (void)hipMemsetAsync((char*)d_ws + WS_CTL, 0, CTL_ZERO_BYTES, stream);
    Args a{};
    for (int i = 0; i < 34; ++i) a.in[i] = (const float*)d_in[i];
    a.out = (float*)d_out; a.ws = (unsigned char*)d_ws;
#if ONE_LAUNCH
    a.ph_lo = 0; a.ph_hi = PH_END;
    hipLaunchKernelGGL(fwd, dim3(grid), dim3(NTHR), LDS_BYTES, stream, a);
#else
#ifndef PH_LIMIT
#define PH_LIMIT PH_END
#endif
    for (int id = 0; id < PH_END; ++id) {
        bool valid = false;
        if (id < PH_SEG0 || id == PH_FINAL) valid = true;
        else { const int s = (id - PH_SEG0) / PH_PER_SEG, k = (id - PH_SEG0) % PH_PER_SEG, layer = s >> 1;
               if (k <= 2) valid = true; else if (!(s & 1)) valid = (layer & 1) ? (k != 5 && k != 6 && k != 12) : true; }
        if (!valid) continue;
        if (id >= PH_LIMIT && id != PH_FINAL) continue;
        a.ph_lo = id; a.ph_hi = id + 1;
        hipLaunchKernelGGL(fwd, dim3(grid), dim3(NTHR), LDS_BYTES, stream, a);
    }
#endif
}
```

```cpp
#include <hip/hip_runtime.h>
#include <cstdio>
#include <cstdint>

#define GAS __attribute__((address_space(1)))
#define LAS __attribute__((address_space(3)))
typedef unsigned short bf16_t;
typedef short bf16x8 __attribute__((ext_vector_type(8)));
typedef float f32x4 __attribute__((ext_vector_type(4)));
typedef float f32x2 __attribute__((ext_vector_type(2)));
typedef unsigned u32x4 __attribute__((ext_vector_type(4)));
typedef unsigned u32x2 __attribute__((ext_vector_type(2)));

constexpr int D = 1024, FF = 2816, DI = 2048, CONVD = 3072, NHEAD = 32, HDIM = 64, NST = 128, NGRP = 4;
constexpr int INW = 5152, INP = 5376, ZXP = 5120;
constexpr int MP = 16384, MS = 1024, M = MP + MS;
constexpr int PB = 8, PL = 2048, SB = 128, SL = 8, NMEM = 256;
constexpr float EPS = 1e-5f;

__device__ __forceinline__ unsigned f2bf(float f) { unsigned u = __builtin_bit_cast(unsigned, f); return (u + 0x7fffu + ((u >> 16) & 1u)) >> 16; }
__device__ __forceinline__ float bf2f(unsigned h) { return __builtin_bit_cast(float, h << 16); }
__device__ __forceinline__ unsigned pk2(float lo, float hi) { return f2bf(lo) | (f2bf(hi) << 16); }
typedef __bf16 bf16x2_t __attribute__((ext_vector_type(2)));
__device__ __forceinline__ unsigned cvt_pk_bf16(float lo, float hi) { f32x2 v = {lo, hi}; bf16x2_t b = __builtin_convertvector(v, bf16x2_t); return __builtin_bit_cast(unsigned, b); }
__device__ __forceinline__ float fast_exp(float x) { return __builtin_amdgcn_exp2f(x * 1.4426950408889634f); }
__device__ __forceinline__ float silu_f(float x) { return x * __builtin_amdgcn_rcpf(1.0f + fast_exp(-x)); }
__device__ __forceinline__ float softplus_f(float x) { const float e = fast_exp(x); const float r = (x < -8.f) ? e : __builtin_amdgcn_logf(1.0f + e) * 0.6931471805599453f; return x > 20.f ? x : r; }
__device__ __forceinline__ int opaque(int x) { asm volatile("" : "+v"(x)); return x; }
__device__ __forceinline__ int lane_now() { int l; asm volatile("v_mbcnt_lo_u32_b32 %0, -1, 0\n\tv_mbcnt_hi_u32_b32 %0, -1, %0" : "=v"(l)); return l; }
__device__ __forceinline__ int tid_now(int wave) { return wave * 64 + lane_now(); }
__device__ __forceinline__ float shx(float v, int mask) { return __builtin_bit_cast(float, __builtin_amdgcn_ds_bpermute((lane_now() ^ mask) << 2, __builtin_bit_cast(int, v))); }
__device__ __forceinline__ float shi(float v, int src) { return __builtin_bit_cast(float, __builtin_amdgcn_ds_bpermute(src << 2, __builtin_bit_cast(int, v))); }
__device__ __forceinline__ float shup(float v, int o) { return __builtin_bit_cast(float, __builtin_amdgcn_ds_bpermute(((lane_now() - o) & 63) << 2, __builtin_bit_cast(int, v))); }
__device__ __forceinline__ float wave_sum(float v) {
#pragma unroll
    for (int o = 1; o < 64; o <<= 1) v += shx(v, o);
    return v;
}

namespace pg8 {
#define PG8_LAS __attribute__((address_space(3)))
constexpr int BM = 256, BK = 64, HALF = 128, HTB = HALF * BK * 2  , STAGE_BYTES = 8 * HTB, NXCD = 8, WGM = 8;

__host__ __device__ __forceinline__ int lds_byte(int r, int c) { const int st = (r >> 4) * 2 + (c >> 5), rr = r & 15, cc = c & 31, ob = rr * 64 + cc * 2; return st * 1024 + (ob ^ (((ob >> 9) & 1) << 5)); }
__host__ __device__ __forceinline__ void stage_rc(int b, int& R, int& C) { const int st = b / 1024, sb = b % 1024, swz = sb ^ (((sb >> 9) & 1) << 5); R = (st >> 1) * 16 + swz / 64; C = (st & 1) * 32 + (swz % 64) / 2; }
__host__ __device__ __forceinline__ int perm32(int rho) { const int n = rho >> 4, i = rho & 15; return 8 * (i >> 2) + 4 * n + (i & 3); }

struct Unit { int pm, pn; };
__host__ __device__ __forceinline__ int uni(int x) {
#if defined(__HIP_DEVICE_COMPILE__)
    x = __builtin_amdgcn_readfirstlane(x); asm volatile("" : "+s"(x)); return x;
#else
    return x;
#endif
}
struct Gemm { const bf16_t* A; const bf16_t* Bt; int K, lda, ldb, akoff; };

struct StaticOrder {
    int nM, nN, nwg, G, c;
    __host__ __device__ __forceinline__ void init(int M_, int N_, int G_, int c_) { nM = M_ / BM; nN = N_ / BM; nwg = nM * nN; G = G_; c = c_; }
    __host__ __device__ __forceinline__ bool next(int i, Unit& u) const {
        const long L = (long)i * G + c; if (L >= nwg) return false;
        int wgid = (int)L; { const int q = nwg / NXCD, r = nwg % NXCD, xcd = wgid % NXCD, off = wgid / NXCD; wgid = (xcd < r ? xcd * (q + 1) : r * (q + 1) + (xcd - r) * q) + off; }
        const int nig = WGM * nN, gid = wgid / nig, fm = gid * WGM, rem = wgid % nig;
        if (fm + WGM <= nM) { u.pm = uni(fm + rem % WGM); u.pn = uni(rem / WGM); }
        else { const int g2 = (nM % WGM) ? (nM % WGM) : 1; u.pm = uni(fm + rem % g2); u.pn = uni(rem / g2); }
        return true;
    }
};
struct KvOrder {
    int G, c;
    __host__ __device__ __forceinline__ bool next(int i, Unit& u) const {
        const int L = i * G + c; if (L >= 256) return false;
        const int l = L >> 6, r = L & 63, b = r & 7, j = r >> 3;
        u.pm = uni(32 + l * 8 + b); u.pn = uni(l * 8 + j);
        return true;
    }
};


struct EpiGU {
    static constexpr bool PERM = true;
    bf16_t* H;
    __device__ __forceinline__ void operator()(const f32x4 (&acc)[2][2][4][2], const Unit& u, int wr, int wc, int fr, int fq) const {
        const int row0 = u.pm * BM + wr * 64 + fr, col0 = u.pn * HALF + wc * 32 + 8 * fq;
#pragma unroll
        for (int ai = 0; ai < 2; ++ai)
#pragma unroll
            for (int m = 0; m < 4; ++m) {
                bf16_t* p = H + (unsigned)((row0 + ai * HALF + m * 16) * FF + col0);
                const f32x4 g0 = acc[ai][0][m][0], g1 = acc[ai][0][m][1], u0 = acc[ai][1][m][0], u1 = acc[ai][1][m][1];
                u32x4 w;
                w.x = cvt_pk_bf16(silu_f(g0[0]) * u0[0], silu_f(g0[1]) * u0[1]); w.y = cvt_pk_bf16(silu_f(g0[2]) * u0[2], silu_f(g0[3]) * u0[3]);
                w.z = cvt_pk_bf16(silu_f(g1[0]) * u1[0], silu_f(g1[1]) * u1[1]); w.w = cvt_pk_bf16(silu_f(g1[2]) * u1[2], silu_f(g1[3]) * u1[3]);
                *(u32x4*)p = w;
            }
    }
};
struct EpiRes {
    static constexpr bool PERM = false;
    const float* sp; const float* ss; float* X; float alpha; const float* scale;
    __device__ __forceinline__ void operator()(const f32x4 (&acc)[2][2][4][2], const Unit& u, int wr, int wc, int fr, int fq) const {
        const int row0 = u.pm * BM + wr * 64 + fr, col0 = u.pn * BM + wc * 32 + 4 * fq;
        const float* src = (u.pm < MP / BM) ? sp : (ss - (size_t)MP * D);
        f32x4 sc[2][2];
#pragma unroll
        for (int bj = 0; bj < 2; ++bj)
#pragma unroll
            for (int n = 0; n < 2; ++n) { sc[bj][n] = scale ? *(const f32x4*)(scale + col0 + bj * HALF + n * 16) : (f32x4){1.f, 1.f, 1.f, 1.f}; sc[bj][n] = sc[bj][n] * alpha; }
#pragma unroll
        for (int ai = 0; ai < 2; ++ai)
#pragma unroll
            for (int mp = 0; mp < 2; ++mp) {
                f32x4 v[2][2][2];
#pragma unroll
                for (int m2 = 0; m2 < 2; ++m2) { const unsigned off = (unsigned)((row0 + ai * HALF + (2 * mp + m2) * 16) * D + col0);
#pragma unroll
                    for (int bj = 0; bj < 2; ++bj)
#pragma unroll
                        for (int n = 0; n < 2; ++n) v[m2][bj][n] = *(const f32x4*)(src + (off + bj * HALF + n * 16)); }
#pragma unroll
                for (int m2 = 0; m2 < 2; ++m2) { const unsigned off = (unsigned)((row0 + ai * HALF + (2 * mp + m2) * 16) * D + col0);
#pragma unroll
                    for (int bj = 0; bj < 2; ++bj)
#pragma unroll
                        for (int n = 0; n < 2; ++n) *(f32x4*)(X + (off + bj * HALF + n * 16)) = v[m2][bj][n] + acc[ai][bj][2 * mp + m2][n] * sc[bj][n]; }
            }
    }
};
template <class T, class = void> struct epi_groups { static constexpr bool value = false; };
template <class T> struct epi_groups<T, decltype((void)T::GROUPS)> { static constexpr bool value = T::GROUPS; };
struct EpiResG : EpiRes {
    static constexpr bool GROUPS = true;
    const PG8_LAS float* tab;
    __device__ __forceinline__ void rescale_slab(f32x4 (&sa)[2], int gi, int fr) const { const float f = tab[(256 + fr) * 4 + gi]; sa[0] = sa[0] * f; sa[1] = sa[1] * f; }
    __device__ __forceinline__ void rescale(f32x4 (&acc)[2][2][4][2], int gi, int wr, int fr) const {
        const PG8_LAS float* t0 = tab + opaque((wr * 64 + fr) * 4 + gi);
#pragma unroll
        for (int ai = 0; ai < 2; ++ai)
#pragma unroll
            for (int m = 0; m < 4; ++m) {
                const float f = t0[(ai * HALF + m * 16) * 4];
#pragma unroll
                for (int bj = 0; bj < 2; ++bj)
#pragma unroll
                    for (int n = 0; n < 2; ++n) acc[ai][bj][m][n] = acc[ai][bj][m][n] * f;
            }
    }
};
struct EpiBf16 {
    static constexpr bool PERM = true;
    bf16_t* O; int ldc; int dt_tile; float* DT; const float* dt_bias;
    __device__ __forceinline__ void operator()(const f32x4 (&acc)[2][2][4][2], const Unit& u, int wr, int wc, int fr, int fq) const {
        const int row0 = u.pm * BM + wr * 64 + fr;
        if (u.pn == dt_tile) {
            if (wc == 0) {
#pragma unroll
                for (int n = 0; n < 2; ++n) { const f32x4 bv = *(const f32x4*)(dt_bias + 8 * fq + 4 * n);
#pragma unroll
                    for (int ai = 0; ai < 2; ++ai)
#pragma unroll
                        for (int m = 0; m < 4; ++m) { f32x4 v = acc[ai][0][m][n] + bv, o;
#pragma unroll
                            for (int i = 0; i < 4; ++i) o[i] = softplus_f(v[i]);
                            *(f32x4*)(DT + (unsigned)((row0 + ai * HALF + m * 16) * 32 + 8 * fq + 4 * n)) = o; } }
            }
            return;
        }
        const int col0 = u.pn * BM + wc * 32 + 8 * fq;
#pragma unroll
        for (int ai = 0; ai < 2; ++ai)
#pragma unroll
            for (int m = 0; m < 4; ++m) { bf16_t* rowp = O + (unsigned)((row0 + ai * HALF + m * 16) * ldc + col0);
#pragma unroll
                for (int bj = 0; bj < 2; ++bj) { const f32x4 v0 = acc[ai][bj][m][0], v1 = acc[ai][bj][m][1];
                    u32x4 w; w.x = cvt_pk_bf16(v0[0], v0[1]); w.y = cvt_pk_bf16(v0[2], v0[3]); w.z = cvt_pk_bf16(v1[0], v1[1]); w.w = cvt_pk_bf16(v1[2], v1[3]);
                    *(u32x4*)(rowp + bj * HALF) = w; } }
    }
};
struct EpiKV {
    static constexpr bool PERM = false;
    float* outK; float* outV; bf16_t* KB; bf16_t* VB;
    __device__ __forceinline__ void operator()(const f32x4 (&acc)[2][2][4][2], const Unit& u, int wr, int wc, int fr, int fq) const {
        const int l = (u.pm - 32) >> 3, b = (u.pm - 32) & 7, j = u.pn & 7, h = j & 3;
        const size_t boff = ((size_t)l * 2048 + b * 256) * D + h * 256;
        float* outp = (j >= 4 ? outV : outK) + boff;
        bf16_t* cp = (j >= 4 ? VB : KB) + boff;
        const int dl = wc * 32 + 4 * fq;
#pragma unroll
        for (int ai = 0; ai < 2; ++ai)
#pragma unroll
            for (int m = 0; m < 4; ++m) {
                const int rowoff = (ai * HALF + wr * 64 + m * 16 + fr) * D;
#pragma unroll
                for (int bj = 0; bj < 2; ++bj)
#pragma unroll
                    for (int n = 0; n < 2; ++n) {
                        const f32x4 v = acc[ai][bj][m][n];
                        const unsigned off = (unsigned)(rowoff + dl + bj * HALF + n * 16);
                        *(f32x4*)(outp + off) = v;
                        u32x2 w; w.x = cvt_pk_bf16(v[0], v[1]); w.y = cvt_pk_bf16(v[2], v[3]); *(u32x2*)(cp + off) = w;
                    }
            }
    }
};
constexpr int SLB_OFF = 131072 + 10240;
struct NoSlab { static constexpr bool ON = false; };
template <class E2> struct Slab { static constexpr bool ON = true; E2 e; };
template <class Epi, class Sched, bool ALIGN_EPI = false, bool SP2 = false, class SlabT = NoSlab>
__device__ __forceinline__ void gemm_phase(PG8_LAS unsigned char* lds, const Gemm g, const Sched& S, const Epi& E, int wave_, const SlabT& SL = SlabT{}) {
    static_assert(!SlabT::ON || SP2, "the slab rides in the SP2 schedule only");
    int tid_ = tid_now(wave_);
    const int tid = tid_, wid = __builtin_amdgcn_readfirstlane(tid >> 6), lane = tid & 63, wr = wid >> 2, wc = wid & 3, fr = lane & 15, fq = lane >> 4;
    const int K = g.K, nt = K / BK;
    unsigned voffA[2], voffB[2];
#pragma unroll
    for (int i = 0; i < 2; ++i) { int R, C; stage_rc(tid * 16 + i * 8192, R, C); const int Rb = Epi::PERM ? ((R & ~31) + perm32(R & 31)) : R;
        voffA[i] = (unsigned)(R * g.lda + C) * 2u; voffB[i] = (unsigned)(Rb * g.ldb + C) * 2u; }
    unsigned voffS = 0;
    if constexpr (SlabT::ON) { const int r = 2 * wid + (lane >> 5), p = lane & 31, c = (p >> 2) ^ (r & 7); voffS = (unsigned)(r * g.lda) * 2u + (unsigned)(c * 4 + (p & 3)) * 4u; }
    const int soff = (lane & 15) * 128, sq = lane >> 4, s7 = lane & 7;
    const size_t kstep = (size_t)(BK * 2);
    const size_t hstepA = (size_t)HALF * g.lda * 2, hstepB = (size_t)HALF * g.ldb * 2;
    const size_t tstepA = 2 * hstepA, tstepB = 2 * hstepB, akoffb = (size_t)g.akoff * 2;
    const unsigned ldsw = (unsigned)wid * 1024u;
    const int aoff = lds_byte(wr * 64 + fr, fq * 8), boff = lds_byte(wc * 32 + fr, fq * 8);
#define PG8_SA(b, h) (((b) * 2 + (h)) * HTB)
#define PG8_SB(b, h) ((4 + (b) * 2 + (h)) * HTB)
#define PG8_STAGE(bufoff, gbase, voff) do { _Pragma("unroll") for (int _i = 0; _i < 2; ++_i) \
        __builtin_amdgcn_global_load_lds((const unsigned*)((const char*)(gbase) + (voff)[_i]), (PG8_LAS unsigned*)(lds + (bufoff) + ldsw + _i * 8192), 16, 0, 0); } while (0)
#define PG8_LDA(dst, b, h) do { _Pragma("unroll") for (int m = 0; m < 4; ++m) _Pragma("unroll") for (int k = 0; k < 2; ++k) dst[m][k] = *(const PG8_LAS bf16x8*)(lds + PG8_SA(b, h) + aoff + m * 2048 + k * 1024); } while (0)
#define PG8_LDB(dst, b, h) do { _Pragma("unroll") for (int n = 0; n < 2; ++n) _Pragma("unroll") for (int k = 0; k < 2; ++k) dst[n][k] = *(const PG8_LAS bf16x8*)(lds + PG8_SB(b, h) + boff + n * 2048 + k * 1024); } while (0)
#define PG8_MMA(ai, bj, At, Bt) do { __builtin_amdgcn_s_setprio(1); _Pragma("unroll") for (int m = 0; m < 4; ++m) _Pragma("unroll") for (int n = 0; n < 2; ++n) _Pragma("unroll") for (int k = 0; k < 2; ++k) \
        acc[ai][bj][m][n] = __builtin_amdgcn_mfma_f32_16x16x32_bf16(Bt[n][k], At[m][k], acc[ai][bj][m][n], 0, 0, 0); __builtin_amdgcn_s_setprio(0); } while (0)
#define PG8_STAGE_S(b, gbase) do { if constexpr (SlabT::ON) __builtin_amdgcn_global_load_lds((const unsigned*)((const char*)(gbase) + voffS), (PG8_LAS unsigned*)(lds + SLB_OFF + (b) * 2048 + wid * 256), 4, 0, 0); } while (0)
#define PG8_LDS_S(b) do { if constexpr (SlabT::ON) { _Pragma("unroll") for (int k = 0; k < 2; ++k) SAf[k] = *(const PG8_LAS bf16x8*)(lds + SLB_OFF + (b) * 2048 + soff + (((4 * k + sq) ^ s7) << 4)); } } while (0)
#define PG8_MMA_S() do { if constexpr (SlabT::ON) { __builtin_amdgcn_s_setprio(1); if (wr == 0) { _Pragma("unroll") for (int n = 0; n < 2; ++n) _Pragma("unroll") for (int k = 0; k < 2; ++k) sacc[n] = __builtin_amdgcn_mfma_f32_16x16x32_bf16(B0[n][k], SAf[k], sacc[n], 0, 0, 0); } \
        else { _Pragma("unroll") for (int n = 0; n < 2; ++n) _Pragma("unroll") for (int k = 0; k < 2; ++k) sacc[n] = __builtin_amdgcn_mfma_f32_16x16x32_bf16(B1[n][k], SAf[k], sacc[n], 0, 0, 0); } __builtin_amdgcn_s_setprio(0); } } while (0)
#define PG8_WAIT_V8() do { if constexpr (SlabT::ON) asm volatile("s_waitcnt vmcnt(9)" ::: "memory"); else asm volatile("s_waitcnt vmcnt(8)" ::: "memory"); } while (0)
#define PG8_WAIT_V(n) asm volatile("s_waitcnt vmcnt(" #n ")" ::: "memory")
#define PG8_WAIT_L(n) asm volatile("s_waitcnt lgkmcnt(" #n ")" ::: "memory")
#define PG8_BAR __builtin_amdgcn_s_barrier()
#define PG8_SCHED __builtin_amdgcn_sched_barrier(0)
    Unit cur, nxt; int ui = 0;
    if (!S.next(0, cur)) return;
    f32x4 acc[2][2][4][2];
#pragma unroll
    for (int a = 0; a < 2; ++a)
#pragma unroll
        for (int b = 0; b < 2; ++b)
#pragma unroll
            for (int m = 0; m < 4; ++m)
#pragma unroll
                for (int n = 0; n < 2; ++n) acc[a][b][m][n] = (f32x4){0.f, 0.f, 0.f, 0.f};
    bf16x8 At[4][2], B0[2][2], B1[2][2];
    f32x4 sacc[2] = {{0.f, 0.f, 0.f, 0.f}, {0.f, 0.f, 0.f, 0.f}}; bf16x8 SAf[2];
    (void)sacc; (void)SAf; (void)soff; (void)sq; (void)s7; (void)voffS;
    const char* cA = (const char*)g.A + (size_t)cur.pm * tstepA + (size_t)cur.pn * akoffb; const char* cB = (const char*)g.Bt + (size_t)cur.pn * tstepB;
    const size_t sstep = (size_t)16 * g.lda * 2, sbase = (size_t)MP * g.lda * 2;
    const char* cS = (const char*)g.A + sbase + (size_t)cur.pm * sstep + (size_t)cur.pn * akoffb;
    if constexpr (SP2) {
        PG8_STAGE_S(0, cS);
        PG8_STAGE(PG8_SB(0, 0), cB, voffB); PG8_STAGE(PG8_SB(0, 1), cB + hstepB, voffB); PG8_STAGE(PG8_SA(0, 0), cA, voffA); PG8_STAGE(PG8_SA(0, 1), cA + hstepA, voffA);
        if (wr == 1) PG8_BAR;
        PG8_WAIT_V(2); PG8_BAR;
        PG8_STAGE_S(1, cS + kstep);
        PG8_STAGE(PG8_SB(1, 0), cB + kstep, voffB); PG8_STAGE(PG8_SA(1, 0), cA + kstep, voffA); PG8_STAGE(PG8_SB(1, 1), cB + hstepB + kstep, voffB);
        PG8_WAIT_V(6); PG8_BAR;
    } else {
        PG8_STAGE(PG8_SB(0, 0), cB, voffB); PG8_STAGE(PG8_SA(0, 0), cA, voffA); PG8_STAGE(PG8_SB(0, 1), cB + hstepB, voffB); PG8_STAGE(PG8_SA(0, 1), cA + hstepA, voffA);
        if (wr == 1) PG8_BAR;
        PG8_WAIT_V(4); PG8_BAR;
        PG8_STAGE(PG8_SB(1, 0), cB + kstep, voffB); PG8_STAGE(PG8_SA(1, 0), cA + kstep, voffA); PG8_STAGE(PG8_SB(1, 1), cB + hstepB + kstep, voffB);
        PG8_WAIT_V(6); PG8_BAR;
    }
    for (;;) {
        const bool has_next = S.next(ui + 1, nxt);
        const char* nA = has_next ? (const char*)g.A + (size_t)nxt.pm * tstepA + (size_t)nxt.pn * akoffb : cA; const char* nB = has_next ? (const char*)g.Bt + (size_t)nxt.pn * tstepB : cB;
        const char* nS = has_next ? (const char*)g.A + sbase + (size_t)nxt.pm * sstep + (size_t)nxt.pn * akoffb : cS;
        const int tspan = epi_groups<Epi>::value ? 8 : nt;
        for (int tg = 0; tg < nt; tg += tspan) {
        if constexpr (epi_groups<Epi>::value) { if (tg != 0) { const int lh = lane_now() & 15; E.rescale(acc, (tg >> 3) - 1, wr, lh); if constexpr (SlabT::ON) E.rescale_slab(sacc, (tg >> 3) - 1, lh); } }
        for (int t = tg; t < tg + tspan; t += 2) {
            const bool last = (t == nt - 2);
            const char* a1 = cA + (size_t)(t + 1) * kstep;
            const char* a2 = last ? nA : cA + (size_t)(t + 2) * kstep; const char* b2 = last ? nB : cB + (size_t)(t + 2) * kstep;
            const char* a3 = a2 + kstep; const char* b3 = b2 + kstep;
            const char* s2 = last ? nS : cS + (size_t)(t + 2) * kstep; const char* s3 = s2 + kstep; (void)s3;
            if constexpr (SP2) {
            PG8_LDB(B0, 0, 0); PG8_LDB(B1, 0, 1); PG8_SCHED; PG8_LDA(At, 0, 0); PG8_LDS_S(0); PG8_STAGE(PG8_SA(1, 1), a1 + hstepA, voffA);
            PG8_WAIT_V8(); PG8_WAIT_L(0); PG8_BAR; PG8_MMA(0, 0, At, B0); PG8_MMA(0, 1, At, B1); PG8_MMA_S(); PG8_BAR; PG8_SCHED;
            PG8_LDA(At, 0, 1); PG8_STAGE_S(0, s2); PG8_STAGE(PG8_SB(0, 0), b2, voffB); PG8_STAGE(PG8_SB(0, 1), b2 + hstepB, voffB); PG8_STAGE(PG8_SA(0, 0), a2, voffA);
            PG8_WAIT_V8(); PG8_WAIT_L(0); PG8_BAR; PG8_MMA(1, 0, At, B0); PG8_MMA(1, 1, At, B1); PG8_BAR; PG8_SCHED;
            PG8_LDB(B0, 1, 0); PG8_LDB(B1, 1, 1); PG8_SCHED; PG8_LDA(At, 1, 0); PG8_LDS_S(1); PG8_STAGE(PG8_SA(0, 1), a2 + hstepA, voffA);
            PG8_WAIT_V8(); PG8_WAIT_L(0); PG8_BAR; PG8_MMA(0, 0, At, B0); PG8_MMA(0, 1, At, B1); PG8_MMA_S(); PG8_BAR; PG8_SCHED;
            PG8_LDA(At, 1, 1); PG8_STAGE_S(1, s3); PG8_STAGE(PG8_SB(1, 0), b3, voffB); PG8_STAGE(PG8_SB(1, 1), b3 + hstepB, voffB); PG8_STAGE(PG8_SA(1, 0), a3, voffA);
            PG8_WAIT_V8(); PG8_WAIT_L(0); PG8_BAR; PG8_MMA(1, 0, At, B0); PG8_MMA(1, 1, At, B1); PG8_BAR; PG8_SCHED;
            } else {
            PG8_LDB(B0, 0, 0); PG8_SCHED; PG8_LDA(At, 0, 0); PG8_STAGE(PG8_SA(1, 1), a1 + hstepA, voffA);
            PG8_WAIT_L(8); PG8_BAR; PG8_WAIT_L(0); PG8_MMA(0, 0, At, B0); PG8_BAR; PG8_SCHED;
            PG8_LDB(B1, 0, 1); PG8_STAGE(PG8_SB(0, 0), b2, voffB);
            PG8_BAR; PG8_WAIT_L(0); PG8_MMA(0, 1, At, B1); PG8_BAR;
            PG8_LDA(At, 0, 1); PG8_STAGE(PG8_SA(0, 0), a2, voffA);
            PG8_BAR; PG8_WAIT_L(0); PG8_MMA(1, 0, At, B0); PG8_BAR; PG8_SCHED;
            PG8_STAGE(PG8_SB(0, 1), b2 + hstepB, voffB);
            PG8_WAIT_V(6); PG8_BAR; PG8_MMA(1, 1, At, B1); PG8_BAR;
            PG8_LDB(B0, 1, 0); PG8_SCHED; PG8_LDA(At, 1, 0); PG8_STAGE(PG8_SA(0, 1), a2 + hstepA, voffA);
            PG8_WAIT_L(8); PG8_BAR; PG8_WAIT_L(0); PG8_MMA(0, 0, At, B0); PG8_BAR; PG8_SCHED;
            PG8_LDB(B1, 1, 1); PG8_STAGE(PG8_SB(1, 0), b3, voffB);
            PG8_BAR; PG8_WAIT_L(0); PG8_MMA(0, 1, At, B1); PG8_BAR;
            PG8_LDA(At, 1, 1); PG8_STAGE(PG8_SA(1, 0), a3, voffA);
            PG8_BAR; PG8_WAIT_L(0); PG8_MMA(1, 0, At, B0); PG8_BAR; PG8_SCHED;
            PG8_STAGE(PG8_SB(1, 1), b3 + hstepB, voffB);
            PG8_WAIT_V(6); PG8_BAR; PG8_MMA(1, 1, At, B1); PG8_BAR;
            }
        }
        }
        if constexpr (ALIGN_EPI) { if (wr == 0) PG8_BAR; }
        const int le = lane_now();
        if constexpr (epi_groups<Epi>::value) E.rescale(acc, 3, wr, le & 15);
        E(acc, cur, wr, wc, le & 15, le >> 4);
        if constexpr (SlabT::ON) {
            if constexpr (epi_groups<Epi>::value) E.rescale_slab(sacc, 3, le & 15);
            const int srow = MP + 16 * cur.pm + (le & 15), scol = cur.pn * BM + wr * HALF + wc * 32 + (Epi::PERM ? 8 * (le >> 4) : 4 * (le >> 4));
#pragma unroll
            for (int n = 0; n < 2; ++n) { SL.e(srow, scol + (Epi::PERM ? 4 * n : 16 * n), sacc[n]); sacc[n] = (f32x4){0.f, 0.f, 0.f, 0.f}; }
        }
        if (!has_next) break;
#pragma unroll
        for (int a = 0; a < 2; ++a)
#pragma unroll
            for (int b = 0; b < 2; ++b)
#pragma unroll
                for (int m = 0; m < 4; ++m)
#pragma unroll
                    for (int n = 0; n < 2; ++n) acc[a][b][m][n] = (f32x4){0.f, 0.f, 0.f, 0.f};
        cur = nxt; cA = nA; cB = nB; ++ui;
        if constexpr (ALIGN_EPI) { if (wr == 1) PG8_BAR; }
    }
    PG8_WAIT_V(0);
    if constexpr (!ALIGN_EPI) { if (wr == 0) PG8_BAR; }
    PG8_BAR;
#undef PG8_SA
#undef PG8_SB
#undef PG8_STAGE
#undef PG8_LDA
#undef PG8_LDB
#undef PG8_MMA
#undef PG8_WAIT_V
#undef PG8_STAGE_S
#undef PG8_LDS_S
#undef PG8_MMA_S
#undef PG8_WAIT_V8
#undef PG8_WAIT_L
#undef PG8_BAR
#undef PG8_SCHED
}
}


constexpr int NWAVES = 8, NTHR = NWAVES * 64;
constexpr int RING_BYTES = 131072, MISC_OFF = RING_BYTES, LDS_BYTES = 147456;
#ifndef ONE_LAUNCH
#define ONE_LAUNCH 1
#endif

constexpr size_t al256(size_t x) { return (x + 255) & ~(size_t)255; }
constexpr size_t WS_CTL = 0, CTL_ZERO_BYTES = 1u << 20;
constexpr size_t SZ_WGU = (size_t)2 * FF * D * 2, SZ_WD = (size_t)D * FF * 2, SZ_WIN = (size_t)INP * D * 2, SZ_WOUT = (size_t)D * DI * 2, SZ_WSQ = (size_t)D * D * 2, SZ_WPOOL = (size_t)D * 256 * 2;
constexpr size_t WS_WGU = CTL_ZERO_BYTES;
constexpr size_t WS_WD = WS_WGU + 8 * SZ_WGU;
constexpr size_t WS_WIN = WS_WD + 8 * SZ_WD;
constexpr size_t WS_WOUT = WS_WIN + 2 * SZ_WIN;
constexpr size_t WS_WQ = WS_WOUT + 2 * SZ_WOUT;
constexpr size_t WS_WKV = WS_WQ + 4 * SZ_WSQ;
constexpr size_t WS_MN = WS_WKV + 8 * SZ_WSQ;
constexpr size_t WS_WO = WS_MN + 8 * SZ_WSQ;
constexpr size_t WS_WPOOL = WS_WO + 4 * SZ_WSQ;
constexpr size_t WS_X = al256(WS_WPOOL + 2 * SZ_WPOOL);
constexpr size_t WS_U = WS_X + (size_t)M * D * 4;
constexpr size_t WS_H = WS_U + (size_t)M * D * 2;
constexpr size_t WS_ZX = WS_H + (size_t)M * FF * 2;
constexpr size_t WS_DT = WS_ZX + (size_t)M * ZXP * 2;
constexpr size_t WS_SS = WS_DT + (size_t)M * 32 * 4;
constexpr size_t WS_V = WS_SS + (size_t)M * 32 * 4;
constexpr size_t WS_Q = WS_V + (size_t)M * DI * 2;
constexpr size_t WS_O = WS_Q + (size_t)M * D * 2;
constexpr size_t WS_R = WS_O + (size_t)M * D * 2;
constexpr size_t WS_KB = al256(WS_R + (size_t)M * 4);
constexpr size_t WS_VT = WS_KB + 4 * (size_t)2048 * D * 2;
constexpr size_t WS_XBC = WS_VT + 4 * (size_t)2048 * D * 2;
constexpr size_t WS_END = WS_XBC + (size_t)M * CONVD * 2;
constexpr int CW_BAR = 4096;

constexpr size_t OUT_Y = 0;
constexpr size_t OUT_SSM_P = (size_t)M * D;
constexpr size_t OUT_CONV_P = OUT_SSM_P + (size_t)2 * PB * NHEAD * HDIM * NST;
constexpr size_t OUT_POOL_P = OUT_CONV_P + (size_t)2 * PB * 3 * CONVD;
constexpr size_t OUT_MK = OUT_POOL_P + (size_t)2 * PB * 15 * D;
constexpr size_t OUT_MV = OUT_MK + (size_t)4 * PB * NMEM * D;
constexpr size_t OUT_SSM_S = OUT_MV + (size_t)4 * PB * NMEM * D;
constexpr size_t OUT_CONV_S = OUT_SSM_S + (size_t)2 * SB * NHEAD * HDIM * NST;
constexpr size_t OUT_POOL_S = OUT_CONV_S + (size_t)2 * SB * 3 * CONVD;
constexpr size_t OUT_END = OUT_POOL_S + (size_t)2 * SB * 15 * D;

#define XB_TMO      128
#define XB_XCNT(j)  (256  + 64 * (j))
#define XB_XSUB(j)  (1280 + 64 * (j))
#define XB_XGEN(j)  (2304 + 64 * (j))
#define XB_TOP      3328
#define XB_TOPGEN   3392
#define XCD_BAR_WORDS 3456
#define XB_SPIN_CAP (1u << 18)
__device__ __forceinline__ unsigned xb_ld(unsigned* p)              { return __hip_atomic_load(p, __ATOMIC_RELAXED, __HIP_MEMORY_SCOPE_AGENT); }
__device__ __forceinline__ unsigned xb_add(unsigned* p, unsigned v) { return __hip_atomic_fetch_add(p, v, __ATOMIC_RELAXED, __HIP_MEMORY_SCOPE_AGENT); }
__device__ __forceinline__ unsigned xb_xcc_id() { return (unsigned)__builtin_amdgcn_s_getreg((3 << 11) | 20) & 0xFu; }
#define XB_SPIN(cond, bar) do { unsigned _sp = 0; while (cond) { __builtin_amdgcn_s_sleep(1); \
    if ((++_sp & 255u) == 0u) { if (xb_ld(&(bar)[XB_TMO])) break; if (_sp > XB_SPIN_CAP) { atomicAdd(&(bar)[XB_TMO], 1u); break; } } } } while (0)
struct XcdBarrier { unsigned* bar; unsigned x; volatile LAS unsigned* st; int wave; };
__device__ __forceinline__ XcdBarrier xcd_barrier_post(unsigned* bar, volatile LAS unsigned* st, int wave) {
    XcdBarrier b; b.bar = bar; b.x = xb_xcc_id(); b.st = st; b.wave = wave;
    if (threadIdx.x == 0) (void)xb_add(&bar[XB_XCNT(b.x)], 1u);
    return b;
}
__device__ __forceinline__ void xcd_barrier_complete(unsigned* bar, unsigned x, unsigned& nloc, unsigned& nx) {
    const unsigned G = gridDim.x * gridDim.y * gridDim.z;
    unsigned sum, cnt, mine, sp = 0u;
    for (;;) {
        sum = 0u; cnt = 0u; mine = 0u;
#pragma unroll
        for (unsigned j = 0; j < 16; ++j) { const unsigned c = xb_ld(&bar[XB_XCNT(j)]); sum += c; cnt += (c > 0u) ? 1u : 0u; mine = (j == x) ? c : mine; }
        if (sum == G) break;
        __builtin_amdgcn_s_sleep(1);
        if ((++sp & 255u) == 0u) { if (xb_ld(&bar[XB_TMO])) break; if (sp > XB_SPIN_CAP) { atomicAdd(&bar[XB_TMO], 1u); break; } }
    }
    nloc = mine > 0u ? mine : 1u; nx = cnt > 0u ? cnt : 1u;
}
__device__ __forceinline__ void xcd_barrier(const XcdBarrier& b) {
    asm volatile("s_waitcnt vmcnt(0)" ::: "memory");
    __syncthreads();
    if (b.wave == 0 && lane_now() == 0) {
        unsigned* bar = b.bar;
        __builtin_amdgcn_s_waitcnt(0);
        unsigned nloc = b.st[0], nx = b.st[1];
        if (nloc == 0u) { xcd_barrier_complete(bar, b.x, nloc, nx); b.st[0] = nloc; b.st[1] = nx; }
        const unsigned old = xb_add(&bar[XB_XSUB(b.x)], 1u);
        const unsigned gen = old / nloc;
        if (old + 1u == (gen + 1u) * nloc) {
            __builtin_amdgcn_fence(__ATOMIC_RELEASE, "agent");
            asm volatile("s_waitcnt vmcnt(0)" ::: "memory");
            const unsigned og = xb_add(&bar[XB_TOP], 1u);
            const unsigned tg = og / nx;
            if (og + 1u == (tg + 1u) * nx) xb_add(&bar[XB_TOPGEN], 1u);
            else XB_SPIN(xb_ld(&bar[XB_TOPGEN]) == tg, bar);
            __builtin_amdgcn_fence(__ATOMIC_ACQUIRE, "agent");
            xb_add(&bar[XB_XGEN(b.x)], 1u);
            asm volatile("s_waitcnt vmcnt(0)" ::: "memory");
        } else {
            XB_SPIN(xb_ld(&bar[XB_XGEN(b.x)]) == gen, bar);
            __builtin_amdgcn_fence(__ATOMIC_ACQUIRE, "agent");
            asm volatile("s_waitcnt vmcnt(0)" ::: "memory");
        }
    }
    __syncthreads();
}

struct Args { const float* in[34]; float* out; unsigned char* ws; int ph_lo, ph_hi; };
enum { I_XP = 0, I_XS, I_MEM, I_CK, I_CV, I_SSM, I_SCONV, I_SPOOL, I_NF1, I_G1, I_U1, I_D1, I_NMIX, I_INW, I_CONVW, I_CONVB, I_DTB, I_ALOG, I_DSKIP, I_SNORM, I_OUTW,
       I_POOLW, I_POOLS, I_NCROSS, I_NMEM, I_WQ, I_WK, I_WV, I_WO, I_NF2, I_G2, I_U2, I_D2, I_NFIN };

struct Frame { LAS unsigned char* lds; unsigned char* ws; float* out; int tid, lane, wave, G, gw, ngw; };
__device__ __forceinline__ unsigned char* launder_u(unsigned char* p) { GAS unsigned char* g = (GAS unsigned char*)p; asm volatile("" : "+s"(g)); return (unsigned char*)g; }
__device__ __forceinline__ int launder_i(int x) { asm volatile("" : "+s"(x)); return x; }
__device__ __forceinline__ float* launder_f(float* p) { GAS float* g = (GAS float*)p; asm volatile("" : "+s"(g)); return (float*)g; }

__device__ __forceinline__ void transpose_item(const float* W, int ldw, int k0, int n0, bf16_t* WT, int ldt, int drow0, const float* ks, LAS float* scr, int lane) {
    { const int r8 = lane >> 3, c4 = lane & 7;
      f32x4 v[8];
#pragma unroll
      for (int i = 0; i < 8; ++i) v[i] = *(const f32x4*)(W + (size_t)(k0 + 8 * i + r8) * ldw + n0 + 4 * c4);
#pragma unroll
      for (int i = 0; i < 8; ++i) { const int kk = 8 * i + r8; f32x4 x = v[i]; if (ks) x = x * ks[k0 + kk];
          LAS float* d = scr + kk * 33 + 4 * c4; d[0] = x[0]; d[1] = x[1]; d[2] = x[2]; d[3] = x[3]; } }
    asm volatile("s_waitcnt lgkmcnt(0)" ::: "memory");
    const int c = lane & 7;
#pragma unroll
    for (int j = 0; j < 4; ++j) { const int n = (lane >> 3) + 8 * j; const LAS float* s = scr + (8 * c) * 33 + n;
        u32x4 o; o.x = pk2(s[0 * 33], s[1 * 33]); o.y = pk2(s[2 * 33], s[3 * 33]); o.z = pk2(s[4 * 33], s[5 * 33]); o.w = pk2(s[6 * 33], s[7 * 33]);
        *(u32x4*)(WT + (size_t)(drow0 + n) * ldt + k0 + 8 * c) = o; }
    asm volatile("s_waitcnt lgkmcnt(0)" ::: "memory");
}
__device__ __forceinline__ void p0_prologue(const Frame& F, const Args& a) {
    unsigned char* ws = F.ws;
    LAS float* scr = (LAS float*)(F.lds + F.wave * 16384);
    constexpr int I_GU = (D / 64) * (FF / 32), I_DN = (FF / 64) * (D / 32), I_IN = (D / 64) * (INW / 32), I_OUT = (DI / 64) * (D / 32), I_SQ = (D / 64) * (D / 32), I_PL = (256 / 64) * (256 / 32);
    constexpr int C0 = 16 * I_GU, C1 = C0 + 8 * I_DN, C2 = C1 + 2 * I_IN, C3 = C2 + 2 * I_OUT, C4 = C3 + 16 * I_SQ, C5 = C4 + 8 * I_PL;
    for (int it = F.gw; it < C5; it += F.ngw) {
        int r = it;
        if (r < C0) {
            const int q = r / I_GU, e = r % I_GU, which = q >> 2, layer = q & 3, kb = e / (FF / 32), nb = e % (FF / 32);
            const float* W = a.in[which == 0 ? I_G1 : which == 1 ? I_U1 : which == 2 ? I_G2 : I_U2] + (size_t)layer * D * FF;
            const int s = layer * 2 + (which >> 1), n0 = nb * 32, drow = (n0 >> 7) * 256 + (which & 1) * 128 + (n0 & 127);
            transpose_item(W, FF, kb * 64, n0, (bf16_t*)(ws + WS_WGU + (size_t)s * SZ_WGU), D, drow, nullptr, scr, F.lane);
        } else if (r < C1) {
            r -= C0; const int q = r / I_DN, e = r % I_DN, which = q >> 2, layer = q & 3, kb = e / (D / 32), nb = e % (D / 32);
            const float* W = a.in[which == 0 ? I_D1 : I_D2] + (size_t)layer * FF * D;
            transpose_item(W, D, kb * 64, nb * 32, (bf16_t*)(ws + WS_WD + (size_t)(layer * 2 + which) * SZ_WD), FF, nb * 32, nullptr, scr, F.lane);
        } else if (r < C2) {
            r -= C1; const int j = r / I_IN, e = r % I_IN, kb = e / (INW / 32), nb = e % (INW / 32);
            transpose_item(a.in[I_INW] + (size_t)j * D * INW, INW, kb * 64, nb * 32, (bf16_t*)(ws + WS_WIN + (size_t)j * SZ_WIN), D, nb * 32, nullptr, scr, F.lane);
        } else if (r < C3) {
            r -= C2; const int j = r / I_OUT, e = r % I_OUT, kb = e / (D / 32), nb = e % (D / 32);
            transpose_item(a.in[I_OUTW] + (size_t)j * DI * D, D, kb * 64, nb * 32, (bf16_t*)(ws + WS_WOUT + (size_t)j * SZ_WOUT), DI, nb * 32, a.in[I_SNORM] + j * DI, scr, F.lane);
        } else if (r < C4) {
            r -= C3; const int q = r / I_SQ, e = r % I_SQ, which = q >> 2, layer = q & 3, kb = e / (D / 32), nb = e % (D / 32);
            const float* W = a.in[which == 0 ? I_WQ : which == 1 ? I_WK : which == 2 ? I_WV : I_WO] + (size_t)layer * D * D;
            bf16_t* T = which == 0 ? (bf16_t*)(ws + WS_WQ + (size_t)layer * SZ_WSQ) : which == 3 ? (bf16_t*)(ws + WS_WO + (size_t)layer * SZ_WSQ)
                      : (bf16_t*)(ws + WS_WKV + (size_t)layer * 2 * SZ_WSQ + (which == 2 ? SZ_WSQ : 0));
            transpose_item(W, D, kb * 64, nb * 32, T, D, nb * 32, nullptr, scr, F.lane);
        } else {
            r -= C4; const int q = r / I_PL, e = r % I_PL, kb = e / 8, nb = e % 8;
            transpose_item(a.in[I_POOLW] + (size_t)q * 256 * 256, 256, kb * 64, nb * 32, (bf16_t*)(ws + WS_WPOOL) + (size_t)q * 256 * 256, 256, nb * 32, nullptr, scr, F.lane);
        }
    }
    for (int i = F.gw * 64 + F.lane; i < 2 * (INP - INW) * D / 8; i += F.ngw * 64) {
        const int j = i / ((INP - INW) * D / 8), e = i % ((INP - INW) * D / 8);
        *(u32x4*)((bf16_t*)(ws + WS_WIN + (size_t)j * SZ_WIN) + (size_t)INW * D + (size_t)e * 8) = (u32x4){0u, 0u, 0u, 0u};
    }
    for (int m = F.gw; m < PB * NMEM; m += F.ngw) {
        const f32x4* xr = (const f32x4*)(a.in[I_MEM] + (size_t)m * D) + F.lane;
        f32x4 v[4]; float s = 0.f;
#pragma unroll
        for (int j = 0; j < 4; ++j) { v[j] = xr[64 * j]; s += (v[j].x * v[j].x + v[j].y * v[j].y) + (v[j].z * v[j].z + v[j].w * v[j].w); }
        const float rstd = 1.f / sqrtf(wave_sum(s) * (1.f / D) + EPS);
#pragma unroll
        for (int i = 0; i < 4; ++i) {
            const f32x4* gr = (const f32x4*)(a.in[I_NMEM] + i * D) + F.lane;
            u32x2* o = (u32x2*)((bf16_t*)(ws + WS_MN) + ((size_t)i * 2048 + m) * D) + F.lane;
#pragma unroll
            for (int j = 0; j < 4; ++j) { const f32x4 g = gr[64 * j]; u32x2 w; w.x = pk2(v[j].x * rstd * g.x, v[j].y * rstd * g.y); w.y = pk2(v[j].z * rstd * g.z, v[j].w * rstd * g.w); o[64 * j] = w; }
        }
    }
}

template <bool FINAL, bool WU = true> __device__ __forceinline__ void norm_phase(const Frame& F, const float* sp, const float* ss, const float* gain, bf16_t* U, float* R, float* outf) {
    f32x4 g[4];
#pragma unroll
    for (int j = 0; j < 4; ++j) g[j] = ((const f32x4*)gain)[F.lane + 64 * j];
    for (int m0 = F.gw; m0 < M; m0 += 3 * F.ngw) {
        f32x4 v[3][4]; float s[3];
#pragma unroll
        for (int q = 0; q < 3; ++q) {
            const int m = m0 + q * F.ngw, mc = m < M ? m : m0;
            const float* xrow = mc < MP ? sp + (size_t)mc * D : ss + (size_t)(mc - MP) * D;
            const f32x4* xr = (const f32x4*)xrow + F.lane;
#pragma unroll
            for (int j = 0; j < 4; ++j) v[q][j] = xr[64 * j];
        }
#pragma unroll
        for (int q = 0; q < 3; ++q) { float t = 0.f;
#pragma unroll
            for (int j = 0; j < 4; ++j) t += (v[q][j].x * v[q][j].x + v[q][j].y * v[q][j].y) + (v[q][j].z * v[q][j].z + v[q][j].w * v[q][j].w);
            s[q] = t; }
#pragma unroll
        for (int o = 1; o < 64; o <<= 1) {
#pragma unroll
            for (int q = 0; q < 3; ++q) s[q] += shx(s[q], o);
        }
#pragma unroll
        for (int q = 0; q < 3; ++q) {
            const int m = m0 + q * F.ngw;
            if (m < M) {
                const float rstd = 1.f / sqrtf(s[q] * (1.f / D) + EPS);
                if constexpr (FINAL) {
                    f32x4* o = (f32x4*)(outf + (size_t)m * D) + F.lane;
#pragma unroll
                    for (int j = 0; j < 4; ++j) o[64 * j] = v[q][j] * rstd * g[j];
                } else {
                    u32x2* o = (u32x2*)(U + (size_t)m * D) + F.lane;
#pragma unroll
                    for (int j = 0; j < 4; ++j) if constexpr (WU) { u32x2 w; w.x = pk2(v[q][j].x * rstd * g[j].x, v[q][j].y * rstd * g[j].y); w.y = pk2(v[q][j].z * rstd * g[j].z, v[q][j].w * rstd * g[j].w); o[64 * j] = w; }
                    if (F.lane == 0) R[m] = rstd;
                }
            }
        }
    }
}

template <int W> __device__ __forceinline__ void pool_prompt_unit(const float* X, const float* R, const f32x4 g4, bf16_t* MIX, float* outp, int rb, int c, int vz) {
    const int row0 = rb * 32, b = row0 >> 11, t0 = row0 & 2047;
    f32x4 s = {0.f, 0.f, 0.f, 0.f};
#pragma unroll
    for (int j = 1; j < W; ++j) {
        const bool valid = t0 - j >= 0; const int rx = valid ? row0 - j : row0;
        const f32x4 x = *(const f32x4*)(X + (size_t)rx * D + c); const float r = R[rx + vz];
        s = s + x * (valid ? r : 0.f);
    }
#pragma unroll 1
    for (int q0 = 0; q0 < 32; q0 += 8) {
        f32x4 xn[8], xo[8]; float rn[8], rr[8];
#pragma unroll
        for (int i = 0; i < 8; ++i) {
            const int row = row0 + q0 + i, t = t0 + q0 + i;
            const bool vo = t - (W - 1) >= 0; const int ro = vo ? row - (W - 1) : row;
            xn[i] = *(const f32x4*)(X + (size_t)row * D + c); rn[i] = R[row + vz];
            xo[i] = *(const f32x4*)(X + (size_t)ro * D + c); rr[i] = vo ? R[ro + vz] : 0.f;
        }
#pragma unroll
        for (int i = 0; i < 8; ++i) {
            const int row = row0 + q0 + i, t = t0 + q0 + i;
            const f32x4 un = xn[i] * rn[i];
            s = s + un;
            const float inv = (t + 1 < W) ? 1.0f / (float)(t + 1) : 1.0f / (float)W;
            const f32x4 mix = (s * inv - un) * g4;
            u32x2 o; o.x = pk2(mix.x, mix.y); o.y = pk2(mix.z, mix.w);
            *(u32x2*)(MIX + (size_t)row * D + c) = o;
            if (t >= PL - 15) *(f32x4*)(outp + ((size_t)b * 15 + (t - (PL - 15))) * D + c) = un * g4;
            s = s - xo[i] * rr[i];
        }
    }
}
template <int W> __device__ __forceinline__ void pool_sample_unit(const float* X, const float* R, const float* sp, const f32x4 g4, bf16_t* MIX, float* ob, int b, int c, int vz) {
    const int row0 = MP + 8 * b;
    f32x4 s = {0.f, 0.f, 0.f, 0.f};
#pragma unroll
    for (int j = 1; j < W; ++j) s = s + *(const f32x4*)(sp + (size_t)(15 - j) * D + c);
    f32x4 xn[8]; float rn[8];
#pragma unroll
    for (int t = 0; t < 8; ++t) { xn[t] = *(const f32x4*)(X + (size_t)(row0 + t) * D + c); rn[t] = R[row0 + t + vz]; }
    f32x4 old[8];
#pragma unroll
    for (int t = 0; t < 8; ++t) if (t < W - 1) old[t] = *(const f32x4*)(sp + (size_t)(16 + t - W) * D + c);
#pragma unroll
    for (int t = 0; t < 8; ++t) {
        const f32x4 un = xn[t] * rn[t] * g4;
        s = s + un;
        const f32x4 mix = s * (1.0f / (float)W) - un;
        u32x2 o; o.x = pk2(mix.x, mix.y); o.y = pk2(mix.z, mix.w);
        *(u32x2*)(MIX + (size_t)(row0 + t) * D + c) = o;
        *(f32x4*)(ob + (size_t)(7 + t) * D + c) = un;
        if (t < W - 1) s = s - old[t]; else s = s - xn[t - (W - 1) < 0 ? 0 : t - (W - 1)] * rn[t - (W - 1) < 0 ? 0 : t - (W - 1)] * g4;
    }
}
__device__ __forceinline__ void pool_phase(const Frame& F, const Args& a, int jl, int layer) {
    const float* X = (const float*)(F.ws + WS_X); const float* R = (const float*)(F.ws + WS_R);
    bf16_t* MIX = (bf16_t*)(F.ws + WS_Q);
    const float* gain = a.in[I_NMIX] + layer * D;
    const float* spool = a.in[I_SPOOL] + (size_t)jl * SB * 15 * D;
    float* outp = F.out + OUT_POOL_P + (size_t)jl * PB * 15 * D;
    float* outs = F.out + OUT_POOL_S + (size_t)jl * SB * 15 * D;
    const int vz = opaque(0);
    for (int wu = F.gw; wu < (MP / 32) * 4; wu += F.ngw) {
        const int g = wu & 3, rb = wu >> 2, c = 256 * g + 4 * F.lane;
        const f32x4 g4 = *(const f32x4*)(gain + c);
        if (g == 0) pool_prompt_unit<2>(X, R, g4, MIX, outp, rb, c, vz);
        else if (g == 1) pool_prompt_unit<4>(X, R, g4, MIX, outp, rb, c, vz);
        else if (g == 2) pool_prompt_unit<8>(X, R, g4, MIX, outp, rb, c, vz);
        else pool_prompt_unit<16>(X, R, g4, MIX, outp, rb, c, vz);
    }
    if ((F.gw & 3) == 0) for (int su = F.gw >> 2; su < SB * 4; su += F.ngw >> 2) {
        const int g = su & 3, b = su >> 2, c = 256 * g + 4 * F.lane;
        const f32x4 g4 = *(const f32x4*)(gain + c);
        const float* sp = spool + (size_t)b * 15 * D; float* ob = outs + (size_t)b * 15 * D;
        if (g == 0) pool_sample_unit<2>(X, R, sp, g4, MIX, ob, b, c, vz);
        else if (g == 1) pool_sample_unit<4>(X, R, sp, g4, MIX, ob, b, c, vz);
        else if (g == 2) pool_sample_unit<8>(X, R, sp, g4, MIX, ob, b, c, vz);
        else pool_sample_unit<16>(X, R, sp, g4, MIX, ob, b, c, vz);
    }
    for (int i = F.gw * 64 + F.lane; i < SB * 7 * (D / 4); i += F.ngw * 64) {
        const int c4 = i % (D / 4), rr = (i / (D / 4)) % 7, b = i / (7 * (D / 4));
        *(f32x4*)(outs + ((size_t)b * 15 + rr) * D + c4 * 4) = *(const f32x4*)(spool + ((size_t)b * 15 + 8 + rr) * D + c4 * 4);
    }
}

__device__ __forceinline__ void gnorm_phase(const Frame& F, const Args& a) {
    bf16_t* V = (bf16_t*)(F.ws + WS_V); const float* SS = (const float*)(F.ws + WS_SS);
    for (int m0 = F.gw; m0 < M; m0 += 3 * F.ngw) {
        f32x4 s0[3]; u32x4 w[3][4];
#pragma unroll
        for (int q = 0; q < 3; ++q) {
            const int m = m0 + q * F.ngw, mc = m < M ? m : m0;
            s0[q] = *(const f32x4*)(SS + (size_t)mc * 32 + (F.lane & 7) * 4);
#pragma unroll
            for (int j = 0; j < 4; ++j) w[q][j] = *((const u32x4*)(V + (size_t)mc * DI + 512 * j) + F.lane);
        }
#pragma unroll
        for (int q = 0; q < 3; ++q) {
            const int m = m0 + q * F.ngw;
            float sg = (s0[q].x + s0[q].y) + (s0[q].z + s0[q].w);
            sg += shx(sg, 1);
#pragma unroll
            for (int j = 0; j < 4; ++j) {
                const float tot = shi(sg, 2 * j);
                const float r = __builtin_amdgcn_rsqf(tot * (1.f / 512.f) + EPS);
                u32x4 o;
#pragma unroll
                for (int e = 0; e < 4; ++e) { const unsigned x = w[q][j][e]; o[e] = cvt_pk_bf16(bf2f(x & 0xffffu) * r, bf2f(x >> 16) * r); }
                if (m < M) *((u32x4*)(V + (size_t)m * DI + 512 * j) + F.lane) = o;
            }
        }
    }
}


constexpr int GTAB_OFF = MISC_OFF + 4096;
static_assert(pg8::SLB_OFF == MISC_OFF + 10240 && GTAB_OFF + 272 * 16 <= pg8::SLB_OFF && pg8::SLB_OFF + 4096 <= LDS_BYTES, "slab buffers sit beyond the group-norm table inside the misc LDS region");
__device__ __forceinline__ void gnorm_table(const Frame& F, int pm) {
    const float* SS = (const float*)(F.ws + WS_SS);
    LAS float* tab = (LAS float*)(F.lds + GTAB_OFF);
    if (F.tid < 272) {
        const int row = F.tid < 256 ? pm * 256 + F.tid : MP + 16 * pm + (F.tid - 256);
        f32x4 v[8];
#pragma unroll
        for (int i = 0; i < 8; ++i) v[i] = *(const f32x4*)(SS + (size_t)row * 32 + 4 * i);
        float r[4];
#pragma unroll
        for (int g = 0; g < 4; ++g) { const f32x4 t = v[2 * g] + v[2 * g + 1]; r[g] = __builtin_amdgcn_rsqf(((t.x + t.y) + (t.z + t.w)) * (1.f / 512.f) + EPS); }
        f32x4 o; o.x = r[0] / r[1]; o.y = r[1] / r[2]; o.z = r[2] / r[3]; o.w = r[3];
        *(LAS f32x4*)(tab + F.tid * 4) = o;
    }
    __syncthreads();
}
__device__ __forceinline__ bf16x8 lfrag(const LAS bf16_t* base, int row, int pitch, int k) { return *(const LAS bf16x8*)(base + row * pitch + k); }
__device__ __forceinline__ void wave_lds_sync() { asm volatile("s_waitcnt lgkmcnt(0)" ::: "memory"); __builtin_amdgcn_wave_barrier(); }
__device__ __forceinline__ bf16x8 pack8(f32x4 a, f32x4 b) { u32x4 w; w.x = cvt_pk_bf16(a[0], a[1]); w.y = cvt_pk_bf16(a[2], a[3]); w.z = cvt_pk_bf16(b[0], b[1]); w.w = cvt_pk_bf16(b[2], b[3]); return __builtin_bit_cast(bf16x8, w); }

__device__ __forceinline__ void lds_barrier() { asm volatile("s_waitcnt lgkmcnt(0)" ::: "memory"); __builtin_amdgcn_s_barrier(); asm volatile("" ::: "memory"); }
__device__ __forceinline__ float row16_sum(float v) {
    v += __builtin_bit_cast(float, __builtin_amdgcn_update_dpp(0, __builtin_bit_cast(int, v), 0x128, 0xf, 0xf, false));
    v += __builtin_bit_cast(float, __builtin_amdgcn_update_dpp(0, __builtin_bit_cast(int, v), 0x124, 0xf, 0xf, false));
    v += __builtin_bit_cast(float, __builtin_amdgcn_update_dpp(0, __builtin_bit_cast(int, v), 0x122, 0xf, 0xf, false));
    v += __builtin_bit_cast(float, __builtin_amdgcn_update_dpp(0, __builtin_bit_cast(int, v), 0x121, 0xf, 0xf, false));
    return v;
}

struct MiniRes {
    const float* src; float* X; float alpha; const float* scale;
    __device__ __forceinline__ void operator()(int row, int col, f32x4 v) const {
        const unsigned off = (unsigned)(row * D + col);
        f32x4 sc = scale ? *(const f32x4*)(scale + col) : (f32x4){1.f, 1.f, 1.f, 1.f};
        *(f32x4*)(X + off) = *(const f32x4*)(src + off) + v * (sc * alpha);
    }
};
struct MiniBf16 {
    bf16_t* O; int ldc;
    __device__ __forceinline__ void operator()(int row, int col, f32x4 v) const {
        u32x2 w; w.x = cvt_pk_bf16(v[0], v[1]); w.y = cvt_pk_bf16(v[2], v[3]);
        *(u32x2*)(O + (unsigned)(row * ldc + col)) = w;
    }
};
__device__ __forceinline__ void conv_phase(const Frame& F, const Args& a, int jl) {
    const bf16_t* ZX = (const bf16_t*)(F.ws + WS_ZX); bf16_t* XBC = (bf16_t*)(F.ws + WS_XBC);
    const float* cw = a.in[I_CONVW] + (size_t)jl * 4 * CONVD; const float* cb = a.in[I_CONVB] + (size_t)jl * CONVD;
    const int lane = F.lane;
    constexpr int RPU = (M * 6) / 2048;
    static_assert(RPU * 2048 == M * 6, "conv runs");
#define CONV_UNPACK(dst, raw) do { dst[0] = (f32x4){bf2f((raw).x & 0xffffu), bf2f((raw).x >> 16), bf2f((raw).y & 0xffffu), bf2f((raw).y >> 16)}; dst[1] = (f32x4){bf2f((raw).z & 0xffffu), bf2f((raw).z >> 16), bf2f((raw).w & 0xffffu), bf2f((raw).w >> 16)}; } while (0)
    for (int u = F.gw; u < 2048; u += F.ngw) {
        int slab = -1, ch = 0;
        f32x4 w[4][2], bv[2], x0[2], x1[2], x2[2];
#pragma unroll
        for (int e = 0; e < 2; ++e) { x0[e] = (f32x4){0.f, 0.f, 0.f, 0.f}; x1[e] = x0[e]; x2[e] = x0[e]; bv[e] = x0[e];
#pragma unroll
            for (int k = 0; k < 4; ++k) w[k][e] = x0[e]; }
#pragma unroll 1
        for (int r0 = 0; r0 < RPU; r0 += 8) {
            u32x4 rq[8];
#pragma unroll
            for (int q = 0; q < 8; ++q) { const int rc = (r0 + q < RPU) ? r0 + q : RPU - 1; const int idx = u * RPU + rc, sl = idx / M, row = idx - sl * M;
                rq[q] = *(const u32x4*)(ZX + (size_t)row * ZXP + DI + sl * 512 + 8 * lane); }
#pragma unroll
            for (int q = 0; q < 8; ++q) {
                const int r = r0 + q;
                if (r < RPU) {
                    const int idx = u * RPU + r, sl = idx / M, row = idx - sl * M;
                    const bool isS = row >= MP;
                    const int t = isS ? ((row - MP) & 7) : (row & (PL - 1));
                    if (sl != slab) {
                        slab = sl; ch = sl * 512 + 8 * lane;
#pragma unroll
                        for (int k = 0; k < 4; ++k) { w[k][0] = *(const f32x4*)(cw + k * CONVD + ch); w[k][1] = *(const f32x4*)(cw + k * CONVD + ch + 4); }
                        bv[0] = *(const f32x4*)(cb + ch); bv[1] = *(const f32x4*)(cb + ch + 4);
                    }
                    if (r == 0 || t == 0) {
                        const float* sc = a.in[I_SCONV] + (((size_t)jl * SB + (isS ? ((row - MP) >> 3) : 0)) * 3) * CONVD + ch;
#pragma unroll
                        for (int j = 1; j <= 3; ++j) {
                            f32x4 h[2];
                            if (t - j >= 0) { const u32x4 rw = *(const u32x4*)(ZX + (size_t)(row - j) * ZXP + DI + ch); CONV_UNPACK(h, rw); }
                            else if (isS) { h[0] = *(const f32x4*)(sc + (size_t)(3 + t - j) * CONVD); h[1] = *(const f32x4*)(sc + (size_t)(3 + t - j) * CONVD + 4); }
                            else { h[0] = (f32x4){0.f, 0.f, 0.f, 0.f}; h[1] = h[0]; }
                            if (j == 1) { x2[0] = h[0]; x2[1] = h[1]; } else if (j == 2) { x1[0] = h[0]; x1[1] = h[1]; } else { x0[0] = h[0]; x0[1] = h[1]; }
                        }
                    }
                    f32x4 x3[2]; CONV_UNPACK(x3, rq[q]);
                    u32x4 o;
                    {   f32x4 v0 = bv[0] + w[0][0] * x0[0] + w[1][0] * x1[0] + w[2][0] * x2[0] + w[3][0] * x3[0];
                        f32x4 v1 = bv[1] + w[0][1] * x0[1] + w[1][1] * x1[1] + w[2][1] * x2[1] + w[3][1] * x3[1];
                        o.x = cvt_pk_bf16(silu_f(v0[0]), silu_f(v0[1])); o.y = cvt_pk_bf16(silu_f(v0[2]), silu_f(v0[3]));
                        o.z = cvt_pk_bf16(silu_f(v1[0]), silu_f(v1[1])); o.w = cvt_pk_bf16(silu_f(v1[2]), silu_f(v1[3])); }
                    *(u32x4*)(XBC + (size_t)row * CONVD + ch) = o;
#pragma unroll
                    for (int e = 0; e < 2; ++e) { x0[e] = x1[e]; x1[e] = x2[e]; x2[e] = x3[e]; }
                }
            }
        }
    }
#undef CONV_UNPACK
}

constexpr int SC_CM = 0, SC_XD = 17408, SC_BM = 34816, SC_XW = 53248, SC_LM = 71680, SC_XS = 80896, SC_HS = 90112, SC_ZT = 107520, SC_VT = 116736, SC_F32 = 125952;
__device__ __forceinline__ void scan_prompt_unit(const Frame& F, const Args& a, int jl, int b, int h) {
    LAS unsigned char* L = F.lds;
    LAS bf16_t* CM = (LAS bf16_t*)(L + SC_CM); LAS bf16_t* BM = (LAS bf16_t*)(L + SC_BM);
    LAS bf16_t* XD = (LAS bf16_t*)(L + SC_XD); LAS bf16_t* XW = (LAS bf16_t*)(L + SC_XW); LAS bf16_t* LM = (LAS bf16_t*)(L + SC_LM);
    LAS bf16_t* XS = (LAS bf16_t*)(L + SC_XS); LAS bf16_t* HS = (LAS bf16_t*)(L + SC_HS);
    LAS bf16_t* ZT = (LAS bf16_t*)(L + SC_ZT); LAS bf16_t* VT = (LAS bf16_t*)(L + SC_VT);
    LAS float* FB = (LAS float*)(L + SC_F32);
    LAS float* SSP = FB + 2 * 256;
    const int g = h >> 3, tid = F.tid, lane = F.lane, w = F.wave, fr = lane & 15, fq = lane >> 4;
    const bf16_t* ZX = (const bf16_t*)(F.ws + WS_ZX); const bf16_t* XBC = (const bf16_t*)(F.ws + WS_XBC); const float* DT = (const float*)(F.ws + WS_DT);
    bf16_t* V = (bf16_t*)(F.ws + WS_V); float* SS = (float*)(F.ws + WS_SS);
    const float A_h = -__expf(a.in[I_ALOG][jl * 32 + h]), dsk = a.in[I_DSKIP][jl * 32 + h];
    const size_t row0 = (size_t)b * PL;
    for (int i = tid; i < 64 * 136 / 2; i += NTHR) ((LAS unsigned*)HS)[i] = 0u;
    f32x4 hacc[4];
#pragma unroll
    for (int j = 0; j < 4; ++j) hacc[j] = (f32x4){0.f, 0.f, 0.f, 0.f};
    const int qt = w >> 1, xh = w & 1;
    const unsigned trq4 = (unsigned)(fr >> 2), trp4 = (unsigned)(fr & 3);
    const unsigned trx = (unsigned)(size_t)L + (8u * fq + trq4) * 160u + 8u * trp4 + 64u * (unsigned)xh;
    const unsigned trw = (unsigned)(size_t)L + (8u * fq + trq4) * 160u + 8u * trp4 + 32u * (unsigned)qt;
    const unsigned trb = (unsigned)(size_t)L + (8u * fq + trq4) * 288u + 8u * trp4 + 128u * (unsigned)xh;
    u32x4 pre[5], prez; float predt;
    const int zr = tid >> 3, zo = tid & 7;
#define SCAN_CH(it_) ((it_) == 0 ? h * 64 + 8 * w : ((it_) < 3 ? DI + g * 128 + 8 * (w + 8 * ((it_) - 1)) : DI + 512 + g * 128 + 8 * (w + 8 * ((it_) - 3))))
#define SCAN_LOAD(c_) do { const size_t rb_ = row0 + (size_t)(c_) * 64; \
        _Pragma("unroll") for (int it = 0; it < 5; ++it) pre[it] = *(const u32x4*)(XBC + (rb_ + lane) * CONVD + SCAN_CH(it)); \
        prez = *(const u32x4*)(ZX + (rb_ + zr) * ZXP + h * 64 + 8 * zo); predt = DT[(rb_ + lane) * 32 + h]; } while (0)
#define SCAN_STEP0(c_) do { if (w == 0) { LAS float* fb_ = FB + ((c_) & 1) * 256; \
        const float dtv = predt; float x = A_h * dtv; \
        _Pragma("unroll") for (int o = 1; o < 64; o <<= 1) { const float y = shup(x, o); if (lane >= o) x += y; } \
        const float tot = shi(x, 63); fb_[lane] = x; fb_[64 + lane] = dtv; fb_[128 + lane] = __expf(tot - x); if (lane == 0) fb_[192] = __expf(tot); } } while (0)
    SCAN_LOAD(0);
    SCAN_STEP0(0);
    __syncthreads();
    for (int c = 0; c < PL / 64; ++c) {
        const int t0 = c * 64;
        LAS float* fb = FB + (c & 1) * 256;
        {   const int r = lane;
            {   const u32x4 pk = pre[0];
                *(LAS u32x4*)(XS + r * 72 + 8 * w) = pk;
                const float dtl = fb[64 + r], dte = fb[128 + r];
                u32x4 d4, w4;
#pragma unroll
                for (int e = 0; e < 4; ++e) { const float x0 = bf2f(pk[e] & 0xffffu) * dtl, x1 = bf2f(pk[e] >> 16) * dtl; d4[e] = cvt_pk_bf16(x0, x1); w4[e] = cvt_pk_bf16(x0 * dte, x1 * dte); }
                *(LAS u32x4*)(XD + r * 80 + 8 * w) = d4; *(LAS u32x4*)(XW + r * 80 + 8 * w) = w4; }
#pragma unroll
            for (int it = 1; it < 3; ++it) *(LAS u32x4*)(BM + r * 144 + 8 * (w + 8 * (it - 1))) = pre[it];
#pragma unroll
            for (int it = 3; it < 5; ++it) *(LAS u32x4*)(CM + r * 136 + 8 * (w + 8 * (it - 3))) = pre[it];
        }
        *(LAS u32x4*)(ZT + zr * 72 + 8 * zo) = prez;
        lds_barrier();
        { const int cn = (c + 1 < PL / 64) ? c + 1 : c; SCAN_LOAD(cn); }
        const float cdec = fb[192];
        f32x4 yoff[2];
#pragma unroll
        for (int x = 0; x < 2; ++x) {
            const int ct = 2 * xh + x;
            f32x4 c1 = {0.f, 0.f, 0.f, 0.f}, c3 = {0.f, 0.f, 0.f, 0.f};
#pragma unroll
            for (int ks = 0; ks < 4; ++ks) {
                const bf16x8 af = lfrag(CM, qt * 16 + fr, 136, ks * 32 + 8 * fq);
                const bf16x8 b1 = lfrag(BM, ct * 16 + fr, 144, ks * 32 + 8 * fq);
                const bf16x8 b3 = lfrag(HS, ct * 16 + fr, 136, ks * 32 + 8 * fq);
                c1 = __builtin_amdgcn_mfma_f32_16x16x32_bf16(af, b1, c1, 0, 0, 0);
                c3 = __builtin_amdgcn_mfma_f32_16x16x32_bf16(af, b3, c3, 0, 0, 0);
            }
            const int kk = ct * 16 + fr; const float ak = fb[kk];
#pragma unroll
            for (int r = 0; r < 4; ++r) {
                const int q = qt * 16 + 4 * fq + r; const float aq = fb[q];
                const float lv = (kk <= q) ? c1[r] * __expf(aq - ak) : 0.f;
                LM[q * 72 + kk] = (bf16_t)cvt_pk_bf16(lv, 0.f);
                yoff[x][r] = c3[r] * __expf(aq);
            }
        }
        lds_barrier();
        float ssq[4] = {0.f, 0.f, 0.f, 0.f};
        bf16x8 xdf[2][2];
        {   u32x2 r0, r1, r2, r3, r4, r5, r6, r7; const unsigned ad = trx + SC_XD;
            asm volatile("ds_read_b64_tr_b16 %0, %8\n\tds_read_b64_tr_b16 %1, %8 offset:640\n\tds_read_b64_tr_b16 %2, %8 offset:5120\n\tds_read_b64_tr_b16 %3, %8 offset:5760\n\t"
                         "ds_read_b64_tr_b16 %4, %8 offset:32\n\tds_read_b64_tr_b16 %5, %8 offset:672\n\tds_read_b64_tr_b16 %6, %8 offset:5152\n\tds_read_b64_tr_b16 %7, %8 offset:5792\n\ts_waitcnt lgkmcnt(0)"
                         : "=&v"(r0), "=&v"(r1), "=&v"(r2), "=&v"(r3), "=&v"(r4), "=&v"(r5), "=&v"(r6), "=&v"(r7) : "v"(ad) : "memory");
            xdf[0][0] = __builtin_bit_cast(bf16x8, (u32x4){r0.x, r0.y, r1.x, r1.y}); xdf[0][1] = __builtin_bit_cast(bf16x8, (u32x4){r2.x, r2.y, r3.x, r3.y});
            xdf[1][0] = __builtin_bit_cast(bf16x8, (u32x4){r4.x, r4.y, r5.x, r5.y}); xdf[1][1] = __builtin_bit_cast(bf16x8, (u32x4){r6.x, r6.y, r7.x, r7.y}); }
#pragma unroll
        for (int x = 0; x < 2; ++x) {
            const int pt = 2 * xh + x;
            f32x4 c2 = yoff[x];
#pragma unroll
            for (int ks = 0; ks < 2; ++ks)
                c2 = __builtin_amdgcn_mfma_f32_16x16x32_bf16(lfrag(LM, qt * 16 + fr, 72, ks * 32 + 8 * fq), xdf[x][ks], c2, 0, 0, 0);
            const int p = pt * 16 + fr;
#pragma unroll
            for (int r = 0; r < 4; ++r) {
                const int q = qt * 16 + 4 * fq + r;
                const float y = c2[r] + dsk * bf2f(XS[q * 72 + p]);
                const float vv = y * silu_f(bf2f(ZT[q * 72 + p]));
                VT[q * 72 + p] = (bf16_t)cvt_pk_bf16(vv, 0.f);
                ssq[r] += vv * vv;
            }
        }
#pragma unroll
        for (int r = 0; r < 4; ++r) { const float s = row16_sum(ssq[r]); if (fr == 0) SSP[xh * 64 + qt * 16 + 4 * fq + r] = s; }
        bf16x8 xwf[2], bmf[4][2];
        {   u32x2 r0, r1, r2, r3, r4, r5, r6, r7, r8, r9, r10, r11; const unsigned aw = trw + SC_XW, ab = trb + SC_BM;
            asm volatile("ds_read_b64_tr_b16 %0, %12\n\tds_read_b64_tr_b16 %1, %12 offset:640\n\tds_read_b64_tr_b16 %2, %12 offset:5120\n\tds_read_b64_tr_b16 %3, %12 offset:5760\n\t"
                         "ds_read_b64_tr_b16 %4, %13\n\tds_read_b64_tr_b16 %5, %13 offset:1152\n\tds_read_b64_tr_b16 %6, %13 offset:9216\n\tds_read_b64_tr_b16 %7, %13 offset:10368\n\t"
                         "ds_read_b64_tr_b16 %8, %13 offset:32\n\tds_read_b64_tr_b16 %9, %13 offset:1184\n\tds_read_b64_tr_b16 %10, %13 offset:9248\n\tds_read_b64_tr_b16 %11, %13 offset:10400\n\ts_waitcnt lgkmcnt(0)"
                         : "=&v"(r0), "=&v"(r1), "=&v"(r2), "=&v"(r3), "=&v"(r4), "=&v"(r5), "=&v"(r6), "=&v"(r7), "=&v"(r8), "=&v"(r9), "=&v"(r10), "=&v"(r11) : "v"(aw), "v"(ab) : "memory");
            xwf[0] = __builtin_bit_cast(bf16x8, (u32x4){r0.x, r0.y, r1.x, r1.y}); xwf[1] = __builtin_bit_cast(bf16x8, (u32x4){r2.x, r2.y, r3.x, r3.y});
            bmf[0][0] = __builtin_bit_cast(bf16x8, (u32x4){r4.x, r4.y, r5.x, r5.y}); bmf[0][1] = __builtin_bit_cast(bf16x8, (u32x4){r6.x, r6.y, r7.x, r7.y});
            bmf[1][0] = __builtin_bit_cast(bf16x8, (u32x4){r8.x, r8.y, r9.x, r9.y}); bmf[1][1] = __builtin_bit_cast(bf16x8, (u32x4){r10.x, r10.y, r11.x, r11.y}); }
        {   u32x2 r0, r1, r2, r3, r4, r5, r6, r7; const unsigned ab = trb + SC_BM;
            asm volatile("ds_read_b64_tr_b16 %0, %8 offset:64\n\tds_read_b64_tr_b16 %1, %8 offset:1216\n\tds_read_b64_tr_b16 %2, %8 offset:9280\n\tds_read_b64_tr_b16 %3, %8 offset:10432\n\t"
                         "ds_read_b64_tr_b16 %4, %8 offset:96\n\tds_read_b64_tr_b16 %5, %8 offset:1248\n\tds_read_b64_tr_b16 %6, %8 offset:9312\n\tds_read_b64_tr_b16 %7, %8 offset:10464\n\ts_waitcnt lgkmcnt(0)"
                         : "=&v"(r0), "=&v"(r1), "=&v"(r2), "=&v"(r3), "=&v"(r4), "=&v"(r5), "=&v"(r6), "=&v"(r7) : "v"(ab) : "memory");
            bmf[2][0] = __builtin_bit_cast(bf16x8, (u32x4){r0.x, r0.y, r1.x, r1.y}); bmf[2][1] = __builtin_bit_cast(bf16x8, (u32x4){r2.x, r2.y, r3.x, r3.y});
            bmf[3][0] = __builtin_bit_cast(bf16x8, (u32x4){r4.x, r4.y, r5.x, r5.y}); bmf[3][1] = __builtin_bit_cast(bf16x8, (u32x4){r6.x, r6.y, r7.x, r7.y}); }
#pragma unroll
        for (int j = 0; j < 4; ++j) {
            const int nt = 4 * xh + j;
            f32x4 acc = hacc[j] * cdec;
#pragma unroll
            for (int ks = 0; ks < 2; ++ks)
                acc = __builtin_amdgcn_mfma_f32_16x16x32_bf16(xwf[ks], bmf[j][ks], acc, 0, 0, 0);
            hacc[j] = acc;
#pragma unroll
            for (int r = 0; r < 4; ++r) HS[(qt * 16 + 4 * fq + r) * 136 + nt * 16 + fr] = (bf16_t)cvt_pk_bf16(acc[r], 0.f);
        }
        SCAN_STEP0(c + 1);
        lds_barrier();
        *(u32x4*)(V + (row0 + t0 + zr) * DI + h * 64 + 8 * zo) = *(const LAS u32x4*)(VT + zr * 72 + 8 * zo);
        if (tid < 64) SS[(row0 + t0 + tid) * 32 + h] = SSP[tid] + SSP[64 + tid];
    }
#undef SCAN_LOAD
#undef SCAN_CH
#undef SCAN_STEP0
    float* outS = F.out + OUT_SSM_P + (((size_t)jl * PB + b) * NHEAD + h) * HDIM * NST;
#pragma unroll
    for (int j = 0; j < 4; ++j)
#pragma unroll
        for (int r = 0; r < 4; ++r) outS[(qt * 16 + 4 * fq + r) * NST + (4 * xh + j) * 16 + fr] = hacc[j][r];
    __syncthreads();
}

__device__ __forceinline__ void scan_sample_unit(const Frame& F, const Args& a, int jl, int b, int h) {
    LAS float* S = (LAS float*)(F.lds + F.wave * 16384);
    LAS float* xsS = S; LAS float* bmS = S + 512; LAS float* cmS = bmS + 1056; LAS float* xdtS = cmS + 1056; LAS float* xdtwS = xdtS + 512; LAS float* LmS = xdtwS + 512; LAS float* acsS = LmS + 64;
    const int lane = F.lane, g = h >> 3;
    const bf16_t* ZX = (const bf16_t*)(F.ws + WS_ZX); const bf16_t* XBC = (const bf16_t*)(F.ws + WS_XBC); const float* DT = (const float*)(F.ws + WS_DT);
    bf16_t* V = (bf16_t*)(F.ws + WS_V); float* SS = (float*)(F.ws + WS_SS);
    const float A_h = -__expf(a.in[I_ALOG][jl * 32 + h]), dsk = a.in[I_DSKIP][jl * 32 + h];
    const size_t row0 = (size_t)MP + (size_t)b * SL;
    const size_t soff = ((((size_t)jl * SB + b) * NHEAD + h) * HDIM) * NST;
    const float* st = a.in[I_SSM] + soff; float* so = F.out + OUT_SSM_S + soff;
    const int pl = lane & 15, kq = lane >> 4, tq = lane & 7;
    f32x4 hc[4][8];
#pragma unroll
    for (int pt = 0; pt < 4; ++pt)
#pragma unroll
        for (int e = 0; e < 8; ++e) hc[pt][e] = *(const f32x4*)(st + (unsigned)((16 * pt + pl) * NST + 32 * (e >> 1) + 8 * kq + 4 * (e & 1)));
    float dtv[8], acs[8]; float run = 0.f;
    const int vz = opaque(0);
#pragma unroll
    for (int t = 0; t < 8; ++t) { dtv[t] = DT[(row0 + t) * 32 + h + vz]; run += A_h * dtv[t]; acs[t] = run; }
    const float tot = run, cdec = __expf(tot);
    { float v = acs[0];
#pragma unroll
      for (int t = 1; t < 8; ++t) v = (lane == t) ? acs[t] : v;
      if (lane < 8) acsS[lane] = v; }
#pragma unroll
    for (int it = 0; it < 10; ++it) {
        const int item = lane + 64 * it, t = item / 80, qd = item % 80;
        const int ch = qd < 16 ? h * 64 + 4 * qd : (qd < 48 ? DI + g * 128 + 4 * (qd - 16) : DI + 512 + g * 128 + 4 * (qd - 48));
        const u32x2 raw = *(const u32x2*)(XBC + (row0 + t) * CONVD + ch);
        LAS float* dst = qd < 16 ? xsS + t * 64 + 4 * qd : (qd < 48 ? bmS + t * 132 + 4 * (qd - 16) : cmS + t * 132 + 4 * (qd - 48));
        *(LAS f32x4*)dst = (f32x4){bf2f(raw.x & 0xffffu), bf2f(raw.x >> 16), bf2f(raw.y & 0xffffu), bf2f(raw.y >> 16)};
    }
    wave_lds_sync();
#pragma unroll
    for (int t = 0; t < 8; ++t) { const float xd = xsS[t * 64 + lane] * dtv[t]; xdtS[t * 64 + lane] = xd; xdtwS[t * 64 + lane] = xd * __expf(tot - acs[t]); }
    { const int t = lane >> 3, k = lane & 7; float s = 0.f;
#pragma unroll 8
      for (int n = 0; n < 128; n += 4) { const f32x4 c4 = *(const LAS f32x4*)(cmS + t * 132 + n), b4 = *(const LAS f32x4*)(bmS + k * 132 + n); s += (c4[0] * b4[0] + c4[1] * b4[1]) + (c4[2] * b4[2] + c4[3] * b4[3]); }
      LmS[lane] = (k <= t) ? s * __expf(acsS[t] - acsS[k]) : 0.f; }
    wave_lds_sync();
    bf16x8 cmF[4];
#pragma unroll
    for (int ks = 0; ks < 4; ++ks) cmF[ks] = pack8(*(const LAS f32x4*)(cmS + tq * 132 + 32 * ks + 8 * kq), *(const LAS f32x4*)(cmS + tq * 132 + 32 * ks + 8 * kq + 4));
    float Lrow[8];
#pragma unroll
    for (int k = 0; k < 8; ++k) Lrow[k] = LmS[tq * 8 + k];
    const float eacs = __expf(acsS[tq]);
    float ssacc = 0.f;
#pragma unroll
    for (int pt = 0; pt < 4; ++pt) {
        const int p = 16 * pt + pl;
        const int kqo = opaque(kq);
        float xw[8];
#pragma unroll
        for (int t = 0; t < 8; ++t) xw[t] = xdtwS[t * 64 + p];
        f32x4 yacc = {0.f, 0.f, 0.f, 0.f};
#pragma unroll
        for (int ks = 0; ks < 4; ++ks) {
            const f32x4 h0a = hc[pt][2 * ks], h0b = hc[pt][2 * ks + 1];
            yacc = __builtin_amdgcn_mfma_f32_16x16x32_bf16(pack8(h0a, h0b), cmF[ks], yacc, 0, 0, 0);
            f32x4 na = h0a * cdec, nb = h0b * cdec;
#pragma unroll
            for (int t = 0; t < 8; ++t) { na = na + *(const LAS f32x4*)(bmS + t * 132 + 32 * ks + 8 * kqo) * xw[t]; nb = nb + *(const LAS f32x4*)(bmS + t * 132 + 32 * ks + 8 * kqo + 4) * xw[t]; }
            *(f32x4*)(so + (unsigned)(p * NST + 32 * ks + 8 * kq)) = na; *(f32x4*)(so + (unsigned)(p * NST + 32 * ks + 8 * kq + 4)) = nb;
        }
#pragma unroll
        for (int r = 0; r < 4; ++r) {
            const int pp = 16 * pt + 4 * kq + r;
            float y = eacs * yacc[r] + dsk * xsS[tq * 64 + pp];
#pragma unroll
            for (int k = 0; k < 8; ++k) y += Lrow[k] * xdtS[k * 64 + pp];
            if (pl < 8) {
                const size_t grow = row0 + tq;
                const float z = bf2f(ZX[grow * ZXP + h * 64 + pp]);
                const float vv = y * silu_f(z);
                V[grow * DI + h * 64 + pp] = (bf16_t)f2bf(vv);
                ssacc += vv * vv;
            }
        }
        asm volatile("" ::: "memory");
    }
    ssacc += shx(ssacc, 16);
    ssacc += shx(ssacc, 32);
    if (lane < 8) SS[(row0 + lane) * 32 + h] = ssacc;
    wave_lds_sync();
}

__device__ __forceinline__ void scan_phase(const Frame& F, const Args& a, int jl) {
#ifndef REP_SP
#define REP_SP 1
#endif
#ifndef REP_SS
#define REP_SS 1
#endif
    for (int rep = 0; rep < REP_SP; ++rep)
    for (int u = blockIdx.x; u < PB * NHEAD; u += F.G) {
        const int x = u & 7, hi = (u >> 3) & 7, z = u >> 6, bg = x + 8 * z;
        scan_prompt_unit(F, a, jl, bg >> 2, (bg & 3) * 8 + hi);
    }
    for (int rep = 0; rep < REP_SS; ++rep)
    for (int u = F.gw; u < SB * NHEAD; u += F.ngw) scan_sample_unit(F, a, jl, u >> 5, u & 31);
    const bf16_t* ZX = (const bf16_t*)(F.ws + WS_ZX);
    for (int i = F.gw * 64 + F.lane; i < (PB + SB) * 3 * (CONVD / 4); i += F.ngw * 64) {
        const int c4 = i % (CONVD / 4), rr = (i / (CONVD / 4)) % 3, bb = i / (3 * (CONVD / 4));
        const size_t row = bb < PB ? (size_t)bb * PL + (PL - 3) + rr : (size_t)MP + (size_t)(bb - PB) * SL + (SL - 3) + rr;
        const u32x2 raw = *(const u32x2*)(ZX + row * ZXP + DI + c4 * 4);
        float* o = bb < PB ? F.out + OUT_CONV_P + (((size_t)jl * PB + bb) * 3 + rr) * CONVD + c4 * 4 : F.out + OUT_CONV_S + (((size_t)jl * SB + (bb - PB)) * 3 + rr) * CONVD + c4 * 4;
        *(f32x4*)o = (f32x4){bf2f(raw.x & 0xffffu), bf2f(raw.x >> 16), bf2f(raw.y & 0xffffu), bf2f(raw.y >> 16)};
    }
}

constexpr float ATT_C = 0.0625f * 1.4426950408889634f;
__device__ __forceinline__ void stage_256x256_tr(LAS unsigned char* L, const bf16_t* src, int pitch, int tid) {
#pragma unroll 1
    for (int hseg = 0; hseg < 2; ++hseg) {
        u32x4 st[8];
#pragma unroll
        for (int i = 0; i < 8; ++i) { const int c = tid + NTHR * (i + 8 * hseg), row = c >> 5, ch = c & 31; st[i] = *(const u32x4*)(src + (unsigned)(row * pitch + ch * 8)); }
#pragma unroll
        for (int i = 0; i < 8; ++i) { const int c = tid + NTHR * (i + 8 * hseg), row = c >> 5, ch = c & 31; *(LAS u32x4*)(L + row * 512 + ((ch ^ ((row & 3) << 1)) << 4)) = st[i]; }
    }
}
__device__ __forceinline__ void stage_256x256(LAS unsigned char* L, const bf16_t* src, int pitch, int tid) {
#pragma unroll 1
    for (int hseg = 0; hseg < 2; ++hseg) {
        u32x4 st[8];
#pragma unroll
        for (int i = 0; i < 8; ++i) { const int c = tid + NTHR * (i + 8 * hseg), row = c >> 5, ch = c & 31; st[i] = *(const u32x4*)(src + (unsigned)(row * pitch + ch * 8)); }
#pragma unroll
        for (int i = 0; i < 8; ++i) { const int c = tid + NTHR * (i + 8 * hseg), row = c >> 5, ch = c & 31; *(LAS u32x4*)(L + row * 512 + ((ch ^ (row & 15)) << 4)) = st[i]; }
    }
}
__device__ __forceinline__ void attn_prompt_wg(const Frame& F, const bf16_t* Qp, const bf16_t* Kp, const bf16_t* VTp, bf16_t* Op) {
    LAS unsigned char* L = F.lds;
    const int lane = opaque(F.lane), w = F.wave, tid = w * 64 + lane, fr = lane & 15, fq = lane >> 4;
    stage_256x256(L, Kp, D, tid);
    __syncthreads();
    bf16x8 pf[2][8];
#pragma unroll
    for (int qh = 0; qh < 2; ++qh) {
        const int qrow = qh * 128 + w * 16 + fr;
        bf16x8 qf[8];
#pragma unroll
        for (int ks = 0; ks < 8; ++ks) qf[ks] = *(const bf16x8*)(Qp + (unsigned)(qrow * D + ks * 32 + 8 * fq));
        f32x4 s[16];
#pragma unroll
        for (int kt = 0; kt < 16; ++kt) {
            f32x4 acc = {0.f, 0.f, 0.f, 0.f};
#pragma unroll
            for (int ks = 0; ks < 8; ++ks)
                acc = __builtin_amdgcn_mfma_f32_16x16x32_bf16(*(const LAS bf16x8*)(L + (kt * 16 + fr) * 512 + (((ks * 4 + fq) ^ fr) << 4)), qf[ks], acc, 0, 0, 0);
            s[kt] = acc;
            asm volatile("" ::: "memory");
        }
        float mx = -3.0e38f;
#pragma unroll
        for (int kt = 0; kt < 16; ++kt)
#pragma unroll
            for (int r = 0; r < 4; ++r) mx = fmaxf(mx, s[kt][r]);
        mx = fmaxf(mx, shx(mx, 16)); mx = fmaxf(mx, shx(mx, 32));
        float sum = 0.f;
#pragma unroll
        for (int kt = 0; kt < 16; ++kt)
#pragma unroll
            for (int r = 0; r < 4; ++r) { const float p = __builtin_amdgcn_exp2f((s[kt][r] - mx) * ATT_C); s[kt][r] = p; sum += p; }
        sum += shx(sum, 16); sum += shx(sum, 32);
        const float inv = 1.0f / sum;
#pragma unroll
        for (int k2 = 0; k2 < 8; ++k2) pf[qh][k2] = pack8(s[2 * k2] * inv, s[2 * k2 + 1] * inv);
        asm volatile("" ::: "memory");
    }
    __syncthreads();
    stage_256x256_tr(L, VTp, D, tid);
    __syncthreads();
    const int qrow0 = w * 16 + fr;
    const unsigned trq = (unsigned)((lane & 15) >> 2), trp = (unsigned)(lane & 3), trrow = (unsigned)(4 * fq) + trq;
#pragma unroll 1
    for (int dt = 0; dt < 16; ++dt) {
        const unsigned a0 = (unsigned)(size_t)L + trrow * 512u + (((2u * ((unsigned)dt ^ trq)) + (trp >> 1)) << 4) + 8u * (trp & 1u), a1 = a0 + 65536u;
        u32x2 r0, r1, r2, r3, r4, r5, r6, r7, r8, r9, r10, r11, r12, r13, r14, r15;
        asm volatile("ds_read_b64_tr_b16 %0, %16\n\tds_read_b64_tr_b16 %1, %16 offset:8192\n\tds_read_b64_tr_b16 %2, %16 offset:16384\n\tds_read_b64_tr_b16 %3, %16 offset:24576\n\t"
                     "ds_read_b64_tr_b16 %4, %16 offset:32768\n\tds_read_b64_tr_b16 %5, %16 offset:40960\n\tds_read_b64_tr_b16 %6, %16 offset:49152\n\tds_read_b64_tr_b16 %7, %16 offset:57344\n\t"
                     "ds_read_b64_tr_b16 %8, %17\n\tds_read_b64_tr_b16 %9, %17 offset:8192\n\tds_read_b64_tr_b16 %10, %17 offset:16384\n\tds_read_b64_tr_b16 %11, %17 offset:24576\n\t"
                     "ds_read_b64_tr_b16 %12, %17 offset:32768\n\tds_read_b64_tr_b16 %13, %17 offset:40960\n\tds_read_b64_tr_b16 %14, %17 offset:49152\n\tds_read_b64_tr_b16 %15, %17 offset:57344\n\t"
                     "s_waitcnt lgkmcnt(0)"
                     : "=&v"(r0), "=&v"(r1), "=&v"(r2), "=&v"(r3), "=&v"(r4), "=&v"(r5), "=&v"(r6), "=&v"(r7), "=&v"(r8), "=&v"(r9), "=&v"(r10), "=&v"(r11), "=&v"(r12), "=&v"(r13), "=&v"(r14), "=&v"(r15)
                     : "v"(a0), "v"(a1) : "memory");
        f32x4 o0 = {0.f, 0.f, 0.f, 0.f}, o1 = {0.f, 0.f, 0.f, 0.f};
#define TR_MMA(k2_, lo_, hi_) do { const u32x4 av = {lo_.x, lo_.y, hi_.x, hi_.y}; o0 = __builtin_amdgcn_mfma_f32_16x16x32_bf16(__builtin_bit_cast(bf16x8, av), pf[0][k2_], o0, 0, 0, 0); \
            o1 = __builtin_amdgcn_mfma_f32_16x16x32_bf16(__builtin_bit_cast(bf16x8, av), pf[1][k2_], o1, 0, 0, 0); } while (0)
        TR_MMA(0, r0, r1); TR_MMA(1, r2, r3); TR_MMA(2, r4, r5); TR_MMA(3, r6, r7); TR_MMA(4, r8, r9); TR_MMA(5, r10, r11); TR_MMA(6, r12, r13); TR_MMA(7, r14, r15);
#undef TR_MMA
        u32x2 w0, w1; w0.x = cvt_pk_bf16(o0[0], o0[1]); w0.y = cvt_pk_bf16(o0[2], o0[3]); w1.x = cvt_pk_bf16(o1[0], o1[1]); w1.y = cvt_pk_bf16(o1[2], o1[3]);
        *(u32x2*)(Op + (unsigned)(qrow0 * D + dt * 16 + 4 * fq)) = w0;
        *(u32x2*)(Op + (unsigned)((qrow0 + 128) * D + dt * 16 + 4 * fq)) = w1;
    }
    __syncthreads();
}
constexpr int AS_STAT = MISC_OFF + 1024;
__device__ __forceinline__ void attn_sample_wg(const Frame& F, const bf16_t* Qp, const float* Kp, const float* Vp, bf16_t* Op) {
    LAS float* RED = (LAS float*)F.lds; LAS float* MXS = (LAS float*)(F.lds + AS_STAT); LAS float* SMS = MXS + 128;
    const int lane = F.lane, w = F.wave, fr = lane & 15, fq = lane >> 4;
    bf16x8 qf[8];
#pragma unroll
    for (int ks = 0; ks < 8; ++ks) qf[ks] = *(const bf16x8*)(Qp + (unsigned)((fr & 7) * D + ks * 32 + 8 * fq));
    f32x4 s[2];
#pragma unroll
    for (int x = 0; x < 2; ++x) {
        f32x4 acc = {0.f, 0.f, 0.f, 0.f};
        const float* kp = Kp + (unsigned)((w * 32 + x * 16 + fr) * D + 8 * fq);
#pragma unroll
        for (int ks = 0; ks < 8; ++ks) { const f32x4 k0 = *(const f32x4*)(kp + ks * 32), k1 = *(const f32x4*)(kp + ks * 32 + 4); acc = __builtin_amdgcn_mfma_f32_16x16x32_bf16(pack8(k0, k1), qf[ks], acc, 0, 0, 0); }
        s[x] = acc;
    }
#define AS_LOADV(dst_, db_) do { _Pragma("unroll") for (int j = 0; j < 8; ++j) { const int key = w * 32 + (j < 4 ? 4 * fq + j : 16 + 4 * fq + (j - 4)); dst_[j] = *(const f32x4*)(Vp + (unsigned)(key * D + (db_) * 64 + 4 * fr)); } } while (0)
#define AS_PROC(src_, db_) do { _Pragma("unroll") for (int i = 0; i < 4; ++i) { \
            u32x4 wv; wv.x = cvt_pk_bf16(src_[0][i], src_[1][i]); wv.y = cvt_pk_bf16(src_[2][i], src_[3][i]); wv.z = cvt_pk_bf16(src_[4][i], src_[5][i]); wv.w = cvt_pk_bf16(src_[6][i], src_[7][i]); \
            const f32x4 o = __builtin_amdgcn_mfma_f32_16x16x32_bf16(pf, __builtin_bit_cast(bf16x8, wv), (f32x4){0.f, 0.f, 0.f, 0.f}, 0, 0, 0); \
            *(LAS f32x4*)(RED + ((w * 16 + (db_) * 4 + i) * 64 + lane) * 4) = o; } } while (0)
    f32x4 va0[8], va1[8];
    AS_LOADV(va0, 0); AS_LOADV(va1, 1);
    float mx = fmaxf(fmaxf(fmaxf(s[0][0], s[0][1]), fmaxf(s[0][2], s[0][3])), fmaxf(fmaxf(s[1][0], s[1][1]), fmaxf(s[1][2], s[1][3])));
    mx = fmaxf(mx, shx(mx, 16)); mx = fmaxf(mx, shx(mx, 32));
    if (fq == 0) MXS[w * 16 + fr] = mx;
    lds_barrier();
    float gm = MXS[fr];
#pragma unroll
    for (int w2 = 1; w2 < 8; ++w2) gm = fmaxf(gm, MXS[w2 * 16 + fr]);
    float sum = 0.f;
#pragma unroll
    for (int x = 0; x < 2; ++x)
#pragma unroll
        for (int r = 0; r < 4; ++r) { const float p = __builtin_amdgcn_exp2f((s[x][r] - gm) * ATT_C); s[x][r] = p; sum += p; }
    sum += shx(sum, 16); sum += shx(sum, 32);
    if (fq == 0) SMS[w * 16 + fr] = sum;
    const bf16x8 pf = pack8(s[0], s[1]);
    {   f32x4 vb0[8], vb1[8];
        AS_LOADV(vb0, 2); AS_LOADV(vb1, 3);
        AS_PROC(va0, 0); AS_PROC(va1, 1); AS_PROC(vb0, 2); AS_PROC(vb1, 3);
    }
#undef AS_LOADV
#undef AS_PROC
    lds_barrier();
    {   const int db = w >> 1, i0 = 2 * (w & 1);
        f32x4 a0 = {0.f, 0.f, 0.f, 0.f}, a1 = {0.f, 0.f, 0.f, 0.f};
#pragma unroll
        for (int w2 = 0; w2 < 8; ++w2) { a0 = a0 + *(const LAS f32x4*)(RED + ((w2 * 16 + db * 4 + i0) * 64 + lane) * 4); a1 = a1 + *(const LAS f32x4*)(RED + ((w2 * 16 + db * 4 + i0 + 1) * 64 + lane) * 4); }
        if (fq < 2) {
#pragma unroll
            for (int r = 0; r < 4; ++r) {
                const int t = 4 * fq + r;
                float tot = 0.f;
#pragma unroll
                for (int w2 = 0; w2 < 8; ++w2) tot += SMS[w2 * 16 + t];
                const float inv = 1.0f / tot;
                *(unsigned*)(Op + (unsigned)(t * D + db * 64 + 4 * fr + i0)) = cvt_pk_bf16(a0[r] * inv, a1[r] * inv);
            }
        }
    }
    lds_barrier();
}
__device__ __forceinline__ void attn_phase(const Frame& F, const Args& a, int layer) {
    const bf16_t* Q = (const bf16_t*)(F.ws + WS_Q); bf16_t* O = (bf16_t*)(F.ws + WS_O);
    const bf16_t* KB = (const bf16_t*)(F.ws + WS_KB) + (size_t)layer * 2048 * D; const bf16_t* VB = (const bf16_t*)(F.ws + WS_VT) + (size_t)layer * 2048 * D;
    const float* CK = a.in[I_CK] + (size_t)layer * SB * NMEM * D; const float* CV = a.in[I_CV] + (size_t)layer * SB * NMEM * D;
    for (int u = blockIdx.x; u < PB * 4 * (PL / 256); u += F.G) {
        const int x = u & 7, y = u >> 3, bh = x + 8 * (y >> 3), qb = y & 7, b = bh >> 2, h = bh & 3;
        const size_t row0 = (size_t)b * PL + qb * 256;
#ifndef NO_APW
        attn_prompt_wg(F, Q + row0 * D + h * 256, KB + (size_t)b * NMEM * D + h * 256, VB + (size_t)b * NMEM * D + h * 256, O + row0 * D + h * 256);
#endif
    }
    Frame F2 = F; F2.tid = tid_now(F.wave); F2.lane = F2.tid & 63;
    for (int u = blockIdx.x; u < SB * 4; u += F.G) {
        const int b = u >> 2, h = u & 3; const size_t row0 = (size_t)MP + (size_t)b * SL;
#ifndef NO_ASW
        attn_sample_wg(F2, Q + row0 * D + h * 256, CK + (size_t)b * NMEM * D + h * 256, CV + (size_t)b * NMEM * D + h * 256, O + row0 * D + h * 256);
#endif
    }
}

constexpr int PH_PRO = 0, PH_KV = 1, PH_SEG0 = 2, PH_PER_SEG = 13, PH_FINAL = PH_SEG0 + 8 * PH_PER_SEG, PH_END = PH_FINAL + 1;
__global__ void __launch_bounds__(NTHR, 2) fwd(Args a) {
    extern __shared__ __attribute__((aligned(16))) unsigned char lds_raw[];
    Frame F;
    F.lds = (LAS unsigned char*)lds_raw;
    F.tid = threadIdx.x; F.lane = F.tid & 63; F.wave = __builtin_amdgcn_readfirstlane(F.tid >> 6);
    F.G = gridDim.x; F.gw = (int)blockIdx.x * NWAVES + F.wave; F.ngw = F.G * NWAVES;
    F.ws = a.ws; F.out = a.out;
    volatile LAS unsigned* MISC = (volatile LAS unsigned*)(F.lds + MISC_OFF);
    if (F.tid < 64) MISC[F.tid] = 0u;
    __syncthreads();
#if ONE_LAUNCH
    XcdBarrier bar = xcd_barrier_post((unsigned*)(a.ws + WS_CTL) + CW_BAR, MISC + 8, F.wave);
#define SEAM() xcd_barrier(bar)
#else
#define SEAM() do {} while (0)
#endif
#define PH(id) (a.ph_lo <= (id) && (id) < a.ph_hi)
#ifndef REP_SCAN
#define REP_SCAN 1
#endif
#ifndef REP_ATTN
#define REP_ATTN 1
#endif
#ifndef REP_NORM
#define REP_NORM 1
#endif
#ifndef REP_PRO
#define REP_PRO 1
#endif
#define REFRESH() do { F.tid = tid_now(F.wave); F.lane = F.tid & 63; F.ws = launder_u(a.ws); F.out = launder_f(a.out); F.gw = launder_i(F.gw); } while (0)
#define RELANE() do { F.tid = tid_now(F.wave); F.lane = F.tid & 63; } while (0)
#define WSB(off, T) ((T*)(F.ws + (off)))
#define XPTR WSB(WS_X, float)
#define SRC_P ((s == 0) ? a.in[I_XP] : (const float*)XPTR)
#define SRC_S ((s == 0) ? a.in[I_XS] : (const float*)XPTR + (size_t)MP * D)

#ifndef NO_PRO
    if (PH(PH_PRO)) for (int rep = 0; rep < REP_PRO; ++rep) { REFRESH(); p0_prologue(F, a); SEAM(); }
#endif
    const bool fill0 = (F.G == 256);
    if (PH(PH_KV)) {
        REFRESH();
        pg8::Gemm g{WSB(WS_WKV, const bf16_t), WSB(WS_WKV, const bf16_t), D, D, D, 0};
        pg8::KvOrder S{F.G, (int)blockIdx.x};
        pg8::EpiKV E{F.out + OUT_MK, F.out + OUT_MV, WSB(WS_KB, bf16_t), WSB(WS_VT, bf16_t)};
        pg8::gemm_phase<pg8::EpiKV, pg8::KvOrder, true, true>(F.lds, g, S, E, F.wave);
        if (fill0 && blockIdx.x >= 128) {
            RELANE(); Frame F2 = F; F2.gw = ((int)blockIdx.x - 128) * NWAVES + F.wave; F2.ngw = 128 * NWAVES;
            norm_phase<false>(F2, a.in[I_XP], a.in[I_XS], a.in[I_NF1], WSB(WS_U, bf16_t), WSB(WS_R, float), nullptr);
        }
        SEAM();
    }
#pragma unroll 1
    for (int s = 0; s < 8; ++s) {
        const int base = PH_SEG0 + s * PH_PER_SEG, layer = s >> 1, jl = layer >> 1;
        if (PH(base + 0) && !(fill0 && s == 0)) for (int rep = 0; rep < REP_NORM; ++rep) { REFRESH(); norm_phase<false>(F, SRC_P, SRC_S, a.in[(s & 1) ? I_NF2 : I_NF1] + layer * D, WSB(WS_U, bf16_t), WSB(WS_R, float), nullptr); SEAM(); }
#ifndef REP_GU
#define REP_GU 1
#endif
#ifndef REP_DOWN
#define REP_DOWN 1
#endif
        if (PH(base + 1)) for (int rep = 0; rep < REP_GU; ++rep) {
            REFRESH();
            pg8::Gemm g{WSB(WS_U, const bf16_t), WSB(WS_WGU + (size_t)s * SZ_WGU, const bf16_t), D, D, D, 0};
            pg8::StaticOrder S; S.init(M, 2 * FF, F.G, (int)blockIdx.x);
            pg8::EpiGU E{WSB(WS_H, bf16_t)};
            pg8::gemm_phase<pg8::EpiGU, pg8::StaticOrder, true, true>(F.lds, g, S, E, F.wave);
            SEAM();
        }
        if (PH(base + 2)) for (int rep = 0; rep < REP_DOWN; ++rep) {
            REFRESH(); const float alpha_ = (rep == REP_DOWN - 1) ? 0.5f : 0.0f;
            pg8::Gemm g{WSB(WS_H, const bf16_t), WSB(WS_WD + (size_t)s * SZ_WD, const bf16_t), FF, FF, FF, 0};
            pg8::StaticOrder S; S.init(MP, D, F.G, (int)blockIdx.x);
            pg8::EpiRes E{SRC_P, SRC_S, XPTR, alpha_, nullptr};
            pg8::Slab<MiniRes> SE{MiniRes{SRC_S - (size_t)MP * D, XPTR, alpha_, nullptr}};
            pg8::gemm_phase<pg8::EpiRes, pg8::StaticOrder, true, true, pg8::Slab<MiniRes>>(F.lds, g, S, E, F.wave, SE);
            SEAM();
        }
        if (s & 1) continue;
        if (PH(base + 3)) { REFRESH();
            if (layer & 1) norm_phase<false, false>(F, XPTR, XPTR + (size_t)MP * D, a.in[I_NMIX] + layer * D, WSB(WS_U, bf16_t), WSB(WS_R, float), nullptr);
            else norm_phase<false, true>(F, XPTR, XPTR + (size_t)MP * D, a.in[I_NMIX] + layer * D, WSB(WS_U, bf16_t), WSB(WS_R, float), nullptr);
            SEAM(); }
        if ((layer & 1) == 0) {
            if (PH(base + 4)) {
                REFRESH();
                pg8::Gemm g{WSB(WS_U, const bf16_t), WSB(WS_WIN + (size_t)jl * SZ_WIN, const bf16_t), D, D, D, 0};
                pg8::StaticOrder S; S.init(M, INP, F.G, (int)blockIdx.x);
                pg8::EpiBf16 E{WSB(WS_ZX, bf16_t), ZXP, ZXP / 256, WSB(WS_DT, float), a.in[I_DTB] + jl * 32};
                pg8::gemm_phase<pg8::EpiBf16, pg8::StaticOrder, true, true>(F.lds, g, S, E, F.wave);
                SEAM();
            }
#ifndef NO_SCAN
            if (PH(base + 12)) { REFRESH(); conv_phase(F, a, jl); SEAM(); }
            if (PH(base + 5)) for (int rep = 0; rep < REP_SCAN; ++rep) { REFRESH(); scan_phase(F, a, jl); SEAM(); }
#endif
            const bool gfold = (F.G == 256);
            if (PH(base + 6) && !gfold) { REFRESH(); gnorm_phase(F, a); SEAM(); }
            if (PH(base + 7)) {
                REFRESH();
                pg8::Gemm g{WSB(WS_V, const bf16_t), WSB(WS_WOUT + (size_t)jl * SZ_WOUT, const bf16_t), DI, DI, DI, 0};
                pg8::StaticOrder S; S.init(MP, D, F.G, (int)blockIdx.x);
                if (gfold) {
                    pg8::Unit u0; S.next(0, u0);
                    gnorm_table(F, u0.pm);
                    const LAS float* tab = (const LAS float*)(F.lds + GTAB_OFF);
                    pg8::EpiResG E{{XPTR, XPTR + (size_t)MP * D, XPTR, 1.0f, nullptr}, tab};
                    pg8::Slab<MiniRes> SE{MiniRes{XPTR, XPTR, 1.0f, nullptr}};
                    pg8::gemm_phase<pg8::EpiResG, pg8::StaticOrder, true, true, pg8::Slab<MiniRes>>(F.lds, g, S, E, F.wave, SE);
                } else {
                    pg8::EpiRes E{XPTR, XPTR + (size_t)MP * D, XPTR, 1.0f, nullptr};
                    pg8::Slab<MiniRes> SE{MiniRes{XPTR, XPTR, 1.0f, nullptr}};
                    pg8::gemm_phase<pg8::EpiRes, pg8::StaticOrder, true, true, pg8::Slab<MiniRes>>(F.lds, g, S, E, F.wave, SE);
                }
                SEAM();
            }
        } else {
#ifndef NO_POOL
            if (PH(base + 4)) { REFRESH(); pool_phase(F, a, jl, layer); SEAM(); }
#endif
            if (PH(base + 7)) {
                REFRESH();
                pg8::Gemm g{WSB(WS_Q, const bf16_t), WSB(WS_WPOOL + (size_t)jl * SZ_WPOOL, const bf16_t), 256, D, 256, 256};
                pg8::StaticOrder S; S.init(MP, D, F.G, (int)blockIdx.x);
                pg8::EpiRes E{XPTR, XPTR + (size_t)MP * D, XPTR, 1.0f, a.in[I_POOLS] + jl * D};
                pg8::Slab<MiniRes> SE{MiniRes{XPTR, XPTR, 1.0f, a.in[I_POOLS] + jl * D}};
                pg8::gemm_phase<pg8::EpiRes, pg8::StaticOrder, true, true, pg8::Slab<MiniRes>>(F.lds, g, S, E, F.wave, SE);
                SEAM();
            }
        }
        if (PH(base + 8)) for (int rep = 0; rep < REP_NORM; ++rep) { REFRESH(); norm_phase<false>(F, XPTR, XPTR + (size_t)MP * D, a.in[I_NCROSS] + layer * D, WSB(WS_U, bf16_t), WSB(WS_R, float), nullptr); SEAM(); }
        if (PH(base + 9)) {
            REFRESH();
            pg8::Gemm g{WSB(WS_U, const bf16_t), WSB(WS_WQ + (size_t)layer * SZ_WSQ, const bf16_t), D, D, D, 0};
            pg8::StaticOrder S; S.init(MP, D, F.G, (int)blockIdx.x);
            pg8::EpiBf16 E{WSB(WS_Q, bf16_t), D, -1, nullptr, nullptr};
            pg8::Slab<MiniBf16> SE{MiniBf16{WSB(WS_Q, bf16_t), D}};
            pg8::gemm_phase<pg8::EpiBf16, pg8::StaticOrder, true, true, pg8::Slab<MiniBf16>>(F.lds, g, S, E, F.wave, SE);
            SEAM();
        }
#ifndef NO_ATTN
        if (PH(base + 10)) for (int rep = 0; rep < REP_ATTN; ++rep) { REFRESH(); attn_phase(F, a, layer); SEAM(); }
#endif
        if (PH(base + 11)) {
            REFRESH();
            pg8::Gemm g{WSB(WS_O, const bf16_t), WSB(WS_WO + (size_t)layer * SZ_WSQ, const bf16_t), D, D, D, 0};
            pg8::StaticOrder S; S.init(MP, D, F.G, (int)blockIdx.x);
            pg8::EpiRes E{XPTR, XPTR + (size_t)MP * D, XPTR, 1.0f, nullptr};
            pg8::Slab<MiniRes> SE{MiniRes{XPTR, XPTR, 1.0f, nullptr}};
            pg8::gemm_phase<pg8::EpiRes, pg8::StaticOrder, true, true, pg8::Slab<MiniRes>>(F.lds, g, S, E, F.wave, SE);
            SEAM();
        }
    }
    if (PH(PH_FINAL)) { REFRESH(); norm_phase<true>(F, XPTR, XPTR + (size_t)MP * D, a.in[I_NFIN], nullptr, nullptr, F.out + OUT_Y); }
#undef PH
#undef SEAM
#undef REFRESH
#undef WSB
#undef XPTR
#undef SRC_P
#undef SRC_S
}

extern "C" void kernel_launch(void* const* d_in, const int* in_sizes, int n_in, void* d_out, int out_size, void* d_ws, size_t ws_size, hipStream_t stream) {
    static int grid = 0;
    if (grid == 0) {
        if (n_in != 34 || (size_t)out_size != OUT_END || ws_size < WS_END) { fprintf(stderr, "kernel_launch: unexpected shapes: n_in %d out %d (want %zu) ws %zu (want %zu)\n", n_in, out_size, (size_t)OUT_END, ws_size, (size_t)WS_END); grid = -1; return; }
        int dev = 0, cus = 0, per_cu = 0;
        if (hipGetDevice(&dev) != hipSuccess || hipDeviceGetAttribute(&cus, hipDeviceAttributeMultiprocessorCount, dev) != hipSuccess) { grid = -1; return; }
        if (hipFuncSetAttribute((const void*)fwd, hipFuncAttributeMaxDynamicSharedMemorySize, LDS_BYTES) != hipSuccess) { fprintf(stderr, "kernel_launch: hipFuncSetAttribute failed\n"); grid = -1; return; }
        if (hipOccupancyMaxActiveBlocksPerMultiprocessor(&per_cu, (const void*)fwd, NTHR, LDS_BYTES) != hipSuccess || per_cu < 1) { fprintf(stderr, "kernel_launch: occupancy query says %d\n", per_cu); }
        (void)hipGetLastError();
        grid = cus;
    }
    if (grid < 0) return;
    (void)hipMemsetAsync((char*)d_ws + WS_CTL, 0, CTL_ZERO_BYTES, stream);
    Args a{};
    for (int i = 0; i < 34; ++i) a.in[i] = (const float*)d_in[i];
    a.out = (float*)d_out; a.ws = (unsigned char*)d_ws;
#if ONE_LAUNCH
    a.ph_lo = 0; a.ph_hi = PH_END;
    hipLaunchKernelGGL(fwd, dim3(grid), dim3(NTHR), LDS_BYTES, stream, a);
#else
#ifndef PH_LIMIT
#define PH_LIMIT PH_END
#endif
    for (int id = 0; id < PH_END; ++id) {
        bool valid = false;
        if (id < PH_SEG0 || id == PH_FINAL) valid = true;
        else { const int s = (id - PH_SEG0) / PH_PER_SEG, k = (id - PH_SEG0) % PH_PER_SEG, layer = s >> 1;
               if (k <= 2) valid = true; else if (!(s & 1)) valid = (layer & 1) ? (k != 5 && k != 6 && k != 12) : true; }
        if (!valid) continue;
        if (id >= PH_LIMIT && id != PH_FINAL) continue;
        a.ph_lo = id; a.ph_hi = id + 1;
        hipLaunchKernelGGL(fwd, dim3(grid), dim3(NTHR), LDS_BYTES, stream, a);
    }
#endif
}
```
